# Optimizing an MI355X kernel written in HIP

```python
import jax, jax.numpy as jnp
from jax import lax
import numpy as np

D_MODEL = 2048
BATCH = 4
SEQ = 4096
DEPTH = 2

GRID_W = 64
CTX_LEN = 256
MLA_HEADS = 8
MLA_Q_RANK = 512
MLA_KV_RANK = 512
MLA_NOPE = 128
MLA_ROPE = 64
MLA_V = 128
SWA_HEADS = 8
SWA_KV_HEADS = 2
SWA_HEAD_DIM = 64
SWA_WINDOW = 128
SWA_BLOCK = 128
CONV_CH = 512
CONV_K = 31
D_FF = 4 * D_MODEL

Q_BLOCK = 128
ROPE_THETA = 10000.0
EPS = 1e-6
NEG_INF = -1e30
MLA_SCALE = (MLA_NOPE + MLA_ROPE) ** -0.5
SWA_SCALE = SWA_HEAD_DIM ** -0.5
SWA_GROUP = SWA_HEADS // SWA_KV_HEADS

MLA_OUT = MLA_HEADS * MLA_V
SWA_OUT = SWA_HEADS * SWA_HEAD_DIM
MIX_WIDTH = MLA_OUT + SWA_OUT + CONV_CH
IN_SIZES = (MLA_Q_RANK, MLA_KV_RANK, MLA_ROPE,
            SWA_HEADS * SWA_HEAD_DIM, SWA_KV_HEADS * SWA_HEAD_DIM, SWA_KV_HEADS * SWA_HEAD_DIM,
            2 * CONV_CH)
IN_WIDTH = sum(IN_SIZES)
IN_OFFSETS = tuple(sum(IN_SIZES[:i + 1]) for i in range(len(IN_SIZES) - 1))

kernel_name = "hybrid_parallel_groups_dit_block"


def rms_norm(x, g):
    xf = x.astype(jnp.float32)
    y = xf * lax.rsqrt(jnp.mean(xf * xf, axis=-1, keepdims=True) + EPS)
    return (y * g.astype(jnp.float32)).astype(x.dtype)


def layer_norm(x, g, b):
    xf = x.astype(jnp.float32)
    mu = jnp.mean(xf, axis=-1, keepdims=True)
    xc = xf - mu
    y = xc * lax.rsqrt(jnp.mean(xc * xc, axis=-1, keepdims=True) + EPS)
    return (y * g.astype(jnp.float32) + b.astype(jnp.float32)).astype(x.dtype)


def modulate(x, g, shift, scale):
    return rms_norm(x, g) * (1 + scale) + shift


def axial_rope(rows, rot_dim):
    row = jnp.repeat(jnp.arange(rows, dtype=jnp.float32), GRID_W)
    col = jnp.tile(jnp.arange(GRID_W, dtype=jnp.float32), rows)
    n_freq = rot_dim // 4
    inv_freq = ROPE_THETA ** (-jnp.arange(n_freq, dtype=jnp.float32) / n_freq)
    ang = jnp.stack([row[:, None] * inv_freq, col[:, None] * inv_freq], axis=1)
    return jnp.cos(ang), jnp.sin(ang)


def rope_2d(x, cos, sin):
    b_, s_, h_, r_ = x.shape
    xr = x.reshape(b_, s_, h_, 2, 2, r_ // 4)
    x1, x2 = xr[..., 0, :], xr[..., 1, :]
    c = cos[None, :, None].astype(x.dtype)
    s = sin[None, :, None].astype(x.dtype)
    y = jnp.stack([x1 * c - x2 * s, x2 * c + x1 * s], axis=-2)
    return y.reshape(x.shape)


def blocked_attention(q, k, v, scale):
    b_, s_, h_, d_ = q.shape
    nb = s_ // Q_BLOCK
    qb = q.reshape(b_, nb, Q_BLOCK, h_, d_).transpose(1, 0, 2, 3, 4)

    def one_block(q_blk):
        s = jnp.einsum('bqhd,bkhd->bhqk', q_blk, k).astype(jnp.float32) * scale
        p = jax.nn.softmax(s, axis=-1).astype(v.dtype)
        return jnp.einsum('bhqk,bkhd->bqhd', p, v)

    out = lax.map(one_block, qb)
    return out.transpose(1, 0, 2, 3, 4).reshape(b_, s_, h_, v.shape[-1])


def mla_q(a_q, q_norm, w_uq, rope):
    q = jnp.einsum('bsr,rhd->bshd', rms_norm(a_q, q_norm), w_uq)
    q_nope, q_pe = q[..., :MLA_NOPE], q[..., MLA_NOPE:]
    if rope is not None:
        q_pe = rope_2d(q_pe, *rope)
    return jnp.concatenate([q_nope, q_pe], axis=-1)


def mla_kv(a_kv, a_kr, kv_norm, w_ukv, rope):
    kv = jnp.einsum('bsr,rhd->bshd', rms_norm(a_kv, kv_norm), w_ukv)
    k_nope, v = kv[..., :MLA_NOPE], kv[..., MLA_NOPE:]
    k_pe = a_kr[:, :, None, :]
    if rope is not None:
        k_pe = rope_2d(k_pe, *rope)
    k_pe = jnp.broadcast_to(k_pe, k_nope.shape[:-1] + (MLA_ROPE,))
    return jnp.concatenate([k_nope, k_pe], axis=-1), v


def swa_latent(q, k, v, kc, vc, sink):
    b_, s_, h_, dh = q.shape
    nb = s_ // SWA_BLOCK
    win = 3 * SWA_BLOCK
    pad = ((0, 0), (SWA_BLOCK, SWA_BLOCK), (0, 0), (0, 0))
    kp = jnp.pad(k, pad).reshape(b_, nb + 2, SWA_BLOCK, SWA_KV_HEADS, dh)
    vp = jnp.pad(v, pad).reshape(b_, nb + 2, SWA_BLOCK, SWA_KV_HEADS, dh)
    kw = jnp.concatenate([kp[:, :-2], kp[:, 1:-1], kp[:, 2:]], axis=2)
    vw = jnp.concatenate([vp[:, :-2], vp[:, 1:-1], vp[:, 2:]], axis=2)
    qb = q.reshape(b_, nb, SWA_BLOCK, SWA_KV_HEADS, SWA_GROUP, dh)
    s_loc = jnp.einsum('bnqkgd,bnwkd->bnkgqw', qb, kw).astype(jnp.float32) * SWA_SCALE
    s_ctx = jnp.einsum('bnqkgd,bckd->bnkgqc', qb, kc).astype(jnp.float32) * SWA_SCALE
    qi = jnp.arange(SWA_BLOCK)[:, None]
    wi = jnp.arange(win)[None, :]
    kpos = jnp.arange(nb)[:, None, None] * SWA_BLOCK - SWA_BLOCK + wi
    valid = (jnp.abs(wi - SWA_BLOCK - qi) <= SWA_WINDOW)[None] & (kpos >= 0) & (kpos < s_)
    s_loc = jnp.where(valid[None, :, None, None], s_loc, NEG_INF)
    s_sink = jnp.broadcast_to(
        sink.reshape(SWA_KV_HEADS, SWA_GROUP)[None, None, :, :, None, None].astype(jnp.float32),
        s_loc.shape[:-1] + (1,))
    p = jax.nn.softmax(jnp.concatenate([s_loc, s_ctx, s_sink], axis=-1), axis=-1).astype(v.dtype)
    n_ctx = kc.shape[1]
    out = (jnp.einsum('bnkgqw,bnwkd->bnqkgd', p[..., :win], vw)
           + jnp.einsum('bnkgqc,bckd->bnqkgd', p[..., win:win + n_ctx], vc))
    return out.reshape(b_, s_, h_, dh)


def swa_context(qc, kc, vc, sink):
    b_, l_, h_, dh = qc.shape
    qg = qc.reshape(b_, l_, SWA_KV_HEADS, SWA_GROUP, dh)
    s = jnp.einsum('bqkgd,bckd->bkgqc', qg, kc).astype(jnp.float32) * SWA_SCALE
    s_sink = jnp.broadcast_to(
        sink.reshape(SWA_KV_HEADS, SWA_GROUP)[None, :, :, None, None].astype(jnp.float32),
        s.shape[:-1] + (1,))
    p = jax.nn.softmax(jnp.concatenate([s, s_sink], axis=-1), axis=-1).astype(vc.dtype)
    out = jnp.einsum('bkgqc,bckd->bqkgd', p[..., :l_], vc)
    return out.reshape(b_, l_, h_, dh)


def conformer_conv(u, conv_w, conv_b, ln_g, ln_b):
    a, g = jnp.split(u, 2, axis=-1)
    h = a * jax.nn.sigmoid(g)
    h = lax.conv_general_dilated(
        h, conv_w, window_strides=(1,), padding=((CONV_K // 2, CONV_K // 2),),
        dimension_numbers=('NWC', 'WIO', 'NWC'), feature_group_count=CONV_CH) + conv_b
    return jax.nn.silu(layer_norm(h, ln_g, ln_b))


def merge_groups(out_a, out_b, out_c, out_norm, w_out):
    b_, s_ = out_c.shape[:2]
    y = jnp.concatenate([
        rms_norm(out_a.reshape(b_, s_, MLA_OUT), out_norm[:MLA_OUT]),
        rms_norm(out_b.reshape(b_, s_, SWA_OUT), out_norm[MLA_OUT:MLA_OUT + SWA_OUT]),
        rms_norm(out_c, out_norm[MLA_OUT + SWA_OUT:]),
    ], axis=-1)
    return y @ w_out


def token_mixer(h, hc, w_in, q_norm, w_uq, kv_norm, w_ukv, sink, conv_w, conv_b,
                ln_g, ln_b, out_norm, w_out, rope_a, rope_b, with_ctx_out):
    b_, s_, _ = h.shape
    l_ = hc.shape[1]
    a_q, a_kv, a_kr, b_q, b_k, b_v, c_in = jnp.split(h @ w_in, IN_OFFSETS, axis=-1)
    ac_q, ac_kv, ac_kr, bc_q, bc_k, bc_v, cc_in = jnp.split(hc @ w_in, IN_OFFSETS, axis=-1)

    k_a, v_a = mla_kv(a_kv, a_kr, kv_norm, w_ukv, rope_a)
    kc_a, vc_a = mla_kv(ac_kv, ac_kr, kv_norm, w_ukv, None)
    q_a = mla_q(a_q, q_norm, w_uq, rope_a)
    out_a = blocked_attention(q_a, jnp.concatenate([k_a, kc_a], axis=1),
                              jnp.concatenate([v_a, vc_a], axis=1), MLA_SCALE)

    q_b = rope_2d(b_q.reshape(b_, s_, SWA_HEADS, SWA_HEAD_DIM), *rope_b)
    k_b = rope_2d(b_k.reshape(b_, s_, SWA_KV_HEADS, SWA_HEAD_DIM), *rope_b)
    v_b = b_v.reshape(b_, s_, SWA_KV_HEADS, SWA_HEAD_DIM)
    kc_b = bc_k.reshape(b_, l_, SWA_KV_HEADS, SWA_HEAD_DIM)
    vc_b = bc_v.reshape(b_, l_, SWA_KV_HEADS, SWA_HEAD_DIM)
    out_b = swa_latent(q_b, k_b, v_b, kc_b, vc_b, sink)

    out_c = conformer_conv(c_in, conv_w, conv_b, ln_g, ln_b)

    y = merge_groups(out_a, out_b, out_c, out_norm, w_out)
    if not with_ctx_out:
        return y, None
    outc_a = blocked_attention(mla_q(ac_q, q_norm, w_uq, None), kc_a, vc_a, MLA_SCALE)
    outc_b = swa_context(bc_q.reshape(b_, l_, SWA_HEADS, SWA_HEAD_DIM), kc_b, vc_b, sink)
    outc_c = conformer_conv(cc_in, conv_w, conv_b, ln_g, ln_b)
    yc = merge_groups(outc_a, outc_b, outc_c, out_norm, w_out)
    return y, yc


def sq_relu_mlp(h, w1, w2):
    return jnp.square(jax.nn.relu(h @ w1)) @ w2


def setup_inputs(seed: int = 0) -> dict:
    key = jax.random.key(seed)
    ks = jax.random.split(key, 24)
    f32 = jnp.float32
    L, D = DEPTH, D_MODEL

    def dense(k, shape, fan_in, mult=1.0):
        return jax.random.normal(k, shape, f32) * (mult * fan_in ** -0.5)

    def gain(k, shape):
        return 1.0 + 0.05 * jax.random.normal(k, shape, f32)

    def small(k, shape, s=0.02):
        return s * jax.random.normal(k, shape, f32)

    return {
        "x": jax.random.normal(ks[0], (BATCH, SEQ, D), f32),
        "c": jax.random.normal(ks[1], (BATCH, D), f32),
        "ctx": jax.random.normal(ks[2], (BATCH, CTX_LEN, D), f32),
        "c_ctx": jax.random.normal(ks[3], (D,), f32),
        "ada_w": dense(ks[4], (L, D, 6 * D), D, 0.5),
        "ada_b": small(ks[5], (L, 6 * D)),
        "norm_mix": gain(ks[6], (L, D)),
        "norm_mlp": gain(ks[7], (L, D)),
        "w_in": dense(ks[8], (L, D, IN_WIDTH), D),
        "mla_q_norm": gain(ks[9], (L, MLA_Q_RANK)),
        "mla_w_uq": dense(ks[10], (L, MLA_Q_RANK, MLA_HEADS, MLA_NOPE + MLA_ROPE), MLA_Q_RANK),
        "mla_kv_norm": gain(ks[11], (L, MLA_KV_RANK)),
        "mla_w_ukv": dense(ks[12], (L, MLA_KV_RANK, MLA_HEADS, MLA_NOPE + MLA_V), MLA_KV_RANK),
        "swa_sink": small(ks[13], (L, SWA_HEADS), 0.5),
        "conv_w": dense(ks[14], (L, CONV_K, 1, CONV_CH), CONV_K),
        "conv_b": small(ks[15], (L, CONV_CH)),
        "conv_ln_g": gain(ks[16], (L, CONV_CH)),
        "conv_ln_b": small(ks[17], (L, CONV_CH)),
        "out_norm": gain(ks[18], (L, MIX_WIDTH)),
        "w_out": dense(ks[19], (L, MIX_WIDTH, D), MIX_WIDTH),
        "mlp_w1": dense(ks[20], (L, D, D_FF), D),
        "mlp_w2": dense(ks[21], (L, D_FF, D), D_FF),
        "final_norm": gain(ks[22], (D,)),
    }


def reference(x, c, ctx, c_ctx, ada_w, ada_b, norm_mix, norm_mlp, w_in, mla_q_norm,
              mla_w_uq, mla_kv_norm, mla_w_ukv, swa_sink, conv_w, conv_b, conv_ln_g,
              conv_ln_b, out_norm, w_out, mlp_w1, mlp_w2, final_norm):
    n_tok = x.shape[1]
    rows = n_tok // GRID_W
    rope_a = axial_rope(rows, MLA_ROPE)
    rope_b = axial_rope(rows, SWA_HEAD_DIM)
    silu_c = jax.nn.silu(c)
    silu_cc = jax.nn.silu(c_ctx)
    xc = ctx
    for l in range(DEPTH):
        update_ctx = l < DEPTH - 1
        mod = silu_c @ ada_w[l] + ada_b[l]
        mod_c = silu_cc @ ada_w[l] + ada_b[l]
        sh1, sc1, g1, sh2, sc2, g2 = jnp.split(mod[:, None, :], 6, axis=-1)
        sh1c, sc1c, g1c, sh2c, sc2c, g2c = jnp.split(mod_c, 6, axis=-1)
        h = modulate(x, norm_mix[l], sh1, sc1)
        hc = modulate(xc, norm_mix[l], sh1c, sc1c)
        y, yc = token_mixer(h, hc, w_in[l], mla_q_norm[l], mla_w_uq[l], mla_kv_norm[l],
                            mla_w_ukv[l], swa_sink[l], conv_w[l], conv_b[l], conv_ln_g[l],
                            conv_ln_b[l], out_norm[l], w_out[l], rope_a, rope_b, update_ctx)
        x = x + g1 * y
        x = x + g2 * sq_relu_mlp(modulate(x, norm_mlp[l], sh2, sc2), mlp_w1[l], mlp_w2[l])
        if update_ctx:
            xc = xc + g1c * yc
            xc = xc + g2c * sq_relu_mlp(modulate(xc, norm_mlp[l], sh2c, sc2c), mlp_w1[l], mlp_w2[l])
    return rms_norm(x, final_norm)
```

```cpp
#include <hip/hip_runtime.h>
#include <hip/hip_cooperative_groups.h>
#include <cstdio>
#include <cstdint>
namespace cg = cooperative_groups;

#define LAS __attribute__((address_space(3)))
typedef unsigned short bf16_t;
typedef short bf16x8 __attribute__((ext_vector_type(8)));
typedef short s16x4 __attribute__((ext_vector_type(4)));
typedef float f32x4 __attribute__((ext_vector_type(4)));
typedef float f32x2 __attribute__((ext_vector_type(2)));
typedef float f32x16 __attribute__((ext_vector_type(16)));
typedef unsigned u32x4 __attribute__((ext_vector_type(4)));
typedef unsigned u32x2 __attribute__((ext_vector_type(2)));

constexpr int DM = 2048, NB = 4, SEQ = 4096, CTXL = 256, NLAT = NB * SEQ, NCTXR = NB * CTXL, NROW = NLAT + NCTXR, DEPTH = 2;
constexpr int INW = 2880, INWP = 3072, QW = 1536, KVW = 2048, FF = 8192, MODW = 6 * DM, MIXW = 2048;
constexpr int U_AQ = 0, U_AKV = 512, U_AKR = 1024, U_BQ = 1088, U_BK = 1600, U_BV = 1728, U_CA = 1856, U_CG = 2368;
constexpr float EPS = 1e-6f;
constexpr float MLA_SCALE = 0.07216878364870322f;
constexpr float SWA_SCALE = 0.125f;


constexpr size_t MiB = 1u << 20;
constexpr size_t WS_MOD = 0;
constexpr size_t WS_CTL = 512 * 1024;
constexpr size_t WS_WL = 1 * MiB;
constexpr size_t WL_IN = 0, WL_UQ = 12 * MiB, WL_UKV = WL_UQ + 1536 * 1024, WL_OUT = WL_UKV + 2 * MiB, WL_W1 = WL_OUT + 8 * MiB, WL_W2 = WL_W1 + 32 * MiB, WL_SIZE = WL_W2 + 32 * MiB;
constexpr size_t WS_X = WS_WL + 2 * WL_SIZE;
constexpr size_t WS_HN = WS_X + (size_t)NROW * DM * 4;
constexpr size_t WS_U = WS_HN + (size_t)NROW * DM * 2;
constexpr size_t WS_Q = WS_U + (size_t)NROW * INWP * 2;
constexpr size_t WS_KV = WS_Q + (size_t)NROW * QW * 2;
constexpr size_t WS_MIX = WS_KV + (size_t)NROW * KVW * 2;
constexpr size_t WS_ACT = WS_U;
constexpr size_t WS_SLAB = WS_MIX + (size_t)NROW * MIXW * 2;
constexpr size_t WS_END = WS_SLAB + (size_t)8 * NCTXR * DM * 4;
static_assert(WS_ACT + (size_t)NROW * FF * 2 <= WS_SLAB, "act overlay");

__device__ const float ROPE_TAB[64 * 16 * 2] = {
1.00000000e+00f, 0.00000000e+00f, 1.00000000e+00f, 0.00000000e+00f, 1.00000000e+00f, 0.00000000e+00f, 1.00000000e+00f, 0.00000000e+00f,
1.00000000e+00f, 0.00000000e+00f, 1.00000000e+00f, 0.00000000e+00f, 1.00000000e+00f, 0.00000000e+00f, 1.00000000e+00f, 0.00000000e+00f,
1.00000000e+00f, 0.00000000e+00f, 1.00000000e+00f, 0.00000000e+00f, 1.00000000e+00f, 0.00000000e+00f, 1.00000000e+00f, 0.00000000e+00f,
1.00000000e+00f, 0.00000000e+00f, 1.00000000e+00f, 0.00000000e+00f, 1.00000000e+00f, 0.00000000e+00f, 1.00000000e+00f, 0.00000000e+00f,
5.40302306e-01f, 8.41470985e-01f, 8.46009106e-01f, 5.33168446e-01f, 9.50415281e-01f, 3.10983591e-01f, 9.84230235e-01f, 1.76892185e-01f,
9.95004165e-01f, 9.98334181e-02f, 9.98419278e-01f, 5.62044992e-02f, 9.99500042e-01f, 3.16175047e-02f, 9.99841890e-01f, 1.77818571e-02f,
9.99950000e-01f, 9.99983311e-03f, 9.99984189e-01f, 5.62338361e-03f, 9.99995000e-01f, 3.16227236e-03f, 9.99998419e-01f, 1.77827849e-03f,
9.99999500e-01f, 9.99999881e-04f, 9.99999842e-01f, 5.62341272e-04f, 9.99999950e-01f, 3.16227752e-04f, 9.99999984e-01f, 1.77827939e-04f,
-4.16146837e-01f, 9.09297427e-01f, 4.31462816e-01f, 9.02130721e-01f, 8.06578412e-01f, 5.91127114e-01f, 9.37418310e-01f, 3.48205273e-01f,
9.80066577e-01f, 1.98669334e-01f, 9.93682109e-01f, 1.12231311e-01f, 9.98000667e-01f, 6.32033945e-02f, 9.99367611e-01f, 3.55580912e-02f,
9.99800007e-01f, 1.99986662e-02f, 9.99936755e-01f, 1.12465894e-02f, 9.99980000e-01f, 6.32451310e-03f, 9.99993675e-01f, 3.55655136e-03f,
9.99998000e-01f, 1.99999876e-03f, 9.99999368e-01f, 1.12468237e-03f, 9.99999800e-01f, 6.32455472e-04f, 9.99999937e-01f, 3.55655873e-04f,
-9.89992497e-01f, 1.41120008e-01f, -1.15966163e-01f, 9.93253165e-01f, 5.82753640e-01f, 8.12648876e-01f, 8.61040659e-01f, 5.08536117e-01f,
9.55336486e-01f, 2.95520218e-01f, 9.85803469e-01f, 1.67903306e-01f, 9.95503374e-01f, 9.47260862e-02f, 9.98577312e-01f, 5.33230830e-02f,
9.99550034e-01f, 2.99954995e-02f, 9.99857701e-01f, 1.68694395e-02f, 9.99955000e-01f, 9.48669035e-03f, 9.99985770e-01f, 5.33481299e-03f,
9.99995500e-01f, 2.99999553e-03f, 9.99998577e-01f, 1.68702310e-03f, 9.99999550e-01f, 9.48683100e-04f, 9.99999858e-01f, 5.33483781e-04f,
-6.53643621e-01f, -7.56802495e-01f, -6.27679676e-01f, 7.78471723e-01f, 3.01137471e-01f, 9.53580738e-01f, 7.57506176e-01f, 6.52827997e-01f,
9.21060992e-01f, 3.89418348e-01f, 9.74808266e-01f, 2.23044491e-01f, 9.92010662e-01f, 1.26154060e-01f, 9.97471244e-01f, 7.10712093e-02f,
9.99200107e-01f, 3.99893333e-02f, 9.99747028e-01f, 2.24917562e-02f, 9.99920001e-01f, 1.26487732e-02f, 9.99974702e-01f, 7.11305774e-03f,
9.99992000e-01f, 3.99998952e-03f, 9.99997470e-01f, 2.24936331e-03f, 9.99999200e-01f, 1.26491069e-03f, 9.99999747e-01f, 7.11311701e-04f,
2.83662185e-01f, -9.58924275e-01f, -9.46079242e-01f, 3.23935282e-01f, -1.03423381e-02f, 9.99946517e-01f, 6.30080299e-01f, 7.76529984e-01f,
8.77582562e-01f, 4.79425539e-01f, 9.60731260e-01f, 2.77480534e-01f, 9.87526022e-01f, 1.57455882e-01f, 9.96049756e-01f, 8.87968616e-02f,
9.98750261e-01f, 4.99791663e-02f, 9.99604741e-01f, 2.81133616e-02f, 9.99875003e-01f, 1.58107286e-02f, 9.99960472e-01f, 8.89128000e-03f,
9.99987500e-01f, 4.99997952e-03f, 9.99996047e-01f, 2.81170292e-03f, 9.99998750e-01f, 1.58113816e-03f, 9.99999605e-01f, 8.89139598e-04f,
9.60170287e-01f, -2.79415498e-01f, -9.73103698e-01f, -2.30367517e-01f, -3.20796390e-01f, 9.47148181e-01f, 4.82782035e-01f, 8.75740548e-01f,
8.25335601e-01f, 5.64642493e-01f, 9.43616960e-01f, 3.31039323e-01f, 9.82053937e-01f, 1.88600277e-01f, 9.94313298e-01f, 1.06494442e-01f,
9.98200540e-01f, 5.99640051e-02f, 9.99430844e-01f, 3.37340781e-02f, 9.99820005e-01f, 1.89725269e-02f, 9.99943080e-01f, 1.06694741e-02f,
9.99982000e-01f, 5.99996405e-03f, 9.99994308e-01f, 3.37404141e-03f, 9.99998200e-01f, 1.89736535e-03f, 9.99999431e-01f, 1.06696741e-03f,
7.53902254e-01f, 6.56986599e-01f, -7.00429814e-01f, -7.13721287e-01f, -5.99437453e-01f, 8.00421602e-01f, 3.20257002e-01f, 9.47330699e-01f,
7.64842195e-01f, 6.44217678e-01f, 9.23519457e-01f, 3.83551578e-01f, 9.75599879e-01f, 2.19556087e-01f, 9.92262418e-01f, 1.24158339e-01f,
9.97551000e-01f, 6.99428476e-02f, 9.99225342e-01f, 3.93537258e-02f, 9.99755010e-01f, 2.21341355e-02f, 9.99922525e-01f, 1.24476345e-02f,
9.99975500e-01f, 6.99994305e-03f, 9.99992252e-01f, 3.93637883e-03f, 9.99997550e-01f, 2.21359246e-03f, 9.99999225e-01f, 1.24479530e-03f,
-1.45500034e-01f, 9.89358247e-01f, -2.12036448e-01f, -9.77261759e-01f, -8.18632447e-01f, 5.74317783e-01f, 1.47631213e-01f, 9.89042479e-01f,
6.96706701e-01f, 7.17356099e-01f, 9.00502310e-01f, 4.34851228e-01f, 9.68170306e-01f, 2.50292345e-01f, 9.89897766e-01f, 1.41782975e-01f,
9.96801706e-01f, 7.99146922e-02f, 9.98988242e-01f, 4.49721329e-02f, 9.99680017e-01f, 2.52955226e-02f, 9.99898809e-01f, 1.42257556e-02f,
9.99968000e-01f, 7.99991505e-03f, 9.99989881e-01f, 4.49871524e-03f, 9.99996800e-01f, 2.52981936e-03f, 9.99998988e-01f, 1.42262304e-03f,
-9.11130262e-01f, 4.12118485e-01f, 3.41660255e-01f, -9.39823531e-01f, -9.56644168e-01f, 2.91259224e-01f, -2.96507962e-02f, 9.99560318e-01f,
6.21609940e-01f, 7.83326932e-01f, 8.74638261e-01f, 4.84776146e-01f, 9.59772644e-01f, 2.80778331e-01f, 9.87220090e-01f, 1.59362777e-01f,
9.95952733e-01f, 8.98785453e-02f, 9.98719551e-01f, 5.05891178e-02f, 9.99595027e-01f, 2.84566569e-02f, 9.99871931e-01f, 1.60038307e-02f,
9.99959500e-01f, 8.99987904e-03f, 9.99987193e-01f, 5.06105023e-03f, 9.99995950e-01f, 2.84604600e-03f, 9.99998719e-01f, 1.60045073e-03f,
-8.39071529e-01f, -5.44021111e-01f, 7.90131866e-01f, -6.12936893e-01f, -9.99786072e-01f, -2.06835699e-02f, -2.05997633e-01f, 9.78552490e-01f,
5.40302306e-01f, 8.41470985e-01f, 8.46009106e-01f, 5.33168446e-01f, 9.50415290e-01f, 3.10983563e-01f, 9.84230235e-01f, 1.76892185e-01f,
9.95004166e-01f, 9.98334107e-02f, 9.98419278e-01f, 5.62044992e-02f, 9.99500042e-01f, 3.16175047e-02f, 9.99841890e-01f, 1.77818571e-02f,
9.99950000e-01f, 9.99983404e-03f, 9.99984189e-01f, 5.62338361e-03f, 9.99995000e-01f, 3.16227236e-03f, 9.99998419e-01f, 1.77827849e-03f,
4.42569799e-03f, -9.99990207e-01f, 9.95257399e-01f, -9.72764577e-02f, -9.43779739e-01f, -3.30574959e-01f, -3.75847400e-01f, 9.26681570e-01f,
4.53596100e-01f, 8.91207371e-01f, 8.14705342e-01f, 5.79875164e-01f, 9.40107590e-01f, 3.40877865e-01f, 9.80929147e-01f, 1.94365656e-01f,
9.93956098e-01f, 1.09778300e-01f, 9.98087432e-01f, 6.18181033e-02f, 9.99395061e-01f, 3.47780401e-02f, 9.99808688e-01f, 1.95598272e-02f,
9.99939501e-01f, 1.09997790e-02f, 9.99980868e-01f, 6.18571475e-03f, 9.99993950e-01f, 3.47849840e-03f, 9.99998087e-01f, 1.95610608e-03f,
8.43853959e-01f, -5.36572918e-01f, 8.93861614e-01f, 4.48342965e-01f, -7.94179352e-01f, -6.07683434e-01f, -5.33843014e-01f, 8.45583607e-01f,
3.62357710e-01f, 9.32039103e-01f, 7.80825933e-01f, 6.24748639e-01f, 9.28859871e-01f, 3.70431289e-01f, 9.77317868e-01f, 2.11777679e-01f,
9.92808636e-01f, 1.19712205e-01f, 9.97724024e-01f, 6.74297562e-02f, 9.99280086e-01f, 3.79382239e-02f, 9.99772325e-01f, 2.13377337e-02f,
9.99928001e-01f, 1.19997121e-02f, 9.99977232e-01f, 6.74804441e-03f, 9.99992800e-01f, 3.79472386e-03f, 9.99997723e-01f, 2.13393360e-03f,
9.07446781e-01f, 4.20167037e-01f, 5.17172845e-01f, 8.55880978e-01f, -5.65820493e-01f, -8.24528453e-01f, -6.75001666e-01f, 7.37816204e-01f,
2.67498760e-01f, 9.63558205e-01f, 7.44477987e-01f, 6.67647007e-01f, 9.16683370e-01f, 3.99614314e-01f, 9.73397544e-01f, 2.29122720e-01f,
9.91561894e-01f, 1.29634138e-01f, 9.97329065e-01f, 7.30392768e-02f, 9.99155119e-01f, 4.10980321e-02f, 9.99732799e-01f, 2.31155726e-02f,
9.99915501e-01f, 1.29996341e-02f, 9.99973279e-01f, 7.31037192e-03f, 9.99991550e-01f, 4.11094918e-03f, 9.99997328e-01f, 2.31176106e-03f,
1.36737218e-01f, 9.90607356e-01f, -1.87961516e-02f, 9.99823337e-01f, -2.81349481e-01f, -9.59605372e-01f, -7.94870905e-01f, 6.06778580e-01f,
1.69967166e-01f, 9.85449726e-01f, 7.05776374e-01f, 7.08434690e-01f, 9.03590249e-01f, 4.28397784e-01f, 9.69169414e-01f, 2.46395308e-01f,
9.90215996e-01f, 1.39543115e-01f, 9.96902569e-01f, 7.86464803e-02f, 9.99020160e-01f, 4.42574256e-02f, 9.99690113e-01f, 2.48933403e-02f,
9.99902002e-01f, 1.39995431e-02f, 9.99969010e-01f, 7.87269666e-03f, 9.99990200e-01f, 4.42717408e-03f, 9.99996901e-01f, 2.48958868e-03f,
-7.59687913e-01f, 6.50287840e-01f, -5.48975472e-01f, 8.35838460e-01f, 3.10223509e-02f, -9.99518691e-01f, -8.89670427e-01f, 4.56603254e-01f,
7.07372017e-02f, 9.97494987e-01f, 6.64843529e-01f, 7.46982651e-01f, 8.89593626e-01f, 4.56752865e-01f, 9.64634817e-01f, 2.63589966e-01f,
9.88771079e-01f, 1.49438124e-01f, 9.96444547e-01f, 8.42512043e-02f, 9.98875211e-01f, 4.74163803e-02f, 9.99644265e-01f, 2.66710293e-02f,
9.99887502e-01f, 1.49994381e-02f, 9.99964425e-01f, 8.43501985e-03f, 9.99988750e-01f, 4.74339854e-03f, 9.99996442e-01f, 2.66741598e-03f,
-9.57659480e-01f, -2.87903317e-01f, -9.10081090e-01f, 4.14430224e-01f, 3.40318168e-01f, -9.40310345e-01f, -9.56410050e-01f, 2.92027082e-01f,
-2.91995461e-02f, 9.99573602e-01f, 6.21808819e-01f, 7.83169070e-01f, 8.74707484e-01f, 4.84651232e-01f, 9.59795176e-01f, 2.80701301e-01f,
9.87227284e-01f, 1.59318203e-01f, 9.95955015e-01f, 8.98532639e-02f, 9.98720273e-01f, 5.05748570e-02f, 9.99595256e-01f, 2.84486321e-02f,
9.99872003e-01f, 1.59993181e-02f, 9.99959523e-01f, 8.99733943e-03f, 9.99987200e-01f, 5.05962253e-03f, 9.99995952e-01f, 2.84524320e-03f,
-2.75163338e-01f, -9.61397492e-01f, -9.90897960e-01f, -1.34615131e-01f, 6.15864792e-01f, -7.87851863e-01f, -9.92984984e-01f, 1.18240524e-01f,
-1.28844542e-01f, 9.91664804e-01f, 5.76808296e-01f, 8.16879544e-01f, 8.58946708e-01f, 5.12064988e-01f, 9.54652029e-01f, 2.97723872e-01f,
9.85584767e-01f, 1.69182351e-01f, 9.95433988e-01f, 9.54524822e-02f, 9.98555348e-01f, 5.37328280e-02f, 9.99543086e-01f, 3.02261450e-02f,
9.99855503e-01f, 1.69991821e-02f, 9.99954305e-01f, 9.55965617e-03f, 9.99985550e-01f, 5.37584601e-03f, 9.99995431e-01f, 3.02307034e-03f,
6.60316708e-01f, -7.50987247e-01f, -7.66536540e-01f, -6.42200695e-01f, 8.30336128e-01f, -5.57262877e-01f, -9.98241661e-01f, -5.92755186e-02f,
-2.27202164e-01f, 9.73847615e-01f, 5.29984176e-01f, 8.48007532e-01f, 8.42327058e-01f, 5.38966722e-01f, 9.49207011e-01f, 3.14652269e-01f,
9.83843694e-01f, 1.79029566e-01f, 9.94881482e-01f, 1.01048682e-01f, 9.98380437e-01f, 5.68902654e-02f, 9.99487755e-01f, 3.20035622e-02f,
9.99838004e-01f, 1.79990291e-02f, 9.99948772e-01f, 1.01219708e-02f, 9.99983800e-01f, 5.69206895e-03f, 9.99994877e-01f, 3.20089737e-03f,
9.88704618e-01f, 1.49877210e-01f, -3.06095406e-01f, -9.52000842e-01f, 9.62463796e-01f, -2.71410100e-01f, -9.72014272e-01f, -2.34921804e-01f,
-3.23289544e-01f, 9.46300095e-01f, 4.81484589e-01f, 8.76454557e-01f, 8.24865151e-01f, 5.65329535e-01f, 9.43461826e-01f, 3.31481196e-01f,
9.82004236e-01f, 1.88858893e-01f, 9.94297517e-01f, 1.06641679e-01f, 9.98195543e-01f, 6.00471302e-02f, 9.99429263e-01f, 3.37808820e-02f,
9.99819505e-01f, 1.89988581e-02f, 9.99942921e-01f, 1.06842813e-02f, 9.99981950e-01f, 6.00829132e-03f, 9.99994292e-01f, 3.37872454e-03f,
4.08082062e-01f, 9.12945251e-01f, 2.48616731e-01f, -9.68601941e-01f, 9.99144380e-01f, 4.13582902e-02f, -9.15129950e-01f, -4.03158994e-01f,
-4.16146837e-01f, 9.09297427e-01f, 4.31462816e-01f, 9.02130721e-01f, 8.06578448e-01f, 5.91127066e-01f, 9.37418310e-01f, 3.48205273e-01f,
9.80066580e-01f, 1.98669319e-01f, 9.93682109e-01f, 1.12231311e-01f, 9.98000667e-01f, 6.32033945e-02f, 9.99367611e-01f, 3.55580912e-02f,
9.99800007e-01f, 1.99986681e-02f, 9.99936755e-01f, 1.12465894e-02f, 9.99980000e-01f, 6.32451310e-03f, 9.99993675e-01f, 3.55655136e-03f,
-5.47729260e-01f, 8.36655639e-01f, 7.26760256e-01f, -6.86891207e-01f, 9.36740452e-01f, 3.50024751e-01f, -8.29382949e-01f, -5.58680521e-01f,
-5.04846228e-01f, 8.63209294e-01f, 3.80076998e-01f, 9.24954850e-01f, 7.87485197e-01f, 6.16333566e-01f, 9.31078354e-01f, 3.64819269e-01f,
9.78030916e-01f, 2.08459893e-01f, 9.93035277e-01f, 1.17817394e-01f, 9.97795810e-01f, 6.63590305e-02f, 9.99302799e-01f, 3.73351880e-02f,
9.99779508e-01f, 2.09984581e-02f, 9.99930273e-01f, 1.18088930e-02f, 9.99977950e-01f, 6.64073424e-03f, 9.99993027e-01f, 3.73437808e-03f,
-9.99960826e-01f, -8.85130929e-03f, 9.81074582e-01f, -1.93630229e-01f, 7.81440393e-01f, 6.23979898e-01f, -7.17477463e-01f, -6.96581718e-01f,
-5.88501156e-01f, 8.08496376e-01f, 3.27489589e-01f, 9.44854787e-01f, 7.67604563e-01f, 6.40923736e-01f, 9.24443984e-01f, 3.81317874e-01f,
9.75897450e-01f, 2.18229622e-01f, 9.92357044e-01f, 1.23399744e-01f, 9.97580976e-01f, 6.95140029e-02f, 9.99234826e-01f, 3.91121704e-02f,
9.99758010e-01f, 2.19982271e-02f, 9.99923474e-01f, 1.23711928e-02f, 9.99975800e-01f, 6.95695471e-03f, 9.99992347e-01f, 3.91220468e-03f,
-5.32833020e-01f, -8.46220404e-01f, 9.33235772e-01f, 3.59264517e-01f, 5.48645256e-01f, 8.36055251e-01f, -5.82943235e-01f, -8.12512883e-01f,
-6.66275986e-01f, 7.45705244e-01f, 2.73866839e-01f, 9.61767620e-01f, 7.46956388e-01f, 6.64873036e-01f, 9.17517275e-01f, 3.97695927e-01f,
9.73666397e-01f, 2.27977513e-01f, 9.91647429e-01f, 1.28978199e-01f, 9.97356166e-01f, 7.26682802e-02f, 9.99163694e-01f, 4.08890255e-02f,
9.99735512e-01f, 2.29979741e-02f, 9.99916359e-01f, 1.29334897e-02f, 9.99973550e-01f, 7.27317449e-03f, 9.99991636e-01f, 4.09003138e-03f,
4.24179007e-01f, -9.05578362e-01f, 5.97977171e-01f, 8.01513133e-01f, 2.61441688e-01f, 9.65219272e-01f, -4.30023272e-01f, -9.02817803e-01f,
-7.37393780e-01f, 6.75463110e-01f, 2.19378275e-01f, 9.75639878e-01f, 7.25561320e-01f, 6.88157519e-01f, 9.10300429e-01f, 4.13948220e-01f,
9.71337976e-01f, 2.37702621e-01f, 9.90906456e-01f, 1.34552575e-01f, 9.97121382e-01f, 7.58218234e-02f, 9.99089402e-01f, 4.26657512e-02f,
9.99712014e-01f, 2.39976963e-02f, 9.99908928e-01f, 1.34957815e-02f, 9.99971200e-01f, 7.58939308e-03f, 9.99990893e-01f, 4.26785749e-03f,
9.91202812e-01f, -1.32351750e-01f, 7.85522636e-02f, 9.96909997e-01f, -5.16893290e-02f, 9.98663213e-01f, -2.63540593e-01f, -9.64648307e-01f,
-8.01143616e-01f, 5.98472144e-01f, 1.64196159e-01f, 9.86427707e-01f, 7.03440751e-01f, 7.10753902e-01f, 9.02795741e-01f, 4.30069588e-01f,
9.68912422e-01f, 2.47403959e-01f, 9.90134147e-01f, 1.40122697e-01f, 9.96876627e-01f, 7.89746157e-02f, 9.99011951e-01f, 4.44423420e-02f,
9.99687516e-01f, 2.49973963e-02f, 9.99901180e-01f, 1.40580691e-02f, 9.99968750e-01f, 7.90561137e-03f, 9.99990118e-01f, 4.44568393e-03f,
6.46919322e-01f, 7.62558450e-01f, -4.65064496e-01f, 8.85276801e-01f, -3.59694339e-01f, 9.33070191e-01f, -8.87455026e-02f, -9.96054334e-01f,
-8.56888827e-01f, 5.15501249e-01f, 1.08494947e-01f, 9.94097001e-01f, 6.80616801e-01f, 7.32639591e-01f, 8.95005558e-01f, 4.46054986e-01f,
9.66389981e-01f, 2.57080543e-01f, 9.89330528e-01f, 1.45688387e-01f, 9.96621904e-01f, 8.21266183e-02f, 9.98931341e-01f, 4.62187923e-02f,
9.99662019e-01f, 2.59970713e-02f, 9.99893117e-01f, 1.46203532e-02f, 9.99966200e-01f, 8.22182888e-03f, 9.99989312e-01f, 4.62350977e-03f,
-2.92138809e-01f, 9.56375928e-01f, -8.65450634e-01f, 5.00994211e-01f, -6.32028631e-01f, 7.74945037e-01f, 8.88481164e-02f, -9.96045186e-01f,
-9.04072162e-01f, 4.27379837e-01f, 5.24506144e-02f, 9.98623519e-01f, 6.57112291e-01f, 7.53792702e-01f, 8.86932371e-01f, 4.61899307e-01f,
9.63770901e-01f, 2.66731418e-01f, 9.88495623e-01f, 1.51249471e-01f, 9.96357214e-01f, 8.52777923e-02f, 9.98847571e-01f, 4.79951001e-02f,
9.99635522e-01f, 2.69967203e-02f, 9.99884737e-01f, 1.51826317e-02f, 9.99963550e-01f, 8.53804556e-03f, 9.99988474e-01f, 4.80133592e-03f,
-9.62605866e-01f, 2.70905788e-01f, -9.99293409e-01f, -3.75856620e-02f, -8.41684939e-01f, 5.39968946e-01f, 2.63639511e-01f, -9.64621277e-01f,
-9.42222325e-01f, 3.34988195e-01f, -3.75941901e-03f, 9.99992933e-01f, 6.32950677e-01f, 7.74192121e-01f, 8.78578705e-01f, 4.77597592e-01f,
9.61055438e-01f, 2.76355650e-01f, 9.87629462e-01f, 1.56805757e-01f, 9.96082561e-01f, 8.84281209e-02f, 9.98760643e-01f, 4.97712524e-02f,
9.99608026e-01f, 2.79963423e-02f, 9.99876041e-01f, 1.57449054e-02f, 9.99960800e-01f, 8.85426139e-03f, 9.99987604e-01f, 4.97916193e-03f,
-7.48057530e-01f, -6.63633884e-01f, -8.25371633e-01f, -5.64589822e-01f, -9.67871508e-01f, 2.51445312e-01f, 4.30115848e-01f, -9.02773702e-01f,
-9.70958188e-01f, 2.39249237e-01f, -5.99575673e-02f, 9.98200927e-01f, 6.08156211e-01f, 7.93817374e-01f, 8.69947214e-01f, 4.93144851e-01f,
9.58243878e-01f, 2.85952217e-01f, 9.86732067e-01f, 1.62357098e-01f, 9.95797946e-01f, 9.15775651e-02f, 9.98670557e-01f, 5.15472474e-02f,
9.99579529e-01f, 2.89959364e-02f, 9.99867029e-01f, 1.63071750e-02f, 9.99957950e-01f, 9.17047633e-03f, 9.99986703e-01f, 5.15698731e-03f,
1.54251450e-01f, -9.88031624e-01f, -3.97251862e-01f, -9.17709626e-01f, -9.98075227e-01f, -6.20148391e-02f, 5.83026938e-01f, -8.12452823e-01f,
-9.89992497e-01f, 1.41120008e-01f, -1.15966163e-01f, 9.93253165e-01f, 5.82753640e-01f, 8.12648876e-01f, 8.61040659e-01f, 5.08536117e-01f,
9.55336494e-01f, 2.95520190e-01f, 9.85803469e-01f, 1.67903306e-01f, 9.95503374e-01f, 9.47260937e-02f, 9.98577312e-01f, 5.33230830e-02f,
9.99550034e-01f, 2.99955014e-02f, 9.99857701e-01f, 1.68694395e-02f, 9.99955000e-01f, 9.48669035e-03f, 9.99985770e-01f, 5.33481299e-03f,
9.14742358e-01f, -4.04037645e-01f, 1.53215476e-01f, -9.88192804e-01f, -9.29300295e-01f, -3.69325007e-01f, 7.17549222e-01f, -6.96507799e-01f,
-9.99135156e-01f, 4.15805195e-02f, -1.71608138e-01f, 9.85165289e-01f, 5.56768364e-01f, 8.30667797e-01f, 8.51861797e-01f, 5.23766626e-01f,
9.52333569e-01f, 3.05058639e-01f, 9.84843697e-01f, 1.73444204e-01f, 9.95198847e-01f, 9.78736675e-02f, 9.98480910e-01f, 5.50987464e-02f,
9.99519538e-01f, 3.09950364e-02f, 9.99848056e-01f, 1.74316968e-02f, 9.99951950e-01f, 9.80290343e-03f, 9.99984805e-01f, 5.51263804e-03f,
8.34223361e-01f, 5.51426681e-01f, 6.56495179e-01f, -7.54330219e-01f, -7.68367089e-01f, -6.40009388e-01f, 8.29440367e-01f, -5.58595272e-01f,
-9.98294773e-01f, -5.83741910e-02f, -2.26707585e-01f, 9.73962869e-01f, 5.30226367e-01f, 8.47856120e-01f, 8.42413559e-01f, 5.38831509e-01f,
9.49235420e-01f, 3.14566554e-01f, 9.83852782e-01f, 1.78979618e-01f, 9.94884368e-01f, 1.01020270e-01f, 9.98381351e-01f, 5.68742354e-02f,
9.99488044e-01f, 3.19945405e-02f, 9.99838096e-01f, 1.79939505e-02f, 9.99948800e-01f, 1.01191155e-02f, 9.99983809e-01f, 5.69046338e-03f,
-1.32767472e-02f, 9.99911860e-01f, 9.57586074e-01f, -2.88147378e-01f, -5.31235279e-01f, -8.47224338e-01f, 9.15171383e-01f, -4.03064932e-01f,
-9.87479777e-01f, -1.57745647e-01f, -2.81090307e-01f, 9.59681322e-01f, 5.03154187e-01f, 8.64196658e-01f, 8.32698933e-01f, 5.53726003e-01f,
9.46042349e-01f, 3.24043013e-01f, 9.82830754e-01f, 1.84509371e-01f, 9.94559939e-01f, 1.04165862e-01f, 9.98278634e-01f, 5.86495447e-02f,
9.99455549e-01f, 3.29940106e-02f, 9.99827819e-01f, 1.85561985e-02f, 9.99945550e-01f, 1.04353266e-02f, 9.99982781e-01f, 5.86828853e-03f,
-8.48570275e-01f, 5.29082686e-01f, 9.63757533e-01f, 2.66779718e-01f, -2.41421115e-01f, -9.70420448e-01f, 9.72038357e-01f, -2.34822129e-01f,
-9.66798168e-01f, -2.55541194e-01f, -3.34584379e-01f, 9.42365796e-01f, 4.75578896e-01f, 8.79673072e-01f, 8.22720991e-01f, 5.68445398e-01f,
9.42754664e-01f, 3.33487096e-01f, 9.81777647e-01f, 1.90033290e-01f, 9.94225566e-01f, 1.07310406e-01f, 9.98172760e-01f, 6.04246684e-02f,
9.99422056e-01f, 3.39934516e-02f, 9.99817226e-01f, 1.91184387e-02f, 9.99942201e-01f, 1.07515367e-02f, 9.99981722e-01f, 6.04611304e-03f,
-9.03692205e-01f, -4.28182669e-01f, 6.73110268e-01f, 7.39542134e-01f, 7.23346672e-02f, -9.97380417e-01f, 9.98247762e-01f, -5.91726788e-02f,
-9.36456687e-01f, -3.50783228e-01f, -3.87020682e-01f, 9.22071034e-01f, 4.47528065e-01f, 8.94269887e-01f, 8.12482924e-01f, 5.82984990e-01f,
9.39372715e-01f, 3.42897802e-01f, 9.80693494e-01f, 1.95551199e-01f, 9.93881250e-01f, 1.10453883e-01f, 9.98063730e-01f, 6.21996048e-02f,
9.99387563e-01f, 3.49928548e-02f, 9.99806317e-01f, 1.96806747e-02f, 9.99938751e-01f, 1.10677456e-02f, 9.99980631e-01f, 6.22393783e-03f,
-1.27963690e-01f, -9.91778853e-01f, 1.75156534e-01f, 9.84540598e-01f, 3.78916172e-01f, -9.25430999e-01f, 9.92972826e-01f, 1.18342584e-01f,
-8.96758353e-01f, -4.42520572e-01f, -4.38233547e-01f, 8.98861145e-01f, 4.19029744e-01f, 9.07972507e-01f, 8.01987899e-01f, 5.97340280e-01f,
9.35896829e-01f, 3.52274219e-01f, 9.79578328e-01f, 2.01062925e-01f, 9.93526995e-01f, 1.13596256e-01f, 9.97951544e-01f, 6.39743371e-02f,
9.99352070e-01f, 3.59922267e-02f, 9.99795091e-01f, 2.02429046e-02f, 9.99935201e-01f, 1.13839535e-02f, 9.99979509e-01f, 6.40176195e-03f,
7.65414052e-01f, -6.43538133e-01f, -3.76742289e-01f, 9.26318114e-01f, 6.47921689e-01f, -7.61706955e-01f, 9.56380030e-01f, 2.92125382e-01f,
-8.48100006e-01f, -5.29836181e-01f, -4.88060852e-01f, 8.72809604e-01f, 3.90112429e-01f, 9.20767231e-01f, 7.91239269e-01f, 6.11506680e-01f,
9.32327344e-01f, 3.61615436e-01f, 9.78432188e-01f, 2.06568278e-01f, 9.93162805e-01f, 1.16737493e-01f, 9.97836202e-01f, 6.57488745e-02f,
9.99315578e-01f, 3.69915589e-02f, 9.99783550e-01f, 2.08051261e-02f, 9.99931551e-01f, 1.17001602e-02f, 9.99978354e-01f, 6.57958633e-03f,
9.55073644e-01f, 2.96368579e-01f, -8.12611205e-01f, 5.82806168e-01f, 8.52673116e-01f, -5.22444789e-01f, 8.89623492e-01f, 4.56694694e-01f,
-7.90967741e-01f, -6.11857853e-01f, -5.36345181e-01f, 8.43998724e-01f, 3.60805033e-01f, 9.32641264e-01f, 7.80240434e-01f, 6.25479708e-01f,
9.28664637e-01f, 3.70920465e-01f, 9.77255105e-01f, 2.12067113e-01f, 9.92788684e-01f, 1.19877556e-01f, 9.97717704e-01f, 6.75232040e-02f,
9.99278087e-01f, 3.79908578e-02f, 9.99771692e-01f, 2.13673430e-02f, 9.99927801e-01f, 1.20163657e-02f, 9.99977168e-01f, 6.75741050e-03f,
2.66642932e-01f, 9.63795386e-01f, -9.98210360e-01f, 5.98003149e-02f, 9.72865350e-01f, -2.31372019e-01f, 7.94808390e-01f, 6.06860464e-01f,
-7.25932239e-01f, -6.87766228e-01f, -5.82933885e-01f, 8.12519591e-01f, 3.31136863e-01f, 9.43582735e-01f, 7.68994909e-01f, 6.39254902e-01f,
9.24909065e-01f, 3.80188402e-01f, 9.76047118e-01f, 2.17559242e-01f, 9.92404635e-01f, 1.23016426e-01f, 9.97596052e-01f, 6.92973125e-02f,
9.99239596e-01f, 3.89901151e-02f, 9.99759518e-01f, 2.19295531e-02f, 9.99923951e-01f, 1.23325701e-02f, 9.99975951e-01f, 6.93523400e-03f,
-6.66938062e-01f, 7.45113160e-01f, -8.76379442e-01f, -4.81621297e-01f, 9.96578984e-01f, 8.26458063e-02f, 6.74925652e-01f, 7.37885740e-01f,
-6.53643621e-01f, -7.56802495e-01f, -6.27679676e-01f, 7.78471723e-01f, 3.01137584e-01f, 9.53580702e-01f, 7.57506176e-01f, 6.52827997e-01f,
9.21061003e-01f, 3.89418320e-01f, 9.74808266e-01f, 2.23044491e-01f, 9.92010662e-01f, 1.26154060e-01f, 9.97471244e-01f, 7.10712093e-02f,
9.99200107e-01f, 3.99893370e-02f, 9.99747028e-01f, 2.24917562e-02f, 9.99920001e-01f, 1.26487732e-02f, 9.99974702e-01f, 7.11305774e-03f,
-9.87339278e-01f, -1.58622669e-01f, -4.84639397e-01f, -8.74714042e-01f, 9.21462347e-01f, 3.88467685e-01f, 5.33756100e-01f, 8.45638472e-01f,
-5.74824025e-01f, -8.18277056e-01f, -6.70441094e-01f, 7.41962761e-01f, 2.70837078e-01f, 9.62625201e-01f, 7.45777904e-01f, 6.66194655e-01f,
9.17120824e-01f, 3.98609325e-01f, 9.73538587e-01f, 2.28522688e-01f, 9.91606768e-01f, 1.29290439e-01f, 9.97343283e-01f, 7.28448814e-02f,
9.99159618e-01f, 4.09885153e-02f, 9.99734222e-01f, 2.30539504e-02f, 9.99915951e-01f, 1.29649751e-02f, 9.99973421e-01f, 7.29088079e-03f,
-3.99985315e-01f, -9.16521548e-01f, 5.63609403e-02f, -9.98410459e-01f, 7.54965347e-01f, 6.55764687e-01f, 3.75752152e-01f, 9.26720195e-01f,
-4.90260572e-01f, -8.71575913e-01f, -7.11082951e-01f, 7.03108126e-01f, 2.40265871e-01f, 9.70707119e-01f, 7.33813802e-01f, 6.79350649e-01f,
9.13088946e-01f, 4.07760441e-01f, 9.72238123e-01f, 2.33993657e-01f, 9.91192958e-01f, 1.32425525e-01f, 9.97212167e-01f, 7.46183157e-02f,
9.99118130e-01f, 4.19876562e-02f, 9.99721100e-01f, 2.36161391e-02f, 9.99911801e-01f, 1.32811756e-02f, 9.99972109e-01f, 7.46870408e-03f,
5.55113302e-01f, -8.31774743e-01f, 5.80003113e-01f, -8.14614258e-01f, 5.13598418e-01f, 8.58030690e-01f, 2.05897171e-01f, 9.78573633e-01f,
-4.00798997e-01f, -9.16166013e-01f, -7.49476759e-01f, 6.62030655e-01f, 2.09454419e-01f, 9.77818412e-01f, 7.21617654e-01f, 6.92291818e-01f,
9.08965759e-01f, 4.16870782e-01f, 9.70906914e-01f, 2.39457227e-01f, 9.90769236e-01f, 1.35559287e-01f, 9.97077898e-01f, 7.63915215e-02f,
9.99075642e-01f, 4.29867515e-02f, 9.99707662e-01f, 2.41783204e-02f, 9.99907551e-01f, 1.35973748e-02f, 9.99970765e-01f, 7.64652713e-03f,
9.99843309e-01f, 1.77019251e-02f, 9.25014669e-01f, -3.79931391e-01f, 2.21298174e-01f, 9.75206193e-01f, 2.95478207e-02f, 9.99563368e-01f,
-3.07332779e-01f, -9.51602103e-01f, -7.85501139e-01f, 6.18860211e-01f, 1.78433530e-01f, 9.83951968e-01f, 7.09193358e-01f, 7.05014029e-01f,
9.04751664e-01f, 4.25939463e-01f, 9.69545006e-01f, 2.44913210e-01f, 9.90335607e-01f, 1.38691694e-01f, 9.96940476e-01f, 7.81644856e-02f,
9.99032156e-01f, 4.39858075e-02f, 9.99693907e-01f, 2.47404922e-02f, 9.99903202e-01f, 1.39135727e-02f, 9.99969389e-01f, 7.82434947e-03f,
5.25321989e-01f, 8.50903525e-01f, 9.85138202e-01f, 1.71763569e-01f, -9.29481055e-02f, 9.95670955e-01f, -1.47732986e-01f, 9.89027282e-01f,
-2.10795799e-01f, -9.77530118e-01f, -8.19042201e-01f, 5.73733276e-01f, 1.47234222e-01f, 9.89101655e-01f, 6.96544759e-01f, 7.17513344e-01f,
9.00447108e-01f, 4.34965523e-01f, 9.68152431e-01f, 2.50361478e-01f, 9.89892074e-01f, 1.41822713e-01f, 9.96799902e-01f, 7.99371952e-02f,
9.98987671e-01f, 4.49848158e-02f, 9.99679836e-01f, 2.53026580e-02f, 9.99898752e-01f, 1.42297692e-02f, 9.99967982e-01f, 8.00217157e-03f,
-4.32177945e-01f, 9.01788348e-01f, 7.41858013e-01f, 6.70556998e-01f, -3.97976765e-01f, 9.17395495e-01f, -3.20354369e-01f, 9.47297777e-01f,
-1.12152622e-01f, -9.93690993e-01f, -8.49993909e-01f, 5.26792516e-01f, 1.15887692e-01f, 9.93262323e-01f, 6.83675900e-01f, 7.29785766e-01f,
8.96052507e-01f, 4.43948088e-01f, 9.66729248e-01f, 2.55801799e-01f, 9.89438642e-01f, 1.44952315e-01f, 9.96656175e-01f, 8.17096594e-02f,
9.98942186e-01f, 4.59837829e-02f, 9.99665450e-01f, 2.58648158e-02f, 9.99894202e-01f, 1.45459642e-02f, 9.99966543e-01f, 8.17999434e-03f,
-9.92335469e-01f, 1.23573123e-01f, 2.70098458e-01f, 9.62832708e-01f, -6.63538256e-01f, 7.48142355e-01f, -4.82871938e-01f, 8.75690979e-01f,
-1.23883774e-02f, -9.99923261e-01f, -8.78258409e-01f, 4.78186331e-01f, 8.44252840e-02f, 9.96429813e-01f, 6.70590848e-01f, 7.41827416e-01f,
8.91568289e-01f, 4.52886284e-01f, 9.65275487e-01f, 2.61234060e-01f, 9.88975318e-01f, 1.48080452e-01f, 9.96509297e-01f, 8.34818579e-02f,
9.98895703e-01f, 4.69827002e-02f, 9.99650747e-01f, 2.64269636e-02f, 9.99889552e-01f, 1.48621578e-02f, 9.99965073e-01f, 8.35781593e-03f,
-6.40144339e-01f, -7.68254661e-01f, -2.84846606e-01f, 9.58573112e-01f, -8.63296488e-01f, 5.04697111e-01f, -6.30159971e-01f, 7.76465332e-01f,
8.74991734e-02f, -9.96164592e-01f, -9.03746345e-01f, 4.28068388e-01f, 5.28784581e-02f, 9.98600956e-01f, 6.57293742e-01f, 7.53634485e-01f,
8.86994928e-01f, 4.61779166e-01f, 9.63791209e-01f, 2.66658031e-01f, 9.88502102e-01f, 1.51207123e-01f, 9.96359267e-01f, 8.52537997e-02f,
9.98848221e-01f, 4.79815705e-02f, 9.99635728e-01f, 2.69891049e-02f, 9.99884802e-01f, 1.51783490e-02f, 9.99963571e-01f, 8.53563725e-03f,
3.00592544e-01f, -9.53752653e-01f, -7.52063995e-01f, 6.59090090e-01f, -9.77442725e-01f, 2.11200659e-01f, -7.57573076e-01f, 6.52750361e-01f,
1.86512463e-01f, -9.82452595e-01f, -9.26377138e-01f, 3.76597130e-01f, 2.12787581e-02f, 9.99773582e-01f, 6.43788833e-01f, 7.65203201e-01f,
8.82332868e-01f, 4.70625870e-01f, 9.62276453e-01f, 2.72073570e-01f, 9.88019001e-01f, 1.54332282e-01f, 9.96206087e-01f, 8.70254719e-02f,
9.98799740e-01f, 4.89803966e-02f, 9.99620393e-01f, 2.75512376e-02f, 9.99879952e-01f, 1.54945396e-02f, 9.99962037e-01f, 8.71345923e-03f,
9.64966028e-01f, -2.62374854e-01f, -9.87659084e-01f, 1.56619074e-01f, -9.94656427e-01f, -1.03240463e-01f, -8.61092711e-01f, 5.08447974e-01f,
2.83662185e-01f, -9.58924275e-01f, -9.46079242e-01f, 3.23935282e-01f, -1.03422189e-02f, 9.99946518e-01f, 6.30080299e-01f, 7.76529984e-01f,
8.77582562e-01f, 4.79425539e-01f, 9.60731260e-01f, 2.77480534e-01f, 9.87526020e-01f, 1.57455897e-01f, 9.96049756e-01f, 8.87968616e-02f,
9.98750260e-01f, 4.99791700e-02f, 9.99604741e-01f, 2.81133598e-02f, 9.99875003e-01f, 1.58107286e-02f, 9.99960472e-01f, 8.89128000e-03f,
7.42154197e-01f, 6.70229176e-01f, -9.19073538e-01f, -3.94086072e-01f, -9.13230128e-01f, -4.07444148e-01f, -9.37454250e-01f, 3.48108502e-01f,
3.77977654e-01f, -9.25814718e-01f, -9.62790371e-01f, 2.70249331e-01f, -4.19528545e-02f, 9.99119591e-01f, 6.16172522e-01f, 7.87611213e-01f,
8.72744512e-01f, 4.88177239e-01f, 9.59155693e-01f, 2.82878695e-01f, 9.87023164e-01f, 1.60577938e-01f, 9.95890276e-01f, 9.05679778e-02f,
9.98699782e-01f, 5.09778971e-02f, 9.99588774e-01f, 2.86754749e-02f, 9.99869953e-01f, 1.61269170e-02f, 9.99958875e-01f, 9.06910049e-03f,
-1.62990781e-01f, 9.86627592e-01f, -5.67430029e-01f, -8.23421619e-01f, -7.41239965e-01f, -6.71240132e-01f, -9.84248472e-01f, 1.76790685e-01f,
4.68516924e-01f, -8.83454522e-01f, -9.76457693e-01f, 2.15709002e-01f, -7.35215408e-02f, 9.97293629e-01f, 6.02069899e-01f, 7.98443384e-01f,
8.67819189e-01f, 4.96880121e-01f, 9.57549788e-01f, 2.88267938e-01f, 9.86510437e-01f, 1.63698373e-01f, 9.95727646e-01f, 9.23388002e-02f,
9.98648305e-01f, 5.19765696e-02f, 9.99572491e-01f, 2.92375810e-02f, 9.99864803e-01f, 1.64431020e-02f, 9.99957246e-01f, 9.24692070e-03f,
-9.18282786e-01f, 3.95925150e-01f, -4.10281900e-02f, -9.99157989e-01f, -4.95741821e-01f, -8.68469946e-01f, -9.99999995e-01f, -1.03020676e-04f,
5.54374495e-01f, -8.32267336e-01f, -9.87037999e-01f, 1.60486722e-01f, -1.05016712e-01f, 9.94470457e-01f, 5.87776937e-01f, 8.09023036e-01f,
8.62807085e-01f, 5.05533317e-01f, 9.55913610e-01f, 2.93648038e-01f, 9.85987845e-01f, 1.66817172e-01f, 9.95561868e-01f, 9.41093381e-02f,
9.98595829e-01f, 5.29751937e-02f, 9.99555891e-01f, 2.97996760e-02f, 9.99859553e-01f, 1.67592871e-02f, 9.99955586e-01f, 9.42474155e-03f,
-8.29309833e-01f, -5.58789049e-01f, 4.98009600e-01f, -8.67171516e-01f, -2.01079620e-01f, -9.79574901e-01f, -9.84212024e-01f, -1.76993477e-01f,
6.34692950e-01f, -7.72764427e-01f, -9.94497866e-01f, 1.04756834e-01f, -1.36406875e-01f, 9.90652898e-01f, 5.73298061e-01f, 8.19346894e-01f,
8.57708701e-01f, 5.14135959e-01f, 9.54247195e-01f, 2.99018880e-01f, 9.85455396e-01f, 1.69934287e-01f, 9.95392941e-01f, 9.58795783e-02f,
9.98542354e-01f, 5.39737612e-02f, 9.99538975e-01f, 3.03617634e-02f, 9.99854204e-01f, 1.70754687e-02f, 9.99953894e-01f, 9.60256116e-03f,
2.21267563e-02f, -9.99755173e-01f, 8.83669314e-01f, -4.68111679e-01f, 1.13521777e-01f, -9.93535508e-01f, -9.37382505e-01f, -3.48301649e-01f,
7.08669774e-01f, -7.05540326e-01f, -9.98813646e-01f, 4.86959996e-02f, -1.67660642e-01f, 9.85844769e-01f, 5.58637897e-01f, 8.29411659e-01f,
8.52524516e-01f, 5.22687239e-01f, 9.52550613e-01f, 3.04380238e-01f, 9.84913090e-01f, 1.73049718e-01f, 9.95220867e-01f, 9.76495079e-02f,
9.98487881e-01f, 5.49722784e-02f, 9.99521744e-01f, 3.09238412e-02f, 9.99848754e-01f, 1.73916505e-02f, 9.99952171e-01f, 9.78038047e-03f,
8.53220108e-01f, -5.21551002e-01f, 9.97174636e-01f, 7.51182087e-02f, 4.16867074e-01f, -9.08967459e-01f, -8.60988417e-01f, -5.08624563e-01f,
7.75565818e-01f, -6.31266712e-01f, -9.99971734e-01f, -7.51878489e-03f, -1.98746880e-01f, 9.80050855e-01f, 5.43801080e-01f, 8.39214147e-01f,
8.47255110e-01f, 5.31186200e-01f, 9.50823909e-01f, 3.09731970e-01f, 9.84360935e-01f, 1.76163418e-01f, 9.95045645e-01f, 9.94191362e-02f,
9.98432410e-01f, 5.59707370e-02f, 9.99504196e-01f, 3.14859073e-02f, 9.99843204e-01f, 1.77078286e-02f, 9.99950416e-01f, 9.95820041e-03f,
8.99866827e-01f, 4.36164755e-01f, 8.03569087e-01f, 5.95211494e-01f, 6.78870211e-01f, -7.34258290e-01f, -7.57439190e-01f, -6.52905716e-01f,
8.34712942e-01f, -5.50685304e-01f, -9.97968467e-01f, -6.37097991e-02f, -2.29634270e-01f, 9.73276991e-01f, 5.28792303e-01f, 8.48751259e-01f,
8.41900979e-01f, 5.39632043e-01f, 9.49067129e-01f, 3.15073936e-01f, 9.83798936e-01f, 1.79275357e-01f, 9.94867276e-01f, 1.01188450e-01f,
9.98375940e-01f, 5.69691433e-02f, 9.99486332e-01f, 3.20479672e-02f, 9.99837554e-01f, 1.80240068e-02f, 9.99948629e-01f, 1.01360191e-02f,
1.19180135e-01f, 9.92872648e-01f, 3.62476666e-01f, 9.31992847e-01f, 8.73550510e-01f, -4.86733506e-01f, -6.30000714e-01f, -7.76594554e-01f,
8.85519606e-01f, -4.64602011e-01f, -9.92810180e-01f, -1.19699398e-01f, -2.60292045e-01f, 9.65529933e-01f, 5.13616311e-01f, 8.58019979e-01f,
8.36462659e-01f, 5.48023923e-01f, 9.47280345e-01f, 3.20405911e-01f, 9.83227099e-01f, 1.82385503e-01f, 9.94685763e-01f, 1.02957436e-01f,
9.98318471e-01f, 5.79674889e-02f, 9.99468152e-01f, 3.26100133e-02f, 9.99831805e-01f, 1.83401814e-02f, 9.99946811e-01f, 1.03138375e-02f,
-7.71080223e-01f, 6.36738007e-01f, -1.90249096e-01f, 9.81735851e-01f, 9.81602098e-01f, -1.90938005e-01f, -4.82692335e-01f, -8.75789992e-01f,
9.27478466e-01f, -3.73876576e-01f, -9.84513180e-01f, -1.75310575e-01f, -2.90689550e-01f, 9.56817425e-01f, 4.98277903e-01f, 8.67017376e-01f,
8.30940694e-01f, 5.56361001e-01f, 9.45463597e-01f, 3.25727781e-01f, 9.82645430e-01f, 1.85493825e-01f, 9.94501103e-01f, 1.04726105e-01f,
9.98260005e-01f, 5.89657802e-02f, 9.99449656e-01f, 3.31720491e-02f, 9.99825955e-01f, 1.86563560e-02f, 9.99944961e-01f, 1.04916564e-02f,
-9.52412980e-01f, -3.04810621e-01f, -6.84381916e-01f, 7.29123716e-01f, 9.92308319e-01f, 1.23790949e-01f, -3.20159180e-01f, -9.47363763e-01f,
9.60170287e-01f, -2.79415498e-01f, -9.73103698e-01f, -2.30367517e-01f, -3.20796390e-01f, 9.47148181e-01f, 4.82782035e-01f, 8.75740548e-01f,
8.25335635e-01f, 5.64642444e-01f, 9.43616960e-01f, 3.31039323e-01f, 9.82053934e-01f, 1.88600292e-01f, 9.94313298e-01f, 1.06494442e-01f,
9.98200540e-01f, 5.99640089e-02f, 9.99430844e-01f, 3.37340781e-02f, 9.99820005e-01f, 1.89725269e-02f, 9.99943080e-01f, 1.06694741e-02f,
-2.58101636e-01f, -9.66117770e-01f, -9.67739662e-01f, 2.51952269e-01f, 9.04607566e-01f, 4.26245412e-01f, -1.47529203e-01f, -9.89057700e-01f,
9.83268421e-01f, -1.82162598e-01f, -9.58617804e-01f, -2.84696165e-01f, -3.50582460e-01f, 9.36531867e-01f, 4.67133397e-01f, 8.84186852e-01f,
8.19648010e-01f, 5.72867472e-01f, 9.41740473e-01f, 3.36340425e-01f, 9.81452621e-01f, 1.91704858e-01f, 9.94122349e-01f, 1.08262435e-01f,
9.98140077e-01f, 6.09621813e-02f, 9.99411716e-01f, 3.42960927e-02f, 9.99813956e-01f, 1.92886978e-02f, 9.99941166e-01f, 1.08472915e-02f,
6.73507162e-01f, -7.39180697e-01f, -9.53050036e-01f, -3.02812861e-01f, 7.27198078e-01f, 6.86427677e-01f, 2.97537714e-02f, -9.99557259e-01f,
9.96542121e-01f, -8.30891177e-02f, -9.41101294e-01f, -3.38124763e-01f, -3.80017977e-01f, 9.24979101e-01f, 4.51337043e-01f, 8.92353559e-01f,
8.13878454e-01f, 5.81035164e-01f, 9.39834216e-01f, 3.41630863e-01f, 9.80841490e-01f, 1.94807522e-01f, 9.93928256e-01f, 1.10030093e-01f,
9.98078615e-01f, 6.19602890e-02f, 9.99392272e-01f, 3.48580964e-02f, 9.99807806e-01f, 1.96048648e-02f, 9.99939222e-01f, 1.10251085e-02f,
9.85896582e-01f, 1.67355700e-01f, -6.44837016e-01f, -7.64320105e-01f, 4.77671453e-01f, 8.78538550e-01f, 2.06098327e-01f, -9.78531287e-01f,
9.99858633e-01f, 1.68140912e-02f, -9.20609545e-01f, -3.90484398e-01f, -4.09073509e-01f, 9.12501433e-01f, 4.35397967e-01f, 9.00238085e-01f,
8.08027511e-01f, 5.89144754e-01f, 9.37898229e-01f, 3.46910525e-01f, 9.80220551e-01f, 1.97908238e-01f, 9.93731021e-01f, 1.11797395e-01f,
9.98016156e-01f, 6.29583348e-02f, 9.99372512e-01f, 3.54200929e-02f, 9.99801557e-01f, 1.99210318e-02f, 9.99937245e-01f, 1.12029262e-02f,
};

__device__ __forceinline__ unsigned cvt_pk_bf16(float lo, float hi) { unsigned r; asm volatile("v_cvt_pk_bf16_f32 %0, %1, %2" : "=v"(r) : "v"(lo), "v"(hi)); return r; }
__device__ __forceinline__ float bf2f(unsigned short b) { return __uint_as_float((unsigned)b << 16); }
__device__ __forceinline__ float bflo(unsigned w) { return __uint_as_float(w << 16); }
__device__ __forceinline__ float bfhi(unsigned w) { return __uint_as_float(w & 0xffff0000u); }
__device__ __forceinline__ unsigned short f2bf(float f) { unsigned u = __float_as_uint(f); return (unsigned short)((u + 0x7fffu + ((u >> 16) & 1u)) >> 16); }
__device__ __forceinline__ float wave_sum(float v, const int lane) {
#pragma unroll
    for (int o = 1; o < 64; o <<= 1) v += __int_as_float(__builtin_amdgcn_ds_bpermute((lane ^ o) << 2, __float_as_int(v)));
    return v;
}
template <int N> __device__ __forceinline__ void wave_sum_n(float (&s)[N], const int lane) {
#pragma unroll
    for (int o = 1; o < 64; o <<= 1) { float t[N]; const int idx = (lane ^ o) << 2;
#pragma unroll
        for (int q = 0; q < N; ++q) t[q] = __int_as_float(__builtin_amdgcn_ds_bpermute(idx, __float_as_int(s[q])));
#pragma unroll
        for (int q = 0; q < N; ++q) s[q] += t[q]; }
}
__device__ __forceinline__ int lane_id_() { return (int)__builtin_amdgcn_mbcnt_hi(~0u, __builtin_amdgcn_mbcnt_lo(~0u, 0u)); }
__device__ __forceinline__ int tid_from_(int wave_s) { int l; int w = wave_s; asm volatile("v_mbcnt_lo_u32_b32 %0, -1, 0\n\tv_mbcnt_hi_u32_b32 %0, -1, %0" : "=v"(l), "+s"(w)); return w * 64 + l; }
__device__ __forceinline__ float sigmoidf_(float x) { return __builtin_amdgcn_rcpf(1.0f + __expf(-x)); }

namespace pg8 {
constexpr int BM = 256, BK = 64, HALF = 128, HTB = HALF * BK * 2, STAGE_BYTES = 8 * HTB, NXCD = 8, WGM = 8;
__host__ __device__ __forceinline__ int lds_byte(int r, int c) { const int st = (r >> 4) * 2 + (c >> 5), rr = r & 15, cc = c & 31, ob = rr * 64 + cc * 2; return st * 1024 + (ob ^ (((ob >> 9) & 1) << 5)); }
__host__ __device__ __forceinline__ void stage_rc(int b, int& R, int& C) { const int st = b / 1024, sb = b % 1024, swz = sb ^ (((sb >> 9) & 1) << 5); R = (st >> 1) * 16 + swz / 64; C = (st & 1) * 32 + (swz % 64) / 2; }
__host__ __device__ __forceinline__ int perm32(int rho) { const int n = rho >> 4, i = rho & 15; return 8 * (i >> 2) + 4 * n + (i & 3); }

struct Unit { int pm, pn, k0, nt, split; };
struct Gemm { const bf16_t* A; const bf16_t* Bt; int M, N, K, lda; };

struct StaticOrder {
    int nM, nN, nwg, G, c, ntk;
    __host__ __device__ __forceinline__ void init(int M, int N, int G_, int c_, int K) { nM = M / BM; nN = N / BM; nwg = nM * nN; G = G_; c = c_; ntk = K / BK; }
    __host__ __device__ __forceinline__ bool next(int i, Unit& u) const {
        const int L = i * G + c; const bool ok = L < nwg;
        int wgid = ok ? L : 0; { const int q = nwg / NXCD, r = nwg % NXCD, xcd = wgid % NXCD, off = wgid / NXCD; wgid = (xcd < r ? xcd * (q + 1) : r * (q + 1) + (xcd - r) * q) + off; }
        const int nig = WGM * nN, gid = wgid / nig, fm = gid * WGM, gsz = (nM - fm) < WGM ? (nM - fm) : WGM;
        u.pm = fm + ((wgid % nig) % gsz); u.pn = (wgid % nig) / gsz; u.k0 = 0; u.nt = ntk; u.split = 0; return ok;
    }
    __device__ __forceinline__ void a_ready(const Unit&) const {}
    __device__ __forceinline__ void done(const Unit&) const {}
};

struct CtxSplitOrder {
    StaticOrder lat; int with_ctx, nl;
    __host__ __device__ __forceinline__ void init(int N, int G_, int c_, int K, int with_ctx_) { lat.init(NLAT, N, G_, c_, K); with_ctx = with_ctx_; nl = (lat.nwg - c_ + G_ - 1) / G_; if (nl < 0) nl = 0; }
    __host__ __device__ __forceinline__ bool next(int i, Unit& u) const {
        Unit a; const bool va = lat.next(i, a);
        const int nctx = (NCTXR / BM) * lat.nN; constexpr int S = 8;
        const bool use_lat = i < nl;
        const int sub = (use_lat ? 0 : (i - nl) * lat.G) + lat.c;
        const bool vc = with_ctx && !use_lat && sub < nctx * S;
        const int uu = sub / S, sl = sub % S, cnt = lat.ntk / S;
        u.pm = use_lat ? a.pm : NLAT / BM + (uu / lat.nN) % (NCTXR / BM); u.pn = use_lat ? a.pn : uu % lat.nN; u.nt = use_lat ? a.nt : cnt; u.k0 = use_lat ? 0 : sl * cnt * BK; u.split = use_lat ? 0 : 1 + sl;
        return use_lat ? va : vc;
    }
    __device__ __forceinline__ void a_ready(const Unit&) const {}
    __device__ __forceinline__ void done(const Unit&) const {}
};

template <int ACT  > struct EpiBf16 {
    static constexpr bool PERM = true, AFTER_DRAIN = false;
    bf16_t* O; int ldc;
    __device__ __forceinline__ void operator()(const f32x4 (&acc)[2][2][4][2], const Unit& u, int wr, int wc, int fr, int fq) const {
        const int row0 = u.pm * BM + wr * 64 + fr; const int col0 = u.pn * BM + wc * 32 + 8 * fq;
#pragma unroll
        for (int ai = 0; ai < 2; ++ai)
#pragma unroll
            for (int m = 0; m < 4; ++m) { bf16_t* rowp = O + (size_t)(row0 + ai * HALF + m * 16) * ldc + col0;
#pragma unroll
                for (int bj = 0; bj < 2; ++bj) { f32x4 v0 = acc[ai][bj][m][0], v1 = acc[ai][bj][m][1];
                    if (ACT == 2) {
#pragma unroll
                        for (int e = 0; e < 4; ++e) { float a = v0[e] > 0.f ? v0[e] : 0.f; v0[e] = a * a; float b = v1[e] > 0.f ? v1[e] : 0.f; v1[e] = b * b; } }
                    u32x4 w; w.x = cvt_pk_bf16(v0[0], v0[1]); w.y = cvt_pk_bf16(v0[2], v0[3]); w.z = cvt_pk_bf16(v1[0], v1[1]); w.w = cvt_pk_bf16(v1[2], v1[3]);
                    *(u32x4*)(rowp + bj * HALF) = w; } }
    }
};
struct EpiResid {
    static constexpr bool PERM = false, AFTER_DRAIN = false;
    const float* res_lat; const float* res_ctx; float* out; const float* gate; float* slab;
    __device__ __forceinline__ void operator()(const f32x4 (&acc)[2][2][4][2], const Unit& u, int wr, int wc, int fr, int fq) const {
        const int col0 = u.pn * BM + wc * 32 + 4 * fq;
        const bool lat = u.pm < (NLAT / BM);
        const int mrow = lat ? (u.pm >> 4) : 4;
        const float* resb = lat ? res_lat + (size_t)u.pm * BM * DM : res_ctx + (size_t)(u.pm - NLAT / BM) * BM * DM;
        float* outb = out + (size_t)u.pm * BM * DM;
        const float* gp = gate + (size_t)mrow * MODW + col0;
        if (u.split) {
            float* sb = slab + ((size_t)(u.split - 1) * NCTXR + (size_t)(u.pm - NLAT / BM) * BM) * DM + col0;
#pragma unroll
            for (int ai = 0; ai < 2; ++ai)
#pragma unroll
                for (int m = 0; m < 4; ++m) { float* op = sb + (size_t)(ai * HALF + wr * 64 + m * 16 + fr) * DM;
#pragma unroll
                    for (int bj = 0; bj < 2; ++bj)
#pragma unroll
                        for (int n = 0; n < 2; ++n) *(f32x4*)(op + bj * HALF + n * 16) = acc[ai][bj][m][n]; }
            return;
        }
        f32x4 gv[2][2];
#pragma unroll
        for (int bj = 0; bj < 2; ++bj)
#pragma unroll
            for (int n = 0; n < 2; ++n) gv[bj][n] = *(const f32x4*)(gp + bj * HALF + n * 16);
#pragma unroll
        for (int ai = 0; ai < 2; ++ai)
#pragma unroll
            for (int mp = 0; mp < 2; ++mp) {
                f32x4 bs[2][2][2];
#pragma unroll
                for (int mm = 0; mm < 2; ++mm) { const size_t off = (size_t)(ai * HALF + wr * 64 + (2 * mp + mm) * 16 + fr) * DM + col0;
#pragma unroll
                    for (int bj = 0; bj < 2; ++bj)
#pragma unroll
                        for (int n = 0; n < 2; ++n) bs[mm][bj][n] = *(const f32x4*)(resb + off + bj * HALF + n * 16); }
#pragma unroll
                for (int mm = 0; mm < 2; ++mm) { const size_t off = (size_t)(ai * HALF + wr * 64 + (2 * mp + mm) * 16 + fr) * DM + col0;
#pragma unroll
                    for (int bj = 0; bj < 2; ++bj)
#pragma unroll
                        for (int n = 0; n < 2; ++n) *(f32x4*)(outb + off + bj * HALF + n * 16) = bs[mm][bj][n] + gv[bj][n] * acc[ai][bj][2 * mp + mm][n]; }
                asm volatile("" ::: "memory");
            }
    }
};

template <class Epi, class Sched, bool ALIGN_EPI = false, bool SP2 = false>
__device__ __forceinline__ void gemm_phase(LAS unsigned char* lds, const Gemm g, const Sched& S, const Epi& E, const int wave_s) {
    const int tid_ = tid_from_(wave_s);
    const int tid = tid_, wid = __builtin_amdgcn_readfirstlane(tid >> 6), lane = tid & 63, wr = wid >> 2, wc = wid & 3, fr = lane & 15, fq = lane >> 4;
    const int K = g.K, lda = g.lda;
    unsigned voffA[2], voffB[2];
#pragma unroll
    for (int i = 0; i < 2; ++i) { int R, C; stage_rc(tid * 16 + i * 8192, R, C); const int Rb = Epi::PERM ? ((R & ~31) + perm32(R & 31)) : R;
        voffA[i] = (unsigned)(R * lda + C) * 2u; voffB[i] = (unsigned)(Rb * K + C) * 2u; }
    const size_t kstep = (size_t)(BK * 2);
    const size_t hstepA = (size_t)HALF * lda * 2, hstepB = (size_t)HALF * K * 2;
    const size_t tstepA = 2 * hstepA, tstepB = 2 * hstepB;
    const unsigned ldsw = (unsigned)wid * 1024u;
    const int aoff = lds_byte(wr * 64 + fr, fq * 8), boff = lds_byte(wc * 32 + fr, fq * 8);
#define PG8_SA(b, h) (((b) * 2 + (h)) * HTB)
#define PG8_SB(b, h) ((4 + (b) * 2 + (h)) * HTB)
#define PG8_STAGE(bufoff, gbase, voff) do { _Pragma("unroll") for (int _i = 0; _i < 2; ++_i) \
        __builtin_amdgcn_global_load_lds((const unsigned*)((const char*)(gbase) + (voff)[_i]), (LAS unsigned*)(lds + (bufoff) + ldsw + _i * 8192), 16, 0, 0); } while (0)
#define PG8_LDA(dst, b, h) do { _Pragma("unroll") for (int m = 0; m < 4; ++m) _Pragma("unroll") for (int k = 0; k < 2; ++k) dst[m][k] = *(const LAS bf16x8*)(lds + PG8_SA(b, h) + aoff + m * 2048 + k * 1024); } while (0)
#define PG8_LDB(dst, b, h) do { _Pragma("unroll") for (int n = 0; n < 2; ++n) _Pragma("unroll") for (int k = 0; k < 2; ++k) dst[n][k] = *(const LAS bf16x8*)(lds + PG8_SB(b, h) + boff + n * 2048 + k * 1024); } while (0)
#define PG8_MMA(ai, bj, At, Bt) do { __builtin_amdgcn_s_setprio(1); _Pragma("unroll") for (int m = 0; m < 4; ++m) _Pragma("unroll") for (int n = 0; n < 2; ++n) _Pragma("unroll") for (int k = 0; k < 2; ++k) \
        acc[ai][bj][m][n] = __builtin_amdgcn_mfma_f32_16x16x32_bf16(Bt[n][k], At[m][k], acc[ai][bj][m][n], 0, 0, 0); __builtin_amdgcn_s_setprio(0); } while (0)
#define PG8_WAIT_V(n) asm volatile("s_waitcnt vmcnt(" #n ")" ::: "memory")
#define PG8_WAIT_L(n) asm volatile("s_waitcnt lgkmcnt(" #n ")" ::: "memory")
#define PG8_BAR __builtin_amdgcn_s_barrier()
#define PG8_SCHED __builtin_amdgcn_sched_barrier(0)
    Unit cur, nxt; int ui = 0;
    if (!S.next(0, cur)) return;
    f32x4 acc[2][2][4][2];
#pragma unroll
    for (int a = 0; a < 2; ++a)
#pragma unroll
        for (int b = 0; b < 2; ++b)
#pragma unroll
            for (int m = 0; m < 4; ++m)
#pragma unroll
                for (int n = 0; n < 2; ++n) acc[a][b][m][n] = (f32x4){0.f, 0.f, 0.f, 0.f};
    bf16x8 At[4][2], B0[2][2], B1[2][2];
    const char* cA = (const char*)g.A + (size_t)cur.pm * tstepA + (size_t)cur.k0 * 2; const char* cB = (const char*)g.Bt + (size_t)cur.pn * tstepB + (size_t)cur.k0 * 2;
    S.a_ready(cur);
    if constexpr (SP2) {
        PG8_STAGE(PG8_SB(0, 0), cB, voffB); PG8_STAGE(PG8_SB(0, 1), cB + hstepB, voffB); PG8_STAGE(PG8_SA(0, 0), cA, voffA); PG8_STAGE(PG8_SA(0, 1), cA + hstepA, voffA);
        if (wr == 1) PG8_BAR;
        PG8_WAIT_V(2); PG8_BAR;
        PG8_STAGE(PG8_SB(1, 0), cB + kstep, voffB); PG8_STAGE(PG8_SA(1, 0), cA + kstep, voffA); PG8_STAGE(PG8_SB(1, 1), cB + hstepB + kstep, voffB);
        PG8_WAIT_V(6); PG8_BAR;
    } else {
        PG8_STAGE(PG8_SB(0, 0), cB, voffB); PG8_STAGE(PG8_SA(0, 0), cA, voffA); PG8_STAGE(PG8_SB(0, 1), cB + hstepB, voffB); PG8_STAGE(PG8_SA(0, 1), cA + hstepA, voffA);
        if (wr == 1) PG8_BAR;
        PG8_WAIT_V(4); PG8_BAR;
        PG8_STAGE(PG8_SB(1, 0), cB + kstep, voffB); PG8_STAGE(PG8_SA(1, 0), cA + kstep, voffA); PG8_STAGE(PG8_SB(1, 1), cB + hstepB + kstep, voffB);
        PG8_WAIT_V(6); PG8_BAR;
    }
    for (;;) {
        const bool has_next = S.next(ui + 1, nxt);
        const char* nA = has_next ? (const char*)g.A + (size_t)nxt.pm * tstepA + (size_t)nxt.k0 * 2 : cA; const char* nB = has_next ? (const char*)g.Bt + (size_t)nxt.pn * tstepB + (size_t)nxt.k0 * 2 : cB;
        const int nt = cur.nt;
        for (int t = 0; t < nt; t += 2) {
            const bool last = (t == nt - 2);
            const char* a1 = cA + (size_t)(t + 1) * kstep;
            const char* a2 = last ? nA : cA + (size_t)(t + 2) * kstep; const char* b2 = last ? nB : cB + (size_t)(t + 2) * kstep;
            const char* a3 = a2 + kstep; const char* b3 = b2 + kstep;
            if (last && has_next) S.a_ready(nxt);
            if constexpr (SP2) {
            PG8_LDB(B0, 0, 0); PG8_LDB(B1, 0, 1); PG8_SCHED; PG8_LDA(At, 0, 0); PG8_STAGE(PG8_SA(1, 1), a1 + hstepA, voffA);
            PG8_WAIT_V(8); PG8_WAIT_L(0); PG8_BAR; PG8_MMA(0, 0, At, B0); PG8_MMA(0, 1, At, B1); PG8_BAR; PG8_SCHED;
            PG8_LDA(At, 0, 1); PG8_STAGE(PG8_SB(0, 0), b2, voffB); PG8_STAGE(PG8_SB(0, 1), b2 + hstepB, voffB); PG8_STAGE(PG8_SA(0, 0), a2, voffA);
            PG8_WAIT_V(8); PG8_WAIT_L(0); PG8_BAR; PG8_MMA(1, 0, At, B0); PG8_MMA(1, 1, At, B1); PG8_BAR; PG8_SCHED;
            PG8_LDB(B0, 1, 0); PG8_LDB(B1, 1, 1); PG8_SCHED; PG8_LDA(At, 1, 0); PG8_STAGE(PG8_SA(0, 1), a2 + hstepA, voffA);
            PG8_WAIT_V(8); PG8_WAIT_L(0); PG8_BAR; PG8_MMA(0, 0, At, B0); PG8_MMA(0, 1, At, B1); PG8_BAR; PG8_SCHED;
            PG8_LDA(At, 1, 1); PG8_STAGE(PG8_SB(1, 0), b3, voffB); PG8_STAGE(PG8_SB(1, 1), b3 + hstepB, voffB); PG8_STAGE(PG8_SA(1, 0), a3, voffA);
            PG8_WAIT_V(8); PG8_WAIT_L(0); PG8_BAR; PG8_MMA(1, 0, At, B0); PG8_MMA(1, 1, At, B1); PG8_BAR; PG8_SCHED;
            } else {
            PG8_LDB(B0, 0, 0); PG8_SCHED; PG8_LDA(At, 0, 0); PG8_STAGE(PG8_SA(1, 1), a1 + hstepA, voffA);
            PG8_WAIT_L(8); PG8_BAR; PG8_WAIT_L(0); PG8_MMA(0, 0, At, B0); PG8_BAR; PG8_SCHED;
            PG8_LDB(B1, 0, 1); PG8_STAGE(PG8_SB(0, 0), b2, voffB);
            PG8_BAR; PG8_WAIT_L(0); PG8_MMA(0, 1, At, B1); PG8_BAR;
            PG8_LDA(At, 0, 1); PG8_STAGE(PG8_SA(0, 0), a2, voffA);
            PG8_BAR; PG8_WAIT_L(0); PG8_MMA(1, 0, At, B0); PG8_BAR; PG8_SCHED;
            PG8_STAGE(PG8_SB(0, 1), b2 + hstepB, voffB);
            PG8_WAIT_V(6); PG8_BAR; PG8_MMA(1, 1, At, B1); PG8_BAR;
            PG8_LDB(B0, 1, 0); PG8_SCHED; PG8_LDA(At, 1, 0); PG8_STAGE(PG8_SA(0, 1), a2 + hstepA, voffA);
            PG8_WAIT_L(8); PG8_BAR; PG8_WAIT_L(0); PG8_MMA(0, 0, At, B0); PG8_BAR; PG8_SCHED;
            PG8_LDB(B1, 1, 1); PG8_STAGE(PG8_SB(1, 0), b3, voffB);
            PG8_BAR; PG8_WAIT_L(0); PG8_MMA(0, 1, At, B1); PG8_BAR;
            PG8_LDA(At, 1, 1); PG8_STAGE(PG8_SA(1, 0), a3, voffA);
            PG8_BAR; PG8_WAIT_L(0); PG8_MMA(1, 0, At, B0); PG8_BAR; PG8_SCHED;
            PG8_STAGE(PG8_SB(1, 1), b3 + hstepB, voffB);
            PG8_WAIT_V(6); PG8_BAR; PG8_MMA(1, 1, At, B1); PG8_BAR;
            }
        }
        if constexpr (ALIGN_EPI) { if (wr == 0) PG8_BAR; }
        if constexpr (!Epi::AFTER_DRAIN) { E(acc, cur, wr, wc, fr, fq); S.done(cur); }
        if (!has_next) break;
#pragma unroll
        for (int a = 0; a < 2; ++a)
#pragma unroll
            for (int b = 0; b < 2; ++b)
#pragma unroll
                for (int m = 0; m < 4; ++m)
#pragma unroll
                    for (int n = 0; n < 2; ++n) acc[a][b][m][n] = (f32x4){0.f, 0.f, 0.f, 0.f};
        cur = nxt; cA = nA; cB = nB; ++ui;
        if constexpr (ALIGN_EPI) { if (wr == 1) PG8_BAR; }
    }
    PG8_WAIT_V(0);
    if constexpr (!ALIGN_EPI) { if (wr == 0) PG8_BAR; }
    PG8_BAR;
#undef PG8_SA
#undef PG8_SB
#undef PG8_STAGE
#undef PG8_LDA
#undef PG8_LDB
#undef PG8_MMA
#undef PG8_WAIT_V
#undef PG8_WAIT_L
#undef PG8_BAR
#undef PG8_SCHED
}
}

namespace att {
constexpr int NW = 8, QBLK = 32, KVBLK = 64;
constexpr float THR = 8.f;
#define SBAR() __builtin_amdgcn_sched_barrier(0)
__device__ __forceinline__ int crow(int r, int hi) { return (r & 3) + 8 * (r >> 2) + 4 * hi; }
__device__ __forceinline__ unsigned cvtpk(float lo, float hi) { unsigned r; asm volatile("v_cvt_pk_bf16_f32 %0, %1, %2" : "=v"(r) : "v"(lo), "v"(hi)); return r; }

struct UnitP {
    const bf16_t* Q; int ldq;
    const bf16_t* Kn; int ldkn;
    const bf16_t* Kp; int ldkp;
    const bf16_t* V; int ldv;
    bf16_t* O; int ldo;
    int base0, n0, base1, NT;
    int masked;
    int kpos1, qpos0;
    int rope;
    int has_sink; float sink;
};

__device__ __forceinline__ void partialSM(f32x16& p0, f32x16& p1, float& m_reg, float& mn, float& alpha, const float C, const float THRS) {
  float pmax = p0[0];
#pragma unroll
  for (int r = 1; r < 16; ++r) pmax = fmaxf(pmax, p0[r]);
#pragma unroll
  for (int r = 0; r < 16; ++r) pmax = fmaxf(pmax, p1[r]);
  { auto rr = __builtin_amdgcn_permlane32_swap(__float_as_uint(pmax), __float_as_uint(pmax), false, false);
    pmax = fmaxf(__uint_as_float(rr[0]), __uint_as_float(rr[1])); }
  if (__builtin_expect(__all(pmax - m_reg <= THRS), 1)) { mn = m_reg; alpha = 1.f; }
  else { mn = fmaxf(m_reg, pmax); alpha = __builtin_amdgcn_exp2f((m_reg - mn) * C); m_reg = mn; }
  float mnC = -mn * C;
#pragma unroll
  for (int r = 0; r < 16; ++r) p0[r] = fmaf(p0[r], C, mnC);
#pragma unroll
  for (int r = 0; r < 16; ++r) p1[r] = fmaf(p1[r], C, mnC);
#pragma unroll
  for (int r = 0; r < 16; ++r) p0[r] = __builtin_amdgcn_exp2f(p0[r]);
}
__device__ __forceinline__ void finishSM(f32x16& p0, f32x16& p1, float alpha, float& l_reg, bf16x8& pa0, bf16x8& pa1, bf16x8& pa2, bf16x8& pa3) {
#pragma unroll
  for (int r = 0; r < 16; ++r) p1[r] = __builtin_amdgcn_exp2f(p1[r]);
  float ps = 0;
#pragma unroll
  for (int r = 0; r < 16; ++r) ps += p0[r];
#pragma unroll
  for (int r = 0; r < 16; ++r) ps += p1[r];
  { auto rr = __builtin_amdgcn_permlane32_swap(__float_as_uint(ps), __float_as_uint(ps), false, false);
    ps = __uint_as_float(rr[0]) + __uint_as_float(rr[1]); }
  l_reg = l_reg * alpha + ps;
#define PK4(P, BASE, OUT) do { unsigned a0 = cvtpk(P[BASE + 0], P[BASE + 1]), a1 = cvtpk(P[BASE + 2], P[BASE + 3]);   \
    unsigned b0 = cvtpk(P[BASE + 4], P[BASE + 5]), b1 = cvtpk(P[BASE + 6], P[BASE + 7]);                              \
    auto r0 = __builtin_amdgcn_permlane32_swap(a0, b0, false, false); auto r1 = __builtin_amdgcn_permlane32_swap(a1, b1, false, false); \
    u32x4 w = {r0[0], r1[0], r0[1], r1[1]}; OUT = *reinterpret_cast<bf16x8*>(&w); } while (0)
  PK4(p0, 0, pa0); PK4(p0, 8, pa1); PK4(p1, 0, pa2); PK4(p1, 8, pa3);
#undef PK4
}
#define KFRAG(d0, B0, B1) do { if ((d0) < 8 * NKN) { const int cb = ((d0) * 16 + hi * 8) * 2; \
      B0 = *reinterpret_cast<const bf16x8*>(Kn + r32 * 256 + (cb ^ swz)); B1 = *reinterpret_cast<const bf16x8*>(Kn + (32 + r32) * 256 + (cb ^ swz)); } \
    else { const int cb = (((d0) - 8 * NKN) * 16 + hi * 8) * 2; \
      B0 = *reinterpret_cast<const bf16x8*>(Kp + r32 * 128 + (cb ^ swz)); B1 = *reinterpret_cast<const bf16x8*>(Kp + (32 + r32) * 128 + (cb ^ swz)); } } while (0)
template <int NQK, int NKN>
__device__ __forceinline__ void qkt_pre(bf16x8& a0, bf16x8& a1, const char* Kn, const char* Kp, int r32, int hi) {
  const int swz = (r32 & 7) << 4; KFRAG(0, a0, a1);
}
template <int NQK, int NKN>
__device__ __forceinline__ void qkt(f32x16& p0, f32x16& p1, bf16x8 a0, bf16x8 a1, const char* Kn, const char* Kp, const bf16x8* qr, int r32, int hi) {
  p0 = f32x16{}; p1 = f32x16{};
  const int swz = (r32 & 7) << 4;
  bf16x8 n0, n1;
#pragma unroll
  for (int d0 = 0; d0 < NQK; ++d0) {
    if (d0 + 1 < NQK) { KFRAG(d0 + 1, n0, n1); }
    __builtin_amdgcn_sched_barrier(0);
    p0 = __builtin_amdgcn_mfma_f32_32x32x16_bf16(a0, qr[d0], p0, 0, 0, 0);
    p1 = __builtin_amdgcn_mfma_f32_32x32x16_bf16(a1, qr[d0], p1, 0, 0, 0);
    __builtin_amdgcn_sched_barrier(0);
    a0 = n0; a1 = n1;
  }
}
#undef KFRAG
__device__ __forceinline__ void glds16(const void* gsrc, unsigned lds_dst) { unsigned keep;
  asm volatile("s_mov_b32 %0, m0\n\ts_mov_b32 m0, %2\n\ts_nop 0\n\tglobal_load_lds_dwordx4 %1, off\n\ts_mov_b32 m0, %0" : "=&s"(keep) : "v"(gsrc), "s"(lds_dst) : "memory"); }
template <int NDV> __device__ __forceinline__ int v_st(int k, int c) { const int kk = (k & ~0xC) | ((k & 4) << 1) | ((k & 8) >> 1); return ((kk >> 3) * NDV + (c >> 5)) * 512 + ((kk & 7) * 32 + (c & 31)) * 2; }
__device__ __forceinline__ int v_rd_base(int lane) { return ((lane & 3) << 3) | (((lane >> 2) & 3) << 6) | (((lane >> 4) & 1) << 5) | (((lane >> 5) & 1) << 8); }
template <int NDV> constexpr int v_rd_off(int d0, int ks, int half) { return d0 * 512 + ks * (NDV * 1024) + half * (NDV * 512); }
template <int OFF> __device__ __forceinline__ s16x4 tr_read(int vb) {
  s16x4 r; asm volatile("ds_read_b64_tr_b16 %0, %1 offset:%2" : "=&v"(r) : "v"(vb), "i"(OFF) : "memory"); return r;
}
template <int NDV, int D0> __device__ __forceinline__ void pv_one(f32x16& od, int vb, bf16x8 pa0, bf16x8 pa1, bf16x8 pa2, bf16x8 pa3) {
  const s16x4 l0 = tr_read<v_rd_off<NDV>(D0, 0, 0)>(vb), h0 = tr_read<v_rd_off<NDV>(D0, 0, 1)>(vb), l1 = tr_read<v_rd_off<NDV>(D0, 1, 0)>(vb), h1 = tr_read<v_rd_off<NDV>(D0, 1, 1)>(vb);
  const s16x4 l2 = tr_read<v_rd_off<NDV>(D0, 2, 0)>(vb), h2 = tr_read<v_rd_off<NDV>(D0, 2, 1)>(vb), l3 = tr_read<v_rd_off<NDV>(D0, 3, 0)>(vb), h3 = tr_read<v_rd_off<NDV>(D0, 3, 1)>(vb);
  asm volatile("s_waitcnt lgkmcnt(0)" ::: "memory"); SBAR();
#define PK(L, H) (bf16x8){L[0], L[1], L[2], L[3], H[0], H[1], H[2], H[3]}
  od = __builtin_amdgcn_mfma_f32_32x32x16_bf16(pa0, PK(l0, h0), od, 0, 0, 0);
  od = __builtin_amdgcn_mfma_f32_32x32x16_bf16(pa1, PK(l1, h1), od, 0, 0, 0);
  od = __builtin_amdgcn_mfma_f32_32x32x16_bf16(pa2, PK(l2, h2), od, 0, 0, 0);
  od = __builtin_amdgcn_mfma_f32_32x32x16_bf16(pa3, PK(l3, h3), od, 0, 0, 0);
#undef PK
}
template <int NDV> __device__ __forceinline__ void pv_all(f32x16* o, int vb, bf16x8 pa0, bf16x8 pa1, bf16x8 pa2, bf16x8 pa3) {
  pv_one<NDV, 0>(o[0], vb, pa0, pa1, pa2, pa3); pv_one<NDV, 1>(o[1], vb, pa0, pa1, pa2, pa3);
  if constexpr (NDV == 4) { pv_one<NDV, 2>(o[2], vb, pa0, pa1, pa2, pa3); pv_one<NDV, 3>(o[3], vb, pa0, pa1, pa2, pa3); }
}
__device__ __forceinline__ void wmask(f32x16& p0, f32x16& p1, int kd  , int hi) {
#pragma unroll
  for (int r = 0; r < 16; ++r) { const int d = kd + crow(r, hi); if (d < -128 || d > 128) p0[r] = -1e30f; if (d + 32 < -128 || d + 32 > 128) p1[r] = -1e30f; }
}

template <int NQK, int NDV, int NKN>
__device__ __forceinline__ void attn_unit(const UnitP& P, char* lds, const float C, const float THRS, const int wave_s) {
  constexpr int KN_B = NKN * 64 * 256, KP_B = 64 * 128, SHM_K = KN_B + KP_B, SHM_V = 64 * NDV * 64, NVC = NDV / 2  ;
  const int tid_ = tid_from_(wave_s);
  const int tid = tid_, lane = tid & 63, r32 = lane & 31, hi = lane >> 5; const int wid = __builtin_amdgcn_readfirstlane(tid >> 6);
  char* V_lds = lds; char* K_lds = lds + 2 * SHM_V;
  float* ws = (float*)(lds + 2 * SHM_V + 2 * SHM_K) + wid * 64; float* li_l = ws; float* al_l = ws + 32;
  const unsigned lds0 = (unsigned)(uintptr_t)lds;
  float m_reg = -1e30f, l_reg = 0; f32x16 o[NDV]; bf16x8 qr[NQK];
#pragma unroll
  for (int d = 0; d < NDV; ++d) o[d] = f32x16{};
  const int qrow = wid * QBLK + r32;
  unsigned offKn[2], offKp, offV[2];
#pragma unroll
  for (int i = 0; i < 2; ++i) { const int q = i * 512 + tid, row = q >> 4, cp = q & 15, c = (cp & 8) | ((cp & 7) ^ (row & 7)); offKn[i] = (unsigned)(row * P.ldkn + c * 8); }
  { const int row = tid >> 3, cp = tid & 7, c = cp ^ (row & 7); offKp = (unsigned)(row * P.ldkp + c * 8); }
#pragma unroll
  for (int i = 0; i < NVC; ++i) { const int q = i * 512 + tid, sub = q >> 5, rem = q & 31, kk = (sub / NDV) * 8 + (rem >> 2), c = (sub % NDV) * 32 + (rem & 3) * 8;
    const int k = (kk & ~0xC) | ((kk & 4) << 1) | ((kk & 8) >> 1); offV[i] = (unsigned)(k * P.ldv + c); }
#define TROW(j) ((j) < P.n0 ? P.base0 + 64 * (j) : P.base1 + 64 * ((j) - P.n0))
#define DMA_K(j, b) do { const int row0_ = TROW(j); const unsigned kd_ = lds0 + 2 * SHM_V + (b) * SHM_K + wid * 1024; \
    if constexpr (NKN == 1) { const bf16_t* s_ = P.Kn + (size_t)row0_ * P.ldkn; glds16(s_ + offKn[0], kd_); glds16(s_ + offKn[1], kd_ + 8192); } \
    glds16(P.Kp + (size_t)row0_ * P.ldkp + offKp, kd_ + KN_B); } while (0)
#define DMA_V(j, b) do { const int row0_ = TROW(j); const unsigned vd_ = lds0 + (b) * SHM_V + wid * 1024; const bf16_t* s_ = P.V + (size_t)row0_ * P.ldv; \
    glds16(s_ + offV[0], vd_); if constexpr (NVC == 2) glds16(s_ + offV[1], vd_ + 8192); } while (0)
#define WAIT_BAR(N) asm volatile("s_waitcnt vmcnt(" #N ") lgkmcnt(0)\n\ts_barrier" ::: "memory")
#define LBAR() asm volatile("s_waitcnt lgkmcnt(0)\n\ts_barrier" ::: "memory")
#define WAIT_BAR_V() do { if constexpr (NVC == 2) WAIT_BAR(2); else WAIT_BAR(1); } while (0)
  DMA_K(0, 0); DMA_V(0, 0); DMA_K(1, 1);
  const bf16_t* Qw = P.Q + (size_t)qrow * P.ldq + hi * 8;
#pragma unroll
  for (int d0 = 0; d0 < NQK; ++d0) qr[d0] = *reinterpret_cast<const bf16x8*>(Qw + d0 * 16);
  if (P.rope) {
    const int t = P.qpos0 + qrow; const int pr = t >> 6, pc = t & 63;
#pragma unroll
    for (int a = 0; a < 2; ++a) {
      const float* tb = ROPE_TAB + ((a ? pc : pr) * 16 + hi * 8) * 2;
      bf16x8 x1 = qr[NQK - 4 + 2 * a], x2 = qr[NQK - 3 + 2 * a];
#pragma unroll
      for (int j = 0; j < 8; ++j) { const float c = tb[2 * j], s = tb[2 * j + 1]; const float f1 = bf2f((unsigned short)x1[j]), f2 = bf2f((unsigned short)x2[j]);
        x1[j] = (short)f2bf(f1 * c - f2 * s); x2[j] = (short)f2bf(f2 * c + f1 * s); }
      qr[NQK - 4 + 2 * a] = x1; qr[NQK - 3 + 2 * a] = x2;
    }
  }
  const int vb0 = (int)lds0 + v_rd_base(lane);
#define RESC(a) do { if (__any((a) < 1.f)) { if (hi == 0) al_l[r32] = (a); asm volatile("s_waitcnt lgkmcnt(0)" ::: "memory"); \
    _Pragma("unroll") for (int d = 0; d < NDV; ++d) _Pragma("unroll") for (int r = 0; r < 16; ++r) o[d][r] *= al_l[crow(r, hi)]; } } while (0)
#define MASK(P0, P1, j) do { if (P.masked && (j) >= P.n0) wmask(P0, P1, P.kpos1 + 64 * ((j) - P.n0) - (P.qpos0 + qrow), hi); } while (0)
#define QKPRE(b) qkt_pre<NQK, NKN>(kf0, kf1, K_lds + (b) * SHM_K, K_lds + (b) * SHM_K + KN_B, r32, hi)
#define QKT(P0, P1, b) qkt<NQK, NKN>(P0, P1, kf0, kf1, K_lds + (b) * SHM_K, K_lds + (b) * SHM_K + KN_B, qr, r32, hi)
  f32x16 pA0, pA1, pB0, pB1; float mnA, mnB, alA, alB; bf16x8 pa0, pa1, pa2, pa3, kf0, kf1; const int NT = P.NT;
  WAIT_BAR(0);
  QKPRE(0); QKT(pA0, pA1, 0); MASK(pA0, pA1, 0); partialSM(pA0, pA1, m_reg, mnA, alA, C, THRS);
  DMA_V(1, 1);
  for (int j = 1; j + 1 < NT; j += 2) {
    DMA_K(j + 1, 0);
    SBAR(); QKPRE(1); SBAR(); finishSM(pA0, pA1, alA, l_reg, pa0, pa1, pa2, pa3); SBAR();
    QKT(pB0, pB1, 1); MASK(pB0, pB1, j); SBAR();
    pv_all<NDV>(o, vb0, pa0, pa1, pa2, pa3); partialSM(pB0, pB1, m_reg, mnB, alB, C, THRS);
    LBAR();
    DMA_V(j + 1, 0);
    RESC(alB);
    WAIT_BAR_V();
    DMA_K(j + 2, 1);
    SBAR(); QKPRE(0); SBAR(); finishSM(pB0, pB1, alB, l_reg, pa0, pa1, pa2, pa3); SBAR();
    QKT(pA0, pA1, 0); MASK(pA0, pA1, j + 1); SBAR();
    pv_all<NDV>(o, vb0 + SHM_V, pa0, pa1, pa2, pa3); partialSM(pA0, pA1, m_reg, mnA, alA, C, THRS);
    LBAR();
    DMA_V(j + 2, 1);
    RESC(alA);
    WAIT_BAR_V();
  }
  SBAR(); QKPRE(1); SBAR(); finishSM(pA0, pA1, alA, l_reg, pa0, pa1, pa2, pa3); SBAR();
  QKT(pB0, pB1, 1); MASK(pB0, pB1, NT - 1); SBAR();
  pv_all<NDV>(o, vb0, pa0, pa1, pa2, pa3); partialSM(pB0, pB1, m_reg, mnB, alB, C, THRS);
  WAIT_BAR(0); RESC(alB);
  finishSM(pB0, pB1, alB, l_reg, pa0, pa1, pa2, pa3); SBAR();
  pv_all<NDV>(o, vb0 + SHM_V, pa0, pa1, pa2, pa3);
  if (P.has_sink) l_reg += __builtin_amdgcn_exp2f(P.sink * 1.4426950408889634f - m_reg * C);
  if (hi == 0) li_l[r32] = l_reg; asm volatile("s_waitcnt lgkmcnt(0)" ::: "memory");
  float rli[16];
#pragma unroll
  for (int r = 0; r < 16; ++r) rli[r] = __builtin_amdgcn_rcpf(li_l[crow(r, hi)]);
  bf16_t* Ow = P.O + (size_t)(wid * QBLK) * P.ldo;
#pragma unroll
  for (int r = 0; r < 16; ++r) { const int orow = crow(r, hi);
#pragma unroll
    for (int d0 = 0; d0 < NDV; ++d0) Ow[(size_t)orow * P.ldo + d0 * 32 + r32] = f2bf(o[d0][r] * rli[r]); }
  LBAR();
#undef TROW
#undef DMA_K
#undef DMA_V
#undef WAIT_BAR
#undef WAIT_BAR_V
#undef LBAR
#undef RESC
#undef MASK
#undef QKT
#undef QKPRE
}
#undef SBAR
}

struct Ctx {
    unsigned char* lds; LAS unsigned char* lds3;
    int tid, lane, wave, G, bx, vcu;
};

#define LDS_BAR() asm volatile("s_waitcnt lgkmcnt(0)\n\ts_barrier" ::: "memory")
__device__ __forceinline__ Ctx make_ctx(unsigned char* lds, const int wave_s) {
    Ctx T; const int tid_ = tid_from_(wave_s);
    T.lds = lds; T.lds3 = (LAS unsigned char*)lds; T.tid = tid_; T.lane = tid_ & 63; T.wave = __builtin_amdgcn_readfirstlane(tid_ >> 6);
    T.G = gridDim.x; T.bx = blockIdx.x; T.vcu = (T.G % 8 == 0) ? (T.bx % 8) * (T.G / 8) + T.bx / 8 : T.bx;
    return T;
}
__device__ __forceinline__ void transpose_item(const float* W, int K, int N, bf16_t* WT, LAS float* scr, int item, int lane) {
    const int nblk = N / 32, kb = item / nblk, nb = item % nblk, k0 = 64 * kb, n0 = 32 * nb;
    float wv[32];
#pragma unroll
    for (int i = 0; i < 32; ++i) wv[i] = W[(size_t)(k0 + 2 * i + (lane >> 5)) * N + n0 + (lane & 31)];
#pragma unroll
    for (int i = 0; i < 32; ++i) scr[(2 * i + (lane >> 5)) * 33 + (lane & 31)] = wv[i];
    asm volatile("s_waitcnt lgkmcnt(0)" ::: "memory");
    const int c = lane & 7;
#pragma unroll
    for (int j = 0; j < 4; ++j) { const int n = (lane >> 3) + 8 * j; const LAS float* s = scr + (8 * c) * 33 + n;
        u32x4 o; o.x = cvt_pk_bf16(s[0 * 33], s[1 * 33]); o.y = cvt_pk_bf16(s[2 * 33], s[3 * 33]); o.z = cvt_pk_bf16(s[4 * 33], s[5 * 33]); o.w = cvt_pk_bf16(s[6 * 33], s[7 * 33]);
        *(u32x4*)(WT + (size_t)(n0 + n) * K + k0 + 8 * c) = o; }
    asm volatile("s_waitcnt lgkmcnt(0)" ::: "memory");
}

struct Params { const float* in[23]; float* out; unsigned char* ws; int ph_lo, ph_hi; };
enum { I_X = 0, I_C, I_CTX, I_CCTX, I_ADAW, I_ADAB, I_NMIX, I_NMLP, I_WIN, I_QN, I_WUQ, I_KVN, I_WUKV, I_SINK, I_CONVW, I_CONVB, I_LNG, I_LNB, I_ONORM, I_WOUT, I_W1, I_W2, I_FNORM };

__device__ __forceinline__ void prologue_phase(const Ctx& T, const Params& p) {
    float* mod = (float*)(p.ws + WS_MOD);
    {
        float* sil = (float*)T.lds;
        float* red = sil + 5 * DM;
        for (int i = T.tid; i < 5 * DM; i += 512) { const int r = i >> 11, k = i & (DM - 1); const float v = r < 4 ? p.in[I_C][r * DM + k] : p.in[I_CCTX][k]; sil[i] = v * sigmoidf_(v); }
        __syncthreads();
        for (int item = T.bx; item < 2 * 96; item += T.G) {
            const int l = item / 96, cb = item % 96, col = cb * 128 + 2 * T.lane;
            const float* W = p.in[I_ADAW] + (size_t)l * DM * MODW + col;
            float a0[5], a1[5];
#pragma unroll
            for (int r = 0; r < 5; ++r) { a0[r] = 0.f; a1[r] = 0.f; }
            const int k0 = T.wave * 256;
            for (int k = k0; k < k0 + 256; k += 16) {
                f32x2 w[16];
#pragma unroll
                for (int i = 0; i < 16; ++i) w[i] = *(const f32x2*)(W + (size_t)(k + i) * MODW);
#pragma unroll
                for (int i = 0; i < 16; ++i)
#pragma unroll
                    for (int r = 0; r < 5; ++r) { const float s = sil[r * DM + k + i]; a0[r] += s * w[i].x; a1[r] += s * w[i].y; }
            }
#pragma unroll
            for (int r = 0; r < 5; ++r) { red[(T.wave * 5 + r) * 128 + 2 * T.lane] = a0[r]; red[(T.wave * 5 + r) * 128 + 2 * T.lane + 1] = a1[r]; }
            __syncthreads();
            for (int i = T.tid; i < 5 * 128; i += 512) { const int r = i >> 7, cc = i & 127; float s = 0.f;
#pragma unroll
                for (int w = 0; w < 8; ++w) s += red[(w * 5 + r) * 128 + cc];
                mod[(size_t)(l * 5 + r) * MODW + cb * 128 + cc] = s + p.in[I_ADAB][l * MODW + cb * 128 + cc]; }
            __syncthreads();
        }
    }
    {
        LAS float* scr = (LAS float*)(T.lds3 + T.wave * 16384);
        const int gw = T.bx * 8 + T.wave, NGW = T.G * 8;
        constexpr int I_IN = (DM / 64) * (INW / 32), I_UQ = (512 / 64) * (QW / 32), I_UKV = (512 / 64) * (KVW / 32), I_OUT = (DM / 64) * (DM / 32), I_1 = (DM / 64) * (FF / 32), I_2 = (FF / 64) * (DM / 32);
        constexpr int PER_L = I_IN + I_UQ + I_UKV + I_OUT + I_1 + I_2;
        for (int it = gw; it < 2 * PER_L; it += NGW) {
            const int l = it / PER_L; int r = it % PER_L;
            unsigned char* wl = p.ws + WS_WL + (size_t)l * WL_SIZE;
            if (r < I_IN) { transpose_item(p.in[I_WIN] + (size_t)l * DM * INW, DM, INW, (bf16_t*)(wl + WL_IN), scr, r, T.lane); continue; } r -= I_IN;
            if (r < I_UQ) { transpose_item(p.in[I_WUQ] + (size_t)l * 512 * QW, 512, QW, (bf16_t*)(wl + WL_UQ), scr, r, T.lane); continue; } r -= I_UQ;
            if (r < I_UKV) { transpose_item(p.in[I_WUKV] + (size_t)l * 512 * KVW, 512, KVW, (bf16_t*)(wl + WL_UKV), scr, r, T.lane); continue; } r -= I_UKV;
            if (r < I_OUT) { transpose_item(p.in[I_WOUT] + (size_t)l * DM * DM, DM, DM, (bf16_t*)(wl + WL_OUT), scr, r, T.lane); continue; } r -= I_OUT;
            if (r < I_1) { transpose_item(p.in[I_W1] + (size_t)l * DM * FF, DM, FF, (bf16_t*)(wl + WL_W1), scr, r, T.lane); continue; } r -= I_1;
            transpose_item(p.in[I_W2] + (size_t)l * FF * DM, FF, DM, (bf16_t*)(wl + WL_W2), scr, r, T.lane);
        }
        const int gt = T.bx * 512 + T.tid, NGT = T.G * 512;
        constexpr int PADV = (INWP - INW) * DM * 2 / 16;
        for (int i = gt; i < 2 * PADV; i += NGT) { const int l = i / PADV, j = i % PADV;
            *(u32x4*)(p.ws + WS_WL + (size_t)l * WL_SIZE + WL_IN + (size_t)INW * DM * 2 + (size_t)j * 16) = (u32x4){0u, 0u, 0u, 0u}; }
    }
}

template <int TR, bool SLABS>
__device__ __forceinline__ void norm_tile(const Ctx& T, float* red, const float* xb  , const f32x4 gs, const f32x4 sh4, bf16_t* ob  ,
                                          const float* sb  , const f32x4 gt, float* xo  ) {
    f32x4 v[TR];
#pragma unroll
    for (int i = 0; i < TR; ++i) v[i] = *(const f32x4*)(xb + (size_t)i * DM);
    if constexpr (SLABS) {
        f32x4 sv[TR][8];
#pragma unroll
        for (int i = 0; i < TR; ++i)
#pragma unroll
            for (int sl = 0; sl < 8; ++sl) sv[i][sl] = *(const f32x4*)(sb + ((size_t)sl * NCTXR + i) * DM);
#pragma unroll
        for (int i = 0; i < TR; ++i) { const f32x4 a = ((sv[i][0] + sv[i][1]) + (sv[i][2] + sv[i][3])) + ((sv[i][4] + sv[i][5]) + (sv[i][6] + sv[i][7]));
            v[i] += gt * a; *(f32x4*)(xo + (size_t)i * DM) = v[i]; }
    }
    { float ss[TR];
#pragma unroll
      for (int i = 0; i < TR; ++i) ss[i] = (v[i].x * v[i].x + v[i].y * v[i].y) + (v[i].z * v[i].z + v[i].w * v[i].w);
      wave_sum_n<TR>(ss, T.lane);
#pragma unroll
      for (int i = 0; i < TR; ++i) if (T.lane == i) red[i * 8 + T.wave] = ss[i]; }
    LDS_BAR();
#pragma unroll
    for (int i = 0; i < TR; ++i) { const f32x4 a = *(const f32x4*)(red + i * 8), b = *(const f32x4*)(red + i * 8 + 4);
        const float rstd = 1.0f / sqrtf((((a.x + a.y) + (a.z + a.w)) + ((b.x + b.y) + (b.z + b.w))) * (1.0f / DM) + EPS);
        const f32x4 y = v[i] * rstd * gs + sh4;
        u32x2 w; w.x = cvt_pk_bf16(y.x, y.y); w.y = cvt_pk_bf16(y.z, y.w); *(u32x2*)(ob + (size_t)i * DM) = w; }
    LDS_BAR();
}
__device__ __forceinline__ void modnorm_phase(const Ctx& T, const float* src_lat, const float* src_ctx, int nrows, const float* gw, const float* modl, int sh_off, int sc_off, bf16_t* out, const float* slab, const float* gate, float* xout) {
    float* red = (float*)T.lds;
    const int col = 4 * T.tid;
    const f32x4 g4 = *(const f32x4*)(gw + col);
    for (int t = T.bx; t < NLAT / 16; t += T.G) {
        const int r0 = t * 16; const float* mr = modl + (size_t)(r0 >> 12) * MODW + col;
        const f32x4 gs = g4 * (*(const f32x4*)(mr + sc_off) + 1.0f), sh4 = *(const f32x4*)(mr + sh_off);
        norm_tile<16, false>(T, red, src_lat + (size_t)r0 * DM + col, gs, sh4, out + (size_t)r0 * DM + col, nullptr, gs, nullptr);
    }
    if (nrows > NLAT) {
        const float* mr = modl + (size_t)4 * MODW + col;
        const f32x4 gs = g4 * (*(const f32x4*)(mr + sc_off) + 1.0f), sh4 = *(const f32x4*)(mr + sh_off);
        for (int t = T.bx; t < NCTXR / 4; t += T.G) {
            const int rc = t * 4;
            if (slab) { const f32x4 gt = *(const f32x4*)(gate + (size_t)4 * MODW + col);
                norm_tile<4, true>(T, red, src_ctx + (size_t)rc * DM + col, gs, sh4, out + (size_t)(NLAT + rc) * DM + col, slab + (size_t)rc * DM + col, gt, xout + (size_t)(NLAT + rc) * DM + col); }
            else norm_tile<4, false>(T, red, src_ctx + (size_t)rc * DM + col, gs, sh4, out + (size_t)(NLAT + rc) * DM + col, nullptr, gs, nullptr);
        }
    }
}
__device__ __forceinline__ void finalnorm_phase(const Ctx& T, const float* x, const float* gw, float* out) {
    constexpr int TR = 16;
    float* red = (float*)T.lds;
    const int col = 4 * T.tid;
    const f32x4 g4 = *(const f32x4*)(gw + col);
    for (int t = T.bx; t < NLAT / TR; t += T.G) {
        const int r0 = t * TR;
        f32x4 v[TR];
#pragma unroll
        for (int i = 0; i < TR; ++i) v[i] = *(const f32x4*)(x + (size_t)(r0 + i) * DM + col);
        { float ss[TR];
#pragma unroll
          for (int i = 0; i < TR; ++i) ss[i] = (v[i].x * v[i].x + v[i].y * v[i].y) + (v[i].z * v[i].z + v[i].w * v[i].w);
          wave_sum_n<TR>(ss, T.lane);
#pragma unroll
          for (int i = 0; i < TR; ++i) if (T.lane == i) red[i * 8 + T.wave] = ss[i]; }
        LDS_BAR();
#pragma unroll
        for (int i = 0; i < TR; ++i) { const f32x4 a = *(const f32x4*)(red + i * 8), b = *(const f32x4*)(red + i * 8 + 4);
            const float rstd = 1.0f / sqrtf((((a.x + a.y) + (a.z + a.w)) + ((b.x + b.y) + (b.z + b.w))) * (1.0f / DM) + EPS);
            *(f32x4*)(out + (size_t)(r0 + i) * DM + col) = v[i] * rstd * g4; }
        LDS_BAR();
    }
}

__device__ __forceinline__ void unpack8(const u32x4 w, float* f) { f[0] = bflo(w.x); f[1] = bfhi(w.x); f[2] = bflo(w.y); f[3] = bfhi(w.y); f[4] = bflo(w.z); f[5] = bfhi(w.z); f[6] = bflo(w.w); f[7] = bfhi(w.w); }
__device__ __forceinline__ u32x4 pack8(const float* f) { u32x4 w; w.x = cvt_pk_bf16(f[0], f[1]); w.y = cvt_pk_bf16(f[2], f[3]); w.z = cvt_pk_bf16(f[4], f[5]); w.w = cvt_pk_bf16(f[6], f[7]); return w; }

__device__ __forceinline__ void prep_phase(const Ctx& T, bf16_t* U, const float* qn, const float* kvn) {
    constexpr int RR = 4;
    const int gwv = T.bx * 8 + T.wave, NGW = T.G * 8, lane = T.lane;
    float gq[8], gk[8];
#pragma unroll
    for (int j = 0; j < 8; ++j) { gq[j] = qn[8 * lane + j]; gk[j] = kvn[8 * lane + j]; }
    const int a = (lane >> 4) & 1, fi = lane & 15;
    for (int r0 = gwv * RR; r0 < NROW; r0 += NGW * RR) {
        u32x4 vq[RR], vk[RR], va[RR], vg[RR]; unsigned short x1a[RR], x2a[RR], x1b[RR], x2b[RR]; f32x2 rcs[RR];
        const bool lat = r0 < NLAT;
        const int ia = U_AKR + 32 * a + fi, ib = U_BK + (lane >> 5) * 64 + 32 * a + fi;
#pragma unroll
        for (int i = 0; i < RR; ++i) { const bf16_t* ur = U + (size_t)(r0 + i) * INWP;
            vq[i] = ((const u32x4*)(ur + U_AQ))[lane]; vk[i] = ((const u32x4*)(ur + U_AKV))[lane]; va[i] = ((const u32x4*)(ur + U_CA))[lane]; vg[i] = ((const u32x4*)(ur + U_CG))[lane];
            if (lat) { x1a[i] = ur[ia]; x2a[i] = ur[ia + 16]; x1b[i] = ur[ib]; x2b[i] = ur[ib + 16];
                const int t = (r0 + i) & (SEQ - 1), pos = a ? (t & 63) : (t >> 6); rcs[i] = *(const f32x2*)(ROPE_TAB + (pos * 16 + fi) * 2); } }
        float ssq[2 * RR];
#pragma unroll
        for (int i = 0; i < RR; ++i) { float f[8]; unpack8(vq[i], f); float s = 0.f;
#pragma unroll
            for (int j = 0; j < 8; ++j) s += f[j] * f[j];
            ssq[2 * i] = s; unpack8(vk[i], f); s = 0.f;
#pragma unroll
            for (int j = 0; j < 8; ++j) s += f[j] * f[j];
            ssq[2 * i + 1] = s; }
        wave_sum_n<2 * RR>(ssq, lane);
#pragma unroll
        for (int i = 0; i < RR; ++i) { bf16_t* ur = U + (size_t)(r0 + i) * INWP; float f[8];
            { unpack8(vq[i], f); const float rstd = 1.0f / sqrtf(ssq[2 * i] * (1.0f / 512.0f) + EPS);
#pragma unroll
              for (int j = 0; j < 8; ++j) f[j] = f[j] * rstd * gq[j];
              ((u32x4*)(ur + U_AQ))[lane] = pack8(f); }
            { unpack8(vk[i], f); const float rstd = 1.0f / sqrtf(ssq[2 * i + 1] * (1.0f / 512.0f) + EPS);
#pragma unroll
              for (int j = 0; j < 8; ++j) f[j] = f[j] * rstd * gk[j];
              ((u32x4*)(ur + U_AKV))[lane] = pack8(f); }
            if (lat) {
                const float c = rcs[i].x, s = rcs[i].y;
                if (lane < 32) { const float x1 = bf2f(x1a[i]), x2 = bf2f(x2a[i]); ur[ia] = f2bf(x1 * c - x2 * s); ur[ia + 16] = f2bf(x2 * c + x1 * s); }
                { const float x1 = bf2f(x1b[i]), x2 = bf2f(x2b[i]); ur[ib] = f2bf(x1 * c - x2 * s); ur[ib + 16] = f2bf(x2 * c + x1 * s); }
            }
            { float fg[8]; unpack8(va[i], f); unpack8(vg[i], fg);
#pragma unroll
              for (int j = 0; j < 8; ++j) f[j] = f[j] * sigmoidf_(fg[j]);
              ((u32x4*)(ur + U_CA))[lane] = pack8(f); }
        }
    }
}

__device__ __forceinline__ void mergenorm_phase(const Ctx& T, bf16_t* MIX, const float* on, int nrows) {
    constexpr int RR = 4;
    const int gwv = T.bx * 8 + T.wave, NGW = T.G * 8, lane = T.lane;
    float g0[8], g1[8], g2[8], g3[8];
#pragma unroll
    for (int j = 0; j < 8; ++j) { g0[j] = on[8 * lane + j]; g1[j] = on[512 + 8 * lane + j]; g2[j] = on[1024 + 8 * lane + j]; g3[j] = on[1536 + 8 * lane + j]; }
    for (int r0 = gwv * RR; r0 < nrows; r0 += NGW * RR) {
        u32x4 v0[RR], v1[RR], v2[RR], v3[RR];
#pragma unroll
        for (int i = 0; i < RR; ++i) { const u32x4* mr = (const u32x4*)(MIX + (size_t)(r0 + i) * MIXW) + lane; v0[i] = mr[0]; v1[i] = mr[64]; v2[i] = mr[128]; v3[i] = mr[192]; }
        float ssq[3 * RR];
#pragma unroll
        for (int i = 0; i < RR; ++i) { float f[8], h[8]; unpack8(v0[i], f); unpack8(v1[i], h); float s = 0.f;
#pragma unroll
            for (int j = 0; j < 8; ++j) s += f[j] * f[j] + h[j] * h[j];
            ssq[3 * i] = s; unpack8(v2[i], f); s = 0.f;
#pragma unroll
            for (int j = 0; j < 8; ++j) s += f[j] * f[j];
            ssq[3 * i + 1] = s; unpack8(v3[i], f); s = 0.f;
#pragma unroll
            for (int j = 0; j < 8; ++j) s += f[j] * f[j];
            ssq[3 * i + 2] = s; }
        wave_sum_n<3 * RR>(ssq, lane);
#pragma unroll
        for (int i = 0; i < RR; ++i) { u32x4* mr = (u32x4*)(MIX + (size_t)(r0 + i) * MIXW) + lane; float f[8], h[8];
            { unpack8(v0[i], f); unpack8(v1[i], h); const float rstd = 1.0f / sqrtf(ssq[3 * i] * (1.0f / 1024.0f) + EPS);
#pragma unroll
              for (int j = 0; j < 8; ++j) { f[j] = f[j] * rstd * g0[j]; h[j] = h[j] * rstd * g1[j]; }
              mr[0] = pack8(f); mr[64] = pack8(h); }
            { unpack8(v2[i], f); const float rstd = 1.0f / sqrtf(ssq[3 * i + 1] * (1.0f / 512.0f) + EPS);
#pragma unroll
              for (int j = 0; j < 8; ++j) f[j] = f[j] * rstd * g2[j];
              mr[128] = pack8(f); }
            { unpack8(v3[i], f); const float rstd = 1.0f / sqrtf(ssq[3 * i + 2] * (1.0f / 512.0f) + EPS);
#pragma unroll
              for (int j = 0; j < 8; ++j) f[j] = f[j] * rstd * g3[j];
              mr[192] = pack8(f); }
        }
    }
}

__device__ __forceinline__ void conv_phase(const Ctx& T, const bf16_t* U, bf16_t* MIX, const float* cw, const float* cb, const float* lng, const float* lnb, int nitems) {
    constexpr int CR = 16, NL = CR + 30;
    const int c = T.tid;
    float w[31];
#pragma unroll
    for (int k = 0; k < 31; ++k) w[k] = cw[k * 512 + c];
    const float bias = cb[c], g = lng[c], b = lnb[c];
    float* red = (float*)T.lds;
    unsigned short hv[NL], hn[NL];
#define CONV_LOAD(dst, it) do { const int r0_ = (it) * CR; int s0_, s1_; \
        if (r0_ < NLAT) { s0_ = r0_ & ~(SEQ - 1); s1_ = s0_ + SEQ; } else { s0_ = NLAT + ((r0_ - NLAT) & ~(CTXL - 1)); s1_ = s0_ + CTXL; } \
        _Pragma("unroll") for (int j = 0; j < NL; ++j) { int rr = r0_ - 15 + j; rr = rr < s0_ ? s0_ : (rr >= s1_ ? s1_ - 1 : rr); dst[j] = U[(size_t)rr * INWP + U_CA + c]; } } while (0)
    int item = T.bx; asm volatile("" : "+s"(item));
    if (item < nitems) CONV_LOAD(hv, item);
    while (item < nitems) {
        const int nxt = item + T.G;
        if (nxt < nitems) CONV_LOAD(hn, nxt);
        const int r0 = item * CR;
        int seg0, seg1;
        if (r0 < NLAT) { seg0 = r0 & ~(SEQ - 1); seg1 = seg0 + SEQ; } else { seg0 = NLAT + ((r0 - NLAT) & ~(CTXL - 1)); seg1 = seg0 + CTXL; }
        float acc[CR];
#pragma unroll
        for (int i = 0; i < CR; ++i) acc[i] = bias;
#pragma unroll
        for (int j = 0; j < NL; ++j) {
            const int rr = r0 - 15 + j;
            const float v = (rr >= seg0 && rr < seg1) ? bf2f(hv[j]) : 0.f;
#pragma unroll
            for (int i = 0; i < CR; ++i) { const int k = j - i; if (k >= 0 && k < 31) acc[i] += w[k] * v; }
        }
        float s[2 * CR];
#pragma unroll
        for (int i = 0; i < CR; ++i) { s[i] = acc[i]; s[CR + i] = acc[i] * acc[i]; }
        wave_sum_n<2 * CR>(s, T.lane);
#pragma unroll
        for (int q = 0; q < 2 * CR; ++q) if (T.lane == q) red[T.wave * 2 * CR + q] = s[q];
        LDS_BAR();
#pragma unroll
        for (int i = 0; i < CR; ++i) {
            float sm = 0.f, sq = 0.f;
#pragma unroll
            for (int wv = 0; wv < 8; ++wv) { sm += red[wv * 2 * CR + i]; sq += red[wv * 2 * CR + CR + i]; }
            const float mean = sm * (1.0f / 512.0f); const float var = fmaxf(sq * (1.0f / 512.0f) - mean * mean, 0.f);
            const float y = (acc[i] - mean) * __builtin_amdgcn_rsqf(var + EPS) * g + b;
            MIX[(size_t)(r0 + i) * MIXW + 1536 + c] = f2bf(y * sigmoidf_(y));
        }
        LDS_BAR();
#pragma unroll
        for (int j = 0; j < NL; ++j) hv[j] = hn[j];
        item = nxt;
    }
#undef CONV_LOAD
}

#define XB_TMO      128
#define XB_XCNT(j)  (256  + 64 * (j))
#define XB_XSUB(j)  (1280 + 64 * (j))
#define XB_XGEN(j)  (2304 + 64 * (j))
#define XB_TOP      3328
#define XB_TOPGEN   3392
#define XCD_BAR_WORDS 3456
#define XB_SPIN_CAP (1u << 20)
__device__ __forceinline__ unsigned xb_ld(unsigned* p)              { return __hip_atomic_load(p, __ATOMIC_RELAXED, __HIP_MEMORY_SCOPE_AGENT); }
__device__ __forceinline__ unsigned xb_add(unsigned* p, unsigned v) { return __hip_atomic_fetch_add(p, v, __ATOMIC_RELAXED, __HIP_MEMORY_SCOPE_AGENT); }
__device__ __forceinline__ unsigned xb_xcc_id() { return (unsigned)__builtin_amdgcn_s_getreg((3 << 11) | 20) & 0xFu; }
#define XB_SPIN(cond, bar) do { unsigned _sp = 0; while (cond) { __builtin_amdgcn_s_sleep(1); \
    if ((++_sp & 255u) == 0u) { if (xb_ld(&(bar)[XB_TMO])) break; if (_sp > XB_SPIN_CAP) { atomicAdd(&(bar)[XB_TMO], 1u); break; } } } } while (0)
struct XcdBarrier { unsigned* bar; unsigned x; volatile LAS unsigned* st; };
__device__ __forceinline__ XcdBarrier xcd_barrier_post(unsigned* bar, volatile LAS unsigned* st, const int tid) {
    XcdBarrier b; b.bar = bar; b.x = xb_xcc_id(); b.st = st;
    if (tid == 0) (void)xb_add(&bar[XB_XCNT(b.x)], 1u);
    return b;
}
__device__ __forceinline__ void xcd_barrier_complete(unsigned* bar, unsigned x, unsigned& nloc, unsigned& nx) {
    const unsigned G = gridDim.x * gridDim.y * gridDim.z;
    unsigned sum, cnt, mine, sp = 0u;
    for (;;) {
        sum = 0u; cnt = 0u; mine = 0u;
#pragma unroll
        for (unsigned j = 0; j < 16; ++j) { const unsigned c = xb_ld(&bar[XB_XCNT(j)]); sum += c; cnt += (c > 0u) ? 1u : 0u; mine = (j == x) ? c : mine; }
        if (sum == G) break;
        __builtin_amdgcn_s_sleep(1);
        if ((++sp & 255u) == 0u) { if (xb_ld(&bar[XB_TMO])) break; if (sp > XB_SPIN_CAP) { atomicAdd(&bar[XB_TMO], 1u); break; } }
    }
    nloc = mine > 0u ? mine : 1u; nx = cnt > 0u ? cnt : 1u;
}
__device__ __forceinline__ void xcd_barrier(const XcdBarrier& b, const int tid) {
    asm volatile("s_waitcnt vmcnt(0)" ::: "memory");
    __syncthreads();
    if (tid == 0) {
        unsigned* bar = b.bar;
        __builtin_amdgcn_s_waitcnt(0);
        unsigned nloc = b.st[0], nx = b.st[1];
        if (nloc == 0u) { xcd_barrier_complete(bar, b.x, nloc, nx); b.st[0] = nloc; b.st[1] = nx; }
        const unsigned old = xb_add(&bar[XB_XSUB(b.x)], 1u);
        const unsigned gen = old / nloc;
        if (old + 1u == (gen + 1u) * nloc) {
            __builtin_amdgcn_fence(__ATOMIC_RELEASE, "agent");
            asm volatile("s_waitcnt vmcnt(0)" ::: "memory");
            const unsigned og = xb_add(&bar[XB_TOP], 1u);
            const unsigned tg = og / nx;
            if (og + 1u == (tg + 1u) * nx) xb_add(&bar[XB_TOPGEN], 1u);
            else XB_SPIN(xb_ld(&bar[XB_TOPGEN]) == tg, bar);
            __builtin_amdgcn_fence(__ATOMIC_ACQUIRE, "agent");
            xb_add(&bar[XB_XGEN(b.x)], 1u);
            asm volatile("s_waitcnt vmcnt(0)" ::: "memory");
        } else {
            XB_SPIN(xb_ld(&bar[XB_XGEN(b.x)]) == gen, bar);
            __builtin_amdgcn_fence(__ATOMIC_ACQUIRE, "agent");
            asm volatile("s_waitcnt vmcnt(0)" ::: "memory");
        }
    }
    __syncthreads();
}

#ifndef PH_MASK
#define PH_MASK 0xFFFF
#endif
#ifndef DUP_MASK
#define DUP_MASK 0
#endif
#ifndef DUP_SUB
#define DUP_SUB 0
#endif
#ifndef DUP_BAR
#define DUP_BAR 0
#endif
#ifndef DUP_L
#define DUP_L 3
#endif
__global__ void __launch_bounds__(512, 2) mega_fwd(Params p) {
    extern __shared__ __attribute__((aligned(16))) unsigned char lds[];
    cg::grid_group grid = cg::this_grid();
    unsigned char* ws = p.ws;
    float* mod = (float*)(ws + WS_MOD);
    float* XB = (float*)(ws + WS_X);
    bf16_t* HN = (bf16_t*)(ws + WS_HN); bf16_t* U = (bf16_t*)(ws + WS_U); bf16_t* QB = (bf16_t*)(ws + WS_Q); bf16_t* KVB = (bf16_t*)(ws + WS_KV);
    bf16_t* MIX = (bf16_t*)(ws + WS_MIX); bf16_t* ACT = (bf16_t*)(ws + WS_ACT); float* SLAB = (float*)(ws + WS_SLAB);
    const int wave_s = __builtin_amdgcn_readfirstlane((int)threadIdx.x >> 6);
    { volatile LAS unsigned* m = (volatile LAS unsigned*)((LAS unsigned char*)lds + 131072); const int t0 = tid_from_(wave_s); if (t0 < 64) m[t0] = 0u; }
    __syncthreads();
    if (p.ph_hi - p.ph_lo > 1) (void)xcd_barrier_post((unsigned*)(ws + WS_CTL), (volatile LAS unsigned*)((LAS unsigned char*)lds + 131072) + 8, tid_from_(wave_s));
    int ph = 0; int l_ = 0;
#define RUN(k) ((k) >= p.ph_lo && (k) < p.ph_hi)
#define GBAR() do { XcdBarrier xb_; xb_.bar = (unsigned*)(p.ws + WS_CTL); xb_.x = xb_xcc_id(); xb_.st = (volatile LAS unsigned*)((LAS unsigned char*)lds + 131072) + 8; xcd_barrier(xb_, tid_from_(wave_s)); } while (0)
#define SEAM() do { if (ph >= p.ph_lo && ph + 1 < p.ph_hi) { if (p.ph_lo < 0) grid.sync();   for (int rb_ = 0; rb_ <= DUP_BAR; ++rb_) { XcdBarrier xb_; xb_.bar = (unsigned*)(p.ws + WS_CTL); xb_.x = xb_xcc_id(); xb_.st = (volatile LAS unsigned*)((LAS unsigned char*)lds + 131072) + 8; xcd_barrier(xb_, tid_from_(wave_s)); } } ++ph; } while (0)

    if (((PH_MASK >> 0) & 1) && RUN(ph)) { for (int rep_ = 0; rep_ < 1 + ((DUP_MASK >> 0) & 1) * ((DUP_L >> l_) & 1); ++rep_) { if (rep_) GBAR(); { const Ctx T = make_ctx(lds, wave_s); prologue_phase(T, p); } } }
    SEAM();

    for (int l = 0; l < DEPTH; ++l) { l_ = l;
        const unsigned char* wl = ws + WS_WL + (size_t)l * WL_SIZE;
        const float* modl = mod + (size_t)l * 5 * MODW;
        const float* res_lat = l == 0 ? p.in[I_X] : XB;
        const float* res_ctx = l == 0 ? p.in[I_CTX] : XB + (size_t)NLAT * DM;
        const int mrows = l == 0 ? NROW : NLAT;
        if (((PH_MASK >> 1) & 1) && RUN(ph)) { for (int rep_ = 0; rep_ < 1 + ((DUP_MASK >> 1) & 1) * ((DUP_L >> l_) & 1); ++rep_) { if (rep_) GBAR(); { const Ctx T = make_ctx(lds, wave_s); modnorm_phase(T, res_lat, res_ctx, NROW, p.in[I_NMIX] + l * DM, modl, 0 * DM, 1 * DM, HN, l == 1 ? SLAB : nullptr, mod + 5 * DM, XB); } } }
        SEAM();
        if (((PH_MASK >> 2) & 1) && RUN(ph)) { for (int rep_ = 0; rep_ < 1 + ((DUP_MASK >> 2) & 1) * ((DUP_L >> l_) & 1); ++rep_) { if (rep_) GBAR(); { const Ctx T = make_ctx(lds, wave_s);  pg8::Gemm g{HN, (const bf16_t*)(wl + WL_IN), NROW, INWP, DM, DM}; pg8::StaticOrder S; S.init(NROW, INWP, T.G, T.bx, DM);
            pg8::EpiBf16<0> E{U, INWP}; pg8::gemm_phase<pg8::EpiBf16<0>, pg8::StaticOrder, true, true>(T.lds3, g, S, E, wave_s); } } }
        SEAM();
        if (((PH_MASK >> 3) & 1) && RUN(ph)) { for (int rep_ = 0; rep_ < 1 + ((DUP_MASK >> 3) & 1) * ((DUP_L >> l_) & 1); ++rep_) { if (rep_) GBAR(); { const Ctx T = make_ctx(lds, wave_s); prep_phase(T, U, p.in[I_QN] + l * 512, p.in[I_KVN] + l * 512); } } }
        SEAM();
        if (((PH_MASK >> 4) & 1) && RUN(ph)) { for (int rep_ = 0; rep_ < 1 + ((DUP_MASK >> 4) & 1) * ((DUP_L >> l_) & 1); ++rep_) { if (rep_) GBAR(); { const Ctx T = make_ctx(lds, wave_s);
            for (int gi = 0; gi < 2; ++gi) {
                const int Mg = gi == 0 ? mrows : NROW, Ng = gi == 0 ? QW : KVW;
                pg8::Gemm g{U + (gi == 0 ? U_AQ : U_AKV), (const bf16_t*)(wl + (gi == 0 ? WL_UQ : WL_UKV)), Mg, Ng, 512, INWP}; pg8::StaticOrder S; S.init(Mg, Ng, T.G, T.bx, 512);
                pg8::EpiBf16<0> E{gi == 0 ? QB : KVB, Ng}; pg8::gemm_phase<pg8::EpiBf16<0>, pg8::StaticOrder, true, true>(T.lds3, g, S, E, wave_s);
            }
        } } }
        SEAM();
        if (((PH_MASK >> 5) & 1) && RUN(ph)) { for (int rep_ = 0; rep_ < 1 + ((DUP_MASK >> 5) & 1) * ((DUP_L >> l_) & 1); ++rep_) { if (rep_) GBAR(); { const Ctx T = make_ctx(lds, wave_s);
            const float CA = MLA_SCALE * 1.4426950408889634f, CB = SWA_SCALE * 1.4426950408889634f;
            const int nu = l == 0 ? 544 : 512;
            for (int rs_ = 0; rs_ < 1 + (DUP_SUB & 1); ++rs_)
            for (int u = T.vcu; u < nu; u += T.G) {
                att::UnitP P; P.ldq = QW; P.ldkn = KVW; P.Kp = U + U_AKR; P.ldkp = INWP; P.ldv = KVW; P.ldo = MIXW; P.masked = 0; P.kpos1 = 0; P.has_sink = 0; P.sink = 0.f;
                if (u < 512) { const int bh = u >> 4, qb = u & 15, b = bh >> 3, h = bh & 7; const size_t q0 = (size_t)b * SEQ + qb * 256;
                    P.Q = QB + q0 * QW + h * 192; P.Kn = KVB + h * 256; P.V = KVB + h * 256 + 128; P.O = MIX + q0 * MIXW + h * 128;
                    P.base0 = b * SEQ; P.n0 = 64; P.base1 = NLAT + b * CTXL; P.NT = 68; P.qpos0 = qb * 256; P.rope = 1; }
                else { const int bh = u - 512, b = bh >> 3, h = bh & 7; const size_t q0 = (size_t)NLAT + b * CTXL;
                    P.Q = QB + q0 * QW + h * 192; P.Kn = KVB + h * 256; P.V = KVB + h * 256 + 128; P.O = MIX + q0 * MIXW + h * 128;
                    P.base0 = NLAT + b * CTXL; P.n0 = 4; P.base1 = 0; P.NT = 4; P.qpos0 = 0; P.rope = 0; }
#ifndef NO_MLA
                att::attn_unit<12, 4, 1>(P, (char*)lds, CA, att::THR / MLA_SCALE, wave_s);
#endif
            }
            for (int rs_ = 0; rs_ < 1 + ((DUP_SUB >> 1) & 1); ++rs_)
            for (int u = T.vcu; u < nu; u += T.G) {
                att::UnitP P; P.ldq = INWP; P.Kn = nullptr; P.ldkn = 0; P.ldkp = INWP; P.ldv = INWP; P.ldo = MIXW; P.has_sink = 1;
                if (u < 512) { const int bh = u >> 4, qb = u & 15, b = bh >> 3, h = bh & 7, kvh = h >> 2; const size_t q0 = (size_t)b * SEQ + qb * 256;
                    const int kt0 = qb * 256 - 128 < 0 ? 0 : qb * 256 - 128, kt1 = qb * 256 + 384 > SEQ ? SEQ : qb * 256 + 384;
                    P.Q = U + q0 * INWP + U_BQ + h * 64; P.Kp = U + U_BK + kvh * 64; P.V = U + U_BV + kvh * 64; P.O = MIX + q0 * MIXW + 1024 + h * 64;
                    P.base0 = NLAT + b * CTXL; P.n0 = 4; P.base1 = b * SEQ + kt0; P.NT = 4 + (kt1 - kt0) / 64; P.masked = 1; P.kpos1 = kt0; P.qpos0 = qb * 256; P.rope = 1; P.sink = p.in[I_SINK][l * 8 + h]; }
                else { const int bh = u - 512, b = bh >> 3, h = bh & 7, kvh = h >> 2; const size_t q0 = (size_t)NLAT + b * CTXL;
                    P.Q = U + q0 * INWP + U_BQ + h * 64; P.Kp = U + U_BK + kvh * 64; P.V = U + U_BV + kvh * 64; P.O = MIX + q0 * MIXW + 1024 + h * 64;
                    P.base0 = NLAT + b * CTXL; P.n0 = 4; P.base1 = 0; P.NT = 4; P.masked = 0; P.kpos1 = 0; P.qpos0 = 0; P.rope = 0; P.sink = p.in[I_SINK][l * 8 + h]; }
#ifndef NO_SWA
                att::attn_unit<4, 2, 0>(P, (char*)lds, CB, att::THR / SWA_SCALE, wave_s);
#endif
            }
#ifndef NO_CONV
            for (int rs_ = 0; rs_ < 1 + ((DUP_SUB >> 2) & 1); ++rs_)
            { const Ctx T2 = make_ctx(lds, wave_s);
            conv_phase(T2, U, MIX, p.in[I_CONVW] + l * 31 * 512, p.in[I_CONVB] + l * 512, p.in[I_LNG] + l * 512, p.in[I_LNB] + l * 512, mrows / 16); }
#endif
        } } }
        SEAM();
        if (((PH_MASK >> 6) & 1) && RUN(ph)) { for (int rep_ = 0; rep_ < 1 + ((DUP_MASK >> 6) & 1) * ((DUP_L >> l_) & 1); ++rep_) { if (rep_) GBAR(); { const Ctx T = make_ctx(lds, wave_s); mergenorm_phase(T, MIX, p.in[I_ONORM] + l * MIXW, mrows); } } }
        SEAM();
        if (((PH_MASK >> 7) & 1) && RUN(ph)) { for (int rep_ = 0; rep_ < 1 + ((DUP_MASK >> 7) & 1) * ((DUP_L >> l_) & 1); ++rep_) { if (rep_) GBAR(); { const Ctx T = make_ctx(lds, wave_s);  pg8::Gemm g{MIX, (const bf16_t*)(wl + WL_OUT), mrows, DM, DM, DM}; pg8::CtxSplitOrder S; S.init(DM, T.G, T.bx, DM, l == 0);
            pg8::EpiResid E{res_lat, res_ctx, XB, modl + 2 * DM, SLAB}; pg8::gemm_phase<pg8::EpiResid, pg8::CtxSplitOrder, true, true>(T.lds3, g, S, E, wave_s); } } }
        SEAM();
        if (((PH_MASK >> 8) & 1) && RUN(ph)) { for (int rep_ = 0; rep_ < 1 + ((DUP_MASK >> 8) & 1) * ((DUP_L >> l_) & 1); ++rep_) { if (rep_) GBAR(); { const Ctx T = make_ctx(lds, wave_s); modnorm_phase(T, XB, l == 0 ? p.in[I_CTX] : XB + (size_t)NLAT * DM, mrows, p.in[I_NMLP] + l * DM, modl, 3 * DM, 4 * DM, HN, l == 0 ? SLAB : nullptr, mod + 2 * DM, XB); } } }
        SEAM();
        if (((PH_MASK >> 9) & 1) && RUN(ph)) { for (int rep_ = 0; rep_ < 1 + ((DUP_MASK >> 9) & 1) * ((DUP_L >> l_) & 1); ++rep_) { if (rep_) GBAR(); { const Ctx T = make_ctx(lds, wave_s);  pg8::Gemm g{HN, (const bf16_t*)(wl + WL_W1), mrows, FF, DM, DM}; pg8::StaticOrder S; S.init(mrows, FF, T.G, T.bx, DM);
            pg8::EpiBf16<2> E{ACT, FF}; pg8::gemm_phase<pg8::EpiBf16<2>, pg8::StaticOrder, true, true>(T.lds3, g, S, E, wave_s); } } }
        SEAM();
        if (((PH_MASK >> 10) & 1) && RUN(ph)) { for (int rep_ = 0; rep_ < 1 + ((DUP_MASK >> 10) & 1) * ((DUP_L >> l_) & 1); ++rep_) { if (rep_) GBAR(); { const Ctx T = make_ctx(lds, wave_s);  pg8::Gemm g{ACT, (const bf16_t*)(wl + WL_W2), mrows, DM, FF, FF}; pg8::CtxSplitOrder S; S.init(DM, T.G, T.bx, FF, l == 0);
            pg8::EpiResid E{XB, XB + (size_t)NLAT * DM, XB, modl + 5 * DM, SLAB}; pg8::gemm_phase<pg8::EpiResid, pg8::CtxSplitOrder, true, true>(T.lds3, g, S, E, wave_s); } } }
        SEAM();
    }
    if (((PH_MASK >> 11) & 1) && RUN(ph)) { for (int rep_ = 0; rep_ < 1 + ((DUP_MASK >> 11) & 1) * ((DUP_L >> l_) & 1); ++rep_) { if (rep_) GBAR(); { const Ctx T = make_ctx(lds, wave_s); finalnorm_phase(T, XB, p.in[I_FNORM], p.out); } } }
#undef RUN
#undef SEAM
}

constexpr int LDS_BYTES = 131072 + 1024;
constexpr int N_PHASES = 1 + 10 * DEPTH + 1;
#ifndef MK_ONE_LAUNCH
#define MK_ONE_LAUNCH 1
#endif
extern "C" void kernel_launch(void* const* d_in, const int* in_sizes, int n_in, void* d_out, int out_size, void* d_ws, size_t ws_size, hipStream_t stream) {
    static int grid = 0;
    if (grid == 0) {
        if (n_in != 23 || ws_size < WS_END || out_size != NLAT * DM) { fprintf(stderr, "kernel_launch: unexpected shapes: n_in %d ws %zu (need %zu) out %d\n", n_in, ws_size, (size_t)WS_END, out_size); grid = -1; return; }
        int dev = 0, cus = 0, per_cu = 0;
        hipGetDevice(&dev); hipDeviceGetAttribute(&cus, hipDeviceAttributeMultiprocessorCount, dev);
        if (hipFuncSetAttribute((const void*)mega_fwd, hipFuncAttributeMaxDynamicSharedMemorySize, LDS_BYTES) != hipSuccess) { fprintf(stderr, "kernel_launch: hipFuncSetAttribute failed\n"); grid = -1; return; }
        hipOccupancyMaxActiveBlocksPerMultiprocessor(&per_cu, (const void*)mega_fwd, 512, LDS_BYTES);
        (void)hipGetLastError();
        if (per_cu < 1) { fprintf(stderr, "kernel_launch: occupancy query says %d blocks per CU\n", per_cu); per_cu = 1; }
        grid = cus;
    }
    if (grid < 0) return;
    (void)hipMemsetAsync((char*)d_ws + WS_CTL, 0, 16384, stream);
    Params p{};
    for (int i = 0; i < 23; ++i) p.in[i] = (const float*)d_in[i];
    p.out = (float*)d_out; p.ws = (unsigned char*)d_ws;
#if MK_ONE_LAUNCH
    p.ph_lo = 0; p.ph_hi = N_PHASES;
    void* args[] = {&p};
    hipError_t e = hipLaunchCooperativeKernel((const void*)mega_fwd, dim3(grid), dim3(512), args, LDS_BYTES, stream);
    if (e != hipSuccess) fprintf(stderr, "kernel_launch: cooperative launch failed: %s (grid %d)\n", hipGetErrorString(e), grid);
#else
    for (int k = 0; k < N_PHASES; ++k) { p.ph_lo = k; p.ph_hi = k + 1; hipLaunchKernelGGL(mega_fwd, dim3(grid), dim3(512), LDS_BYTES, stream, p); }
#endif
}
```

```cpp
#include <hip/hip_runtime.h>
#include <hip/hip_cooperative_groups.h>
#include <cstdio>
#include <cstdint>
namespace cg = cooperative_groups;

#define LAS __attribute__((address_space(3)))
typedef unsigned short bf16_t;
typedef short bf16x8 __attribute__((ext_vector_type(8)));
typedef short s16x4 __attribute__((ext_vector_type(4)));
typedef float f32x4 __attribute__((ext_vector_type(4)));
typedef float f32x2 __attribute__((ext_vector_type(2)));
typedef float f32x16 __attribute__((ext_vector_type(16)));
typedef unsigned u32x4 __attribute__((ext_vector_type(4)));
typedef unsigned u32x2 __attribute__((ext_vector_type(2)));

constexpr int DM = 2048, NB = 4, SEQ = 4096, CTXL = 256, NLAT = NB * SEQ, NCTXR = NB * CTXL, NROW = NLAT + NCTXR, DEPTH = 2;
constexpr int INW = 2880, INWP = 3072, QW = 1536, KVW = 2048, FF = 8192, MODW = 6 * DM, MIXW = 2048;
constexpr int U_AQ = 0, U_AKV = 512, U_AKR = 1024, U_BQ = 1088, U_BK = 1600, U_BV = 1728, U_CA = 1856, U_CG = 2368;
constexpr float EPS = 1e-6f;
constexpr float MLA_SCALE = 0.07216878364870322f;
constexpr float SWA_SCALE = 0.125f;


constexpr size_t MiB = 1u << 20;
constexpr size_t WS_MOD = 0;
constexpr size_t WS_CTL = 512 * 1024;
constexpr size_t WS_WL = 1 * MiB;
constexpr size_t WL_IN = 0, WL_UQ = 12 * MiB, WL_UKV = WL_UQ + 1536 * 1024, WL_OUT = WL_UKV + 2 * MiB, WL_W1 = WL_OUT + 8 * MiB, WL_W2 = WL_W1 + 32 * MiB, WL_SIZE = WL_W2 + 32 * MiB;
constexpr size_t WS_X = WS_WL + 2 * WL_SIZE;
constexpr size_t WS_HN = WS_X + (size_t)NROW * DM * 4;
constexpr size_t WS_U = WS_HN + (size_t)NROW * DM * 2;
constexpr size_t WS_Q = WS_U + (size_t)NROW * INWP * 2;
constexpr size_t WS_KV = WS_Q + (size_t)NROW * QW * 2;
constexpr size_t WS_MIX = WS_KV + (size_t)NROW * KVW * 2;
constexpr size_t WS_ACT = WS_U;
constexpr size_t WS_SLAB = WS_MIX + (size_t)NROW * MIXW * 2;
constexpr size_t WS_END = WS_SLAB + (size_t)8 * NCTXR * DM * 4;
static_assert(WS_ACT + (size_t)NROW * FF * 2 <= WS_SLAB, "act overlay");

__device__ const float ROPE_TAB[64 * 16 * 2] = {
1.00000000e+00f, 0.00000000e+00f, 1.00000000e+00f, 0.00000000e+00f, 1.00000000e+00f, 0.00000000e+00f, 1.00000000e+00f, 0.00000000e+00f,
1.00000000e+00f, 0.00000000e+00f, 1.00000000e+00f, 0.00000000e+00f, 1.00000000e+00f, 0.00000000e+00f, 1.00000000e+00f, 0.00000000e+00f,
1.00000000e+00f, 0.00000000e+00f, 1.00000000e+00f, 0.00000000e+00f, 1.00000000e+00f, 0.00000000e+00f, 1.00000000e+00f, 0.00000000e+00f,
1.00000000e+00f, 0.00000000e+00f, 1.00000000e+00f, 0.00000000e+00f, 1.00000000e+00f, 0.00000000e+00f, 1.00000000e+00f, 0.00000000e+00f,
5.40302306e-01f, 8.41470985e-01f, 8.46009106e-01f, 5.33168446e-01f, 9.50415281e-01f, 3.10983591e-01f, 9.84230235e-01f, 1.76892185e-01f,
9.95004165e-01f, 9.98334181e-02f, 9.98419278e-01f, 5.62044992e-02f, 9.99500042e-01f, 3.16175047e-02f, 9.99841890e-01f, 1.77818571e-02f,
9.99950000e-01f, 9.99983311e-03f, 9.99984189e-01f, 5.62338361e-03f, 9.99995000e-01f, 3.16227236e-03f, 9.99998419e-01f, 1.77827849e-03f,
9.99999500e-01f, 9.99999881e-04f, 9.99999842e-01f, 5.62341272e-04f, 9.99999950e-01f, 3.16227752e-04f, 9.99999984e-01f, 1.77827939e-04f,
-4.16146837e-01f, 9.09297427e-01f, 4.31462816e-01f, 9.02130721e-01f, 8.06578412e-01f, 5.91127114e-01f, 9.37418310e-01f, 3.48205273e-01f,
9.80066577e-01f, 1.98669334e-01f, 9.93682109e-01f, 1.12231311e-01f, 9.98000667e-01f, 6.32033945e-02f, 9.99367611e-01f, 3.55580912e-02f,
9.99800007e-01f, 1.99986662e-02f, 9.99936755e-01f, 1.12465894e-02f, 9.99980000e-01f, 6.32451310e-03f, 9.99993675e-01f, 3.55655136e-03f,
9.99998000e-01f, 1.99999876e-03f, 9.99999368e-01f, 1.12468237e-03f, 9.99999800e-01f, 6.32455472e-04f, 9.99999937e-01f, 3.55655873e-04f,
-9.89992497e-01f, 1.41120008e-01f, -1.15966163e-01f, 9.93253165e-01f, 5.82753640e-01f, 8.12648876e-01f, 8.61040659e-01f, 5.08536117e-01f,
9.55336486e-01f, 2.95520218e-01f, 9.85803469e-01f, 1.67903306e-01f, 9.95503374e-01f, 9.47260862e-02f, 9.98577312e-01f, 5.33230830e-02f,
9.99550034e-01f, 2.99954995e-02f, 9.99857701e-01f, 1.68694395e-02f, 9.99955000e-01f, 9.48669035e-03f, 9.99985770e-01f, 5.33481299e-03f,
9.99995500e-01f, 2.99999553e-03f, 9.99998577e-01f, 1.68702310e-03f, 9.99999550e-01f, 9.48683100e-04f, 9.99999858e-01f, 5.33483781e-04f,
-6.53643621e-01f, -7.56802495e-01f, -6.27679676e-01f, 7.78471723e-01f, 3.01137471e-01f, 9.53580738e-01f, 7.57506176e-01f, 6.52827997e-01f,
9.21060992e-01f, 3.89418348e-01f, 9.74808266e-01f, 2.23044491e-01f, 9.92010662e-01f, 1.26154060e-01f, 9.97471244e-01f, 7.10712093e-02f,
9.99200107e-01f, 3.99893333e-02f, 9.99747028e-01f, 2.24917562e-02f, 9.99920001e-01f, 1.26487732e-02f, 9.99974702e-01f, 7.11305774e-03f,
9.99992000e-01f, 3.99998952e-03f, 9.99997470e-01f, 2.24936331e-03f, 9.99999200e-01f, 1.26491069e-03f, 9.99999747e-01f, 7.11311701e-04f,
2.83662185e-01f, -9.58924275e-01f, -9.46079242e-01f, 3.23935282e-01f, -1.03423381e-02f, 9.99946517e-01f, 6.30080299e-01f, 7.76529984e-01f,
8.77582562e-01f, 4.79425539e-01f, 9.60731260e-01f, 2.77480534e-01f, 9.87526022e-01f, 1.57455882e-01f, 9.96049756e-01f, 8.87968616e-02f,
9.98750261e-01f, 4.99791663e-02f, 9.99604741e-01f, 2.81133616e-02f, 9.99875003e-01f, 1.58107286e-02f, 9.99960472e-01f, 8.89128000e-03f,
9.99987500e-01f, 4.99997952e-03f, 9.99996047e-01f, 2.81170292e-03f, 9.99998750e-01f, 1.58113816e-03f, 9.99999605e-01f, 8.89139598e-04f,
9.60170287e-01f, -2.79415498e-01f, -9.73103698e-01f, -2.30367517e-01f, -3.20796390e-01f, 9.47148181e-01f, 4.82782035e-01f, 8.75740548e-01f,
8.25335601e-01f, 5.64642493e-01f, 9.43616960e-01f, 3.31039323e-01f, 9.82053937e-01f, 1.88600277e-01f, 9.94313298e-01f, 1.06494442e-01f,
9.98200540e-01f, 5.99640051e-02f, 9.99430844e-01f, 3.37340781e-02f, 9.99820005e-01f, 1.89725269e-02f, 9.99943080e-01f, 1.06694741e-02f,
9.99982000e-01f, 5.99996405e-03f, 9.99994308e-01f, 3.37404141e-03f, 9.99998200e-01f, 1.89736535e-03f, 9.99999431e-01f, 1.06696741e-03f,
7.53902254e-01f, 6.56986599e-01f, -7.00429814e-01f, -7.13721287e-01f, -5.99437453e-01f, 8.00421602e-01f, 3.20257002e-01f, 9.47330699e-01f,
7.64842195e-01f, 6.44217678e-01f, 9.23519457e-01f, 3.83551578e-01f, 9.75599879e-01f, 2.19556087e-01f, 9.92262418e-01f, 1.24158339e-01f,
9.97551000e-01f, 6.99428476e-02f, 9.99225342e-01f, 3.93537258e-02f, 9.99755010e-01f, 2.21341355e-02f, 9.99922525e-01f, 1.24476345e-02f,
9.99975500e-01f, 6.99994305e-03f, 9.99992252e-01f, 3.93637883e-03f, 9.99997550e-01f, 2.21359246e-03f, 9.99999225e-01f, 1.24479530e-03f,
-1.45500034e-01f, 9.89358247e-01f, -2.12036448e-01f, -9.77261759e-01f, -8.18632447e-01f, 5.74317783e-01f, 1.47631213e-01f, 9.89042479e-01f,
6.96706701e-01f, 7.17356099e-01f, 9.00502310e-01f, 4.34851228e-01f, 9.68170306e-01f, 2.50292345e-01f, 9.89897766e-01f, 1.41782975e-01f,
9.96801706e-01f, 7.99146922e-02f, 9.98988242e-01f, 4.49721329e-02f, 9.99680017e-01f, 2.52955226e-02f, 9.99898809e-01f, 1.42257556e-02f,
9.99968000e-01f, 7.99991505e-03f, 9.99989881e-01f, 4.49871524e-03f, 9.99996800e-01f, 2.52981936e-03f, 9.99998988e-01f, 1.42262304e-03f,
-9.11130262e-01f, 4.12118485e-01f, 3.41660255e-01f, -9.39823531e-01f, -9.56644168e-01f, 2.91259224e-01f, -2.96507962e-02f, 9.99560318e-01f,
6.21609940e-01f, 7.83326932e-01f, 8.74638261e-01f, 4.84776146e-01f, 9.59772644e-01f, 2.80778331e-01f, 9.87220090e-01f, 1.59362777e-01f,
9.95952733e-01f, 8.98785453e-02f, 9.98719551e-01f, 5.05891178e-02f, 9.99595027e-01f, 2.84566569e-02f, 9.99871931e-01f, 1.60038307e-02f,
9.99959500e-01f, 8.99987904e-03f, 9.99987193e-01f, 5.06105023e-03f, 9.99995950e-01f, 2.84604600e-03f, 9.99998719e-01f, 1.60045073e-03f,
-8.39071529e-01f, -5.44021111e-01f, 7.90131866e-01f, -6.12936893e-01f, -9.99786072e-01f, -2.06835699e-02f, -2.05997633e-01f, 9.78552490e-01f,
5.40302306e-01f, 8.41470985e-01f, 8.46009106e-01f, 5.33168446e-01f, 9.50415290e-01f, 3.10983563e-01f, 9.84230235e-01f, 1.76892185e-01f,
9.95004166e-01f, 9.98334107e-02f, 9.98419278e-01f, 5.62044992e-02f, 9.99500042e-01f, 3.16175047e-02f, 9.99841890e-01f, 1.77818571e-02f,
9.99950000e-01f, 9.99983404e-03f, 9.99984189e-01f, 5.62338361e-03f, 9.99995000e-01f, 3.16227236e-03f, 9.99998419e-01f, 1.77827849e-03f,
4.42569799e-03f, -9.99990207e-01f, 9.95257399e-01f, -9.72764577e-02f, -9.43779739e-01f, -3.30574959e-01f, -3.75847400e-01f, 9.26681570e-01f,
4.53596100e-01f, 8.91207371e-01f, 8.14705342e-01f, 5.79875164e-01f, 9.40107590e-01f, 3.40877865e-01f, 9.80929147e-01f, 1.94365656e-01f,
9.93956098e-01f, 1.09778300e-01f, 9.98087432e-01f, 6.18181033e-02f, 9.99395061e-01f, 3.47780401e-02f, 9.99808688e-01f, 1.95598272e-02f,
9.99939501e-01f, 1.09997790e-02f, 9.99980868e-01f, 6.18571475e-03f, 9.99993950e-01f, 3.47849840e-03f, 9.99998087e-01f, 1.95610608e-03f,
8.43853959e-01f, -5.36572918e-01f, 8.93861614e-01f, 4.48342965e-01f, -7.94179352e-01f, -6.07683434e-01f, -5.33843014e-01f, 8.45583607e-01f,
3.62357710e-01f, 9.32039103e-01f, 7.80825933e-01f, 6.24748639e-01f, 9.28859871e-01f, 3.70431289e-01f, 9.77317868e-01f, 2.11777679e-01f,
9.92808636e-01f, 1.19712205e-01f, 9.97724024e-01f, 6.74297562e-02f, 9.99280086e-01f, 3.79382239e-02f, 9.99772325e-01f, 2.13377337e-02f,
9.99928001e-01f, 1.19997121e-02f, 9.99977232e-01f, 6.74804441e-03f, 9.99992800e-01f, 3.79472386e-03f, 9.99997723e-01f, 2.13393360e-03f,
9.07446781e-01f, 4.20167037e-01f, 5.17172845e-01f, 8.55880978e-01f, -5.65820493e-01f, -8.24528453e-01f, -6.75001666e-01f, 7.37816204e-01f,
2.67498760e-01f, 9.63558205e-01f, 7.44477987e-01f, 6.67647007e-01f, 9.16683370e-01f, 3.99614314e-01f, 9.73397544e-01f, 2.29122720e-01f,
9.91561894e-01f, 1.29634138e-01f, 9.97329065e-01f, 7.30392768e-02f, 9.99155119e-01f, 4.10980321e-02f, 9.99732799e-01f, 2.31155726e-02f,
9.99915501e-01f, 1.29996341e-02f, 9.99973279e-01f, 7.31037192e-03f, 9.99991550e-01f, 4.11094918e-03f, 9.99997328e-01f, 2.31176106e-03f,
1.36737218e-01f, 9.90607356e-01f, -1.87961516e-02f, 9.99823337e-01f, -2.81349481e-01f, -9.59605372e-01f, -7.94870905e-01f, 6.06778580e-01f,
1.69967166e-01f, 9.85449726e-01f, 7.05776374e-01f, 7.08434690e-01f, 9.03590249e-01f, 4.28397784e-01f, 9.69169414e-01f, 2.46395308e-01f,
9.90215996e-01f, 1.39543115e-01f, 9.96902569e-01f, 7.86464803e-02f, 9.99020160e-01f, 4.42574256e-02f, 9.99690113e-01f, 2.48933403e-02f,
9.99902002e-01f, 1.39995431e-02f, 9.99969010e-01f, 7.87269666e-03f, 9.99990200e-01f, 4.42717408e-03f, 9.99996901e-01f, 2.48958868e-03f,
-7.59687913e-01f, 6.50287840e-01f, -5.48975472e-01f, 8.35838460e-01f, 3.10223509e-02f, -9.99518691e-01f, -8.89670427e-01f, 4.56603254e-01f,
7.07372017e-02f, 9.97494987e-01f, 6.64843529e-01f, 7.46982651e-01f, 8.89593626e-01f, 4.56752865e-01f, 9.64634817e-01f, 2.63589966e-01f,
9.88771079e-01f, 1.49438124e-01f, 9.96444547e-01f, 8.42512043e-02f, 9.98875211e-01f, 4.74163803e-02f, 9.99644265e-01f, 2.66710293e-02f,
9.99887502e-01f, 1.49994381e-02f, 9.99964425e-01f, 8.43501985e-03f, 9.99988750e-01f, 4.74339854e-03f, 9.99996442e-01f, 2.66741598e-03f,
-9.57659480e-01f, -2.87903317e-01f, -9.10081090e-01f, 4.14430224e-01f, 3.40318168e-01f, -9.40310345e-01f, -9.56410050e-01f, 2.92027082e-01f,
-2.91995461e-02f, 9.99573602e-01f, 6.21808819e-01f, 7.83169070e-01f, 8.74707484e-01f, 4.84651232e-01f, 9.59795176e-01f, 2.80701301e-01f,
9.87227284e-01f, 1.59318203e-01f, 9.95955015e-01f, 8.98532639e-02f, 9.98720273e-01f, 5.05748570e-02f, 9.99595256e-01f, 2.84486321e-02f,
9.99872003e-01f, 1.59993181e-02f, 9.99959523e-01f, 8.99733943e-03f, 9.99987200e-01f, 5.05962253e-03f, 9.99995952e-01f, 2.84524320e-03f,
-2.75163338e-01f, -9.61397492e-01f, -9.90897960e-01f, -1.34615131e-01f, 6.15864792e-01f, -7.87851863e-01f, -9.92984984e-01f, 1.18240524e-01f,
-1.28844542e-01f, 9.91664804e-01f, 5.76808296e-01f, 8.16879544e-01f, 8.58946708e-01f, 5.12064988e-01f, 9.54652029e-01f, 2.97723872e-01f,
9.85584767e-01f, 1.69182351e-01f, 9.95433988e-01f, 9.54524822e-02f, 9.98555348e-01f, 5.37328280e-02f, 9.99543086e-01f, 3.02261450e-02f,
9.99855503e-01f, 1.69991821e-02f, 9.99954305e-01f, 9.55965617e-03f, 9.99985550e-01f, 5.37584601e-03f, 9.99995431e-01f, 3.02307034e-03f,
6.60316708e-01f, -7.50987247e-01f, -7.66536540e-01f, -6.42200695e-01f, 8.30336128e-01f, -5.57262877e-01f, -9.98241661e-01f, -5.92755186e-02f,
-2.27202164e-01f, 9.73847615e-01f, 5.29984176e-01f, 8.48007532e-01f, 8.42327058e-01f, 5.38966722e-01f, 9.49207011e-01f, 3.14652269e-01f,
9.83843694e-01f, 1.79029566e-01f, 9.94881482e-01f, 1.01048682e-01f, 9.98380437e-01f, 5.68902654e-02f, 9.99487755e-01f, 3.20035622e-02f,
9.99838004e-01f, 1.79990291e-02f, 9.99948772e-01f, 1.01219708e-02f, 9.99983800e-01f, 5.69206895e-03f, 9.99994877e-01f, 3.20089737e-03f,
9.88704618e-01f, 1.49877210e-01f, -3.06095406e-01f, -9.52000842e-01f, 9.62463796e-01f, -2.71410100e-01f, -9.72014272e-01f, -2.34921804e-01f,
-3.23289544e-01f, 9.46300095e-01f, 4.81484589e-01f, 8.76454557e-01f, 8.24865151e-01f, 5.65329535e-01f, 9.43461826e-01f, 3.31481196e-01f,
9.82004236e-01f, 1.88858893e-01f, 9.94297517e-01f, 1.06641679e-01f, 9.98195543e-01f, 6.00471302e-02f, 9.99429263e-01f, 3.37808820e-02f,
9.99819505e-01f, 1.89988581e-02f, 9.99942921e-01f, 1.06842813e-02f, 9.99981950e-01f, 6.00829132e-03f, 9.99994292e-01f, 3.37872454e-03f,
4.08082062e-01f, 9.12945251e-01f, 2.48616731e-01f, -9.68601941e-01f, 9.99144380e-01f, 4.13582902e-02f, -9.15129950e-01f, -4.03158994e-01f,
-4.16146837e-01f, 9.09297427e-01f, 4.31462816e-01f, 9.02130721e-01f, 8.06578448e-01f, 5.91127066e-01f, 9.37418310e-01f, 3.48205273e-01f,
9.80066580e-01f, 1.98669319e-01f, 9.93682109e-01f, 1.12231311e-01f, 9.98000667e-01f, 6.32033945e-02f, 9.99367611e-01f, 3.55580912e-02f,
9.99800007e-01f, 1.99986681e-02f, 9.99936755e-01f, 1.12465894e-02f, 9.99980000e-01f, 6.32451310e-03f, 9.99993675e-01f, 3.55655136e-03f,
-5.47729260e-01f, 8.36655639e-01f, 7.26760256e-01f, -6.86891207e-01f, 9.36740452e-01f, 3.50024751e-01f, -8.29382949e-01f, -5.58680521e-01f,
-5.04846228e-01f, 8.63209294e-01f, 3.80076998e-01f, 9.24954850e-01f, 7.87485197e-01f, 6.16333566e-01f, 9.31078354e-01f, 3.64819269e-01f,
9.78030916e-01f, 2.08459893e-01f, 9.93035277e-01f, 1.17817394e-01f, 9.97795810e-01f, 6.63590305e-02f, 9.99302799e-01f, 3.73351880e-02f,
9.99779508e-01f, 2.09984581e-02f, 9.99930273e-01f, 1.18088930e-02f, 9.99977950e-01f, 6.64073424e-03f, 9.99993027e-01f, 3.73437808e-03f,
-9.99960826e-01f, -8.85130929e-03f, 9.81074582e-01f, -1.93630229e-01f, 7.81440393e-01f, 6.23979898e-01f, -7.17477463e-01f, -6.96581718e-01f,
-5.88501156e-01f, 8.08496376e-01f, 3.27489589e-01f, 9.44854787e-01f, 7.67604563e-01f, 6.40923736e-01f, 9.24443984e-01f, 3.81317874e-01f,
9.75897450e-01f, 2.18229622e-01f, 9.92357044e-01f, 1.23399744e-01f, 9.97580976e-01f, 6.95140029e-02f, 9.99234826e-01f, 3.91121704e-02f,
9.99758010e-01f, 2.19982271e-02f, 9.99923474e-01f, 1.23711928e-02f, 9.99975800e-01f, 6.95695471e-03f, 9.99992347e-01f, 3.91220468e-03f,
-5.32833020e-01f, -8.46220404e-01f, 9.33235772e-01f, 3.59264517e-01f, 5.48645256e-01f, 8.36055251e-01f, -5.82943235e-01f, -8.12512883e-01f,
-6.66275986e-01f, 7.45705244e-01f, 2.73866839e-01f, 9.61767620e-01f, 7.46956388e-01f, 6.64873036e-01f, 9.17517275e-01f, 3.97695927e-01f,
9.73666397e-01f, 2.27977513e-01f, 9.91647429e-01f, 1.28978199e-01f, 9.97356166e-01f, 7.26682802e-02f, 9.99163694e-01f, 4.08890255e-02f,
9.99735512e-01f, 2.29979741e-02f, 9.99916359e-01f, 1.29334897e-02f, 9.99973550e-01f, 7.27317449e-03f, 9.99991636e-01f, 4.09003138e-03f,
4.24179007e-01f, -9.05578362e-01f, 5.97977171e-01f, 8.01513133e-01f, 2.61441688e-01f, 9.65219272e-01f, -4.30023272e-01f, -9.02817803e-01f,
-7.37393780e-01f, 6.75463110e-01f, 2.19378275e-01f, 9.75639878e-01f, 7.25561320e-01f, 6.88157519e-01f, 9.10300429e-01f, 4.13948220e-01f,
9.71337976e-01f, 2.37702621e-01f, 9.90906456e-01f, 1.34552575e-01f, 9.97121382e-01f, 7.58218234e-02f, 9.99089402e-01f, 4.26657512e-02f,
9.99712014e-01f, 2.39976963e-02f, 9.99908928e-01f, 1.34957815e-02f, 9.99971200e-01f, 7.58939308e-03f, 9.99990893e-01f, 4.26785749e-03f,
9.91202812e-01f, -1.32351750e-01f, 7.85522636e-02f, 9.96909997e-01f, -5.16893290e-02f, 9.98663213e-01f, -2.63540593e-01f, -9.64648307e-01f,
-8.01143616e-01f, 5.98472144e-01f, 1.64196159e-01f, 9.86427707e-01f, 7.03440751e-01f, 7.10753902e-01f, 9.02795741e-01f, 4.30069588e-01f,
9.68912422e-01f, 2.47403959e-01f, 9.90134147e-01f, 1.40122697e-01f, 9.96876627e-01f, 7.89746157e-02f, 9.99011951e-01f, 4.44423420e-02f,
9.99687516e-01f, 2.49973963e-02f, 9.99901180e-01f, 1.40580691e-02f, 9.99968750e-01f, 7.90561137e-03f, 9.99990118e-01f, 4.44568393e-03f,
6.46919322e-01f, 7.62558450e-01f, -4.65064496e-01f, 8.85276801e-01f, -3.59694339e-01f, 9.33070191e-01f, -8.87455026e-02f, -9.96054334e-01f,
-8.56888827e-01f, 5.15501249e-01f, 1.08494947e-01f, 9.94097001e-01f, 6.80616801e-01f, 7.32639591e-01f, 8.95005558e-01f, 4.46054986e-01f,
9.66389981e-01f, 2.57080543e-01f, 9.89330528e-01f, 1.45688387e-01f, 9.96621904e-01f, 8.21266183e-02f, 9.98931341e-01f, 4.62187923e-02f,
9.99662019e-01f, 2.59970713e-02f, 9.99893117e-01f, 1.46203532e-02f, 9.99966200e-01f, 8.22182888e-03f, 9.99989312e-01f, 4.62350977e-03f,
-2.92138809e-01f, 9.56375928e-01f, -8.65450634e-01f, 5.00994211e-01f, -6.32028631e-01f, 7.74945037e-01f, 8.88481164e-02f, -9.96045186e-01f,
-9.04072162e-01f, 4.27379837e-01f, 5.24506144e-02f, 9.98623519e-01f, 6.57112291e-01f, 7.53792702e-01f, 8.86932371e-01f, 4.61899307e-01f,
9.63770901e-01f, 2.66731418e-01f, 9.88495623e-01f, 1.51249471e-01f, 9.96357214e-01f, 8.52777923e-02f, 9.98847571e-01f, 4.79951001e-02f,
9.99635522e-01f, 2.69967203e-02f, 9.99884737e-01f, 1.51826317e-02f, 9.99963550e-01f, 8.53804556e-03f, 9.99988474e-01f, 4.80133592e-03f,
-9.62605866e-01f, 2.70905788e-01f, -9.99293409e-01f, -3.75856620e-02f, -8.41684939e-01f, 5.39968946e-01f, 2.63639511e-01f, -9.64621277e-01f,
-9.42222325e-01f, 3.34988195e-01f, -3.75941901e-03f, 9.99992933e-01f, 6.32950677e-01f, 7.74192121e-01f, 8.78578705e-01f, 4.77597592e-01f,
9.61055438e-01f, 2.76355650e-01f, 9.87629462e-01f, 1.56805757e-01f, 9.96082561e-01f, 8.84281209e-02f, 9.98760643e-01f, 4.97712524e-02f,
9.99608026e-01f, 2.79963423e-02f, 9.99876041e-01f, 1.57449054e-02f, 9.99960800e-01f, 8.85426139e-03f, 9.99987604e-01f, 4.97916193e-03f,
-7.48057530e-01f, -6.63633884e-01f, -8.25371633e-01f, -5.64589822e-01f, -9.67871508e-01f, 2.51445312e-01f, 4.30115848e-01f, -9.02773702e-01f,
-9.70958188e-01f, 2.39249237e-01f, -5.99575673e-02f, 9.98200927e-01f, 6.08156211e-01f, 7.93817374e-01f, 8.69947214e-01f, 4.93144851e-01f,
9.58243878e-01f, 2.85952217e-01f, 9.86732067e-01f, 1.62357098e-01f, 9.95797946e-01f, 9.15775651e-02f, 9.98670557e-01f, 5.15472474e-02f,
9.99579529e-01f, 2.89959364e-02f, 9.99867029e-01f, 1.63071750e-02f, 9.99957950e-01f, 9.17047633e-03f, 9.99986703e-01f, 5.15698731e-03f,
1.54251450e-01f, -9.88031624e-01f, -3.97251862e-01f, -9.17709626e-01f, -9.98075227e-01f, -6.20148391e-02f, 5.83026938e-01f, -8.12452823e-01f,
-9.89992497e-01f, 1.41120008e-01f, -1.15966163e-01f, 9.93253165e-01f, 5.82753640e-01f, 8.12648876e-01f, 8.61040659e-01f, 5.08536117e-01f,
9.55336494e-01f, 2.95520190e-01f, 9.85803469e-01f, 1.67903306e-01f, 9.95503374e-01f, 9.47260937e-02f, 9.98577312e-01f, 5.33230830e-02f,
9.99550034e-01f, 2.99955014e-02f, 9.99857701e-01f, 1.68694395e-02f, 9.99955000e-01f, 9.48669035e-03f, 9.99985770e-01f, 5.33481299e-03f,
9.14742358e-01f, -4.04037645e-01f, 1.53215476e-01f, -9.88192804e-01f, -9.29300295e-01f, -3.69325007e-01f, 7.17549222e-01f, -6.96507799e-01f,
-9.99135156e-01f, 4.15805195e-02f, -1.71608138e-01f, 9.85165289e-01f, 5.56768364e-01f, 8.30667797e-01f, 8.51861797e-01f, 5.23766626e-01f,
9.52333569e-01f, 3.05058639e-01f, 9.84843697e-01f, 1.73444204e-01f, 9.95198847e-01f, 9.78736675e-02f, 9.98480910e-01f, 5.50987464e-02f,
9.99519538e-01f, 3.09950364e-02f, 9.99848056e-01f, 1.74316968e-02f, 9.99951950e-01f, 9.80290343e-03f, 9.99984805e-01f, 5.51263804e-03f,
8.34223361e-01f, 5.51426681e-01f, 6.56495179e-01f, -7.54330219e-01f, -7.68367089e-01f, -6.40009388e-01f, 8.29440367e-01f, -5.58595272e-01f,
-9.98294773e-01f, -5.83741910e-02f, -2.26707585e-01f, 9.73962869e-01f, 5.30226367e-01f, 8.47856120e-01f, 8.42413559e-01f, 5.38831509e-01f,
9.49235420e-01f, 3.14566554e-01f, 9.83852782e-01f, 1.78979618e-01f, 9.94884368e-01f, 1.01020270e-01f, 9.98381351e-01f, 5.68742354e-02f,
9.99488044e-01f, 3.19945405e-02f, 9.99838096e-01f, 1.79939505e-02f, 9.99948800e-01f, 1.01191155e-02f, 9.99983809e-01f, 5.69046338e-03f,
-1.32767472e-02f, 9.99911860e-01f, 9.57586074e-01f, -2.88147378e-01f, -5.31235279e-01f, -8.47224338e-01f, 9.15171383e-01f, -4.03064932e-01f,
-9.87479777e-01f, -1.57745647e-01f, -2.81090307e-01f, 9.59681322e-01f, 5.03154187e-01f, 8.64196658e-01f, 8.32698933e-01f, 5.53726003e-01f,
9.46042349e-01f, 3.24043013e-01f, 9.82830754e-01f, 1.84509371e-01f, 9.94559939e-01f, 1.04165862e-01f, 9.98278634e-01f, 5.86495447e-02f,
9.99455549e-01f, 3.29940106e-02f, 9.99827819e-01f, 1.85561985e-02f, 9.99945550e-01f, 1.04353266e-02f, 9.99982781e-01f, 5.86828853e-03f,
-8.48570275e-01f, 5.29082686e-01f, 9.63757533e-01f, 2.66779718e-01f, -2.41421115e-01f, -9.70420448e-01f, 9.72038357e-01f, -2.34822129e-01f,
-9.66798168e-01f, -2.55541194e-01f, -3.34584379e-01f, 9.42365796e-01f, 4.75578896e-01f, 8.79673072e-01f, 8.22720991e-01f, 5.68445398e-01f,
9.42754664e-01f, 3.33487096e-01f, 9.81777647e-01f, 1.90033290e-01f, 9.94225566e-01f, 1.07310406e-01f, 9.98172760e-01f, 6.04246684e-02f,
9.99422056e-01f, 3.39934516e-02f, 9.99817226e-01f, 1.91184387e-02f, 9.99942201e-01f, 1.07515367e-02f, 9.99981722e-01f, 6.04611304e-03f,
-9.03692205e-01f, -4.28182669e-01f, 6.73110268e-01f, 7.39542134e-01f, 7.23346672e-02f, -9.97380417e-01f, 9.98247762e-01f, -5.91726788e-02f,
-9.36456687e-01f, -3.50783228e-01f, -3.87020682e-01f, 9.22071034e-01f, 4.47528065e-01f, 8.94269887e-01f, 8.12482924e-01f, 5.82984990e-01f,
9.39372715e-01f, 3.42897802e-01f, 9.80693494e-01f, 1.95551199e-01f, 9.93881250e-01f, 1.10453883e-01f, 9.98063730e-01f, 6.21996048e-02f,
9.99387563e-01f, 3.49928548e-02f, 9.99806317e-01f, 1.96806747e-02f, 9.99938751e-01f, 1.10677456e-02f, 9.99980631e-01f, 6.22393783e-03f,
-1.27963690e-01f, -9.91778853e-01f, 1.75156534e-01f, 9.84540598e-01f, 3.78916172e-01f, -9.25430999e-01f, 9.92972826e-01f, 1.18342584e-01f,
-8.96758353e-01f, -4.42520572e-01f, -4.38233547e-01f, 8.98861145e-01f, 4.19029744e-01f, 9.07972507e-01f, 8.01987899e-01f, 5.97340280e-01f,
9.35896829e-01f, 3.52274219e-01f, 9.79578328e-01f, 2.01062925e-01f, 9.93526995e-01f, 1.13596256e-01f, 9.97951544e-01f, 6.39743371e-02f,
9.99352070e-01f, 3.59922267e-02f, 9.99795091e-01f, 2.02429046e-02f, 9.99935201e-01f, 1.13839535e-02f, 9.99979509e-01f, 6.40176195e-03f,
7.65414052e-01f, -6.43538133e-01f, -3.76742289e-01f, 9.26318114e-01f, 6.47921689e-01f, -7.61706955e-01f, 9.56380030e-01f, 2.92125382e-01f,
-8.48100006e-01f, -5.29836181e-01f, -4.88060852e-01f, 8.72809604e-01f, 3.90112429e-01f, 9.20767231e-01f, 7.91239269e-01f, 6.11506680e-01f,
9.32327344e-01f, 3.61615436e-01f, 9.78432188e-01f, 2.06568278e-01f, 9.93162805e-01f, 1.16737493e-01f, 9.97836202e-01f, 6.57488745e-02f,
9.99315578e-01f, 3.69915589e-02f, 9.99783550e-01f, 2.08051261e-02f, 9.99931551e-01f, 1.17001602e-02f, 9.99978354e-01f, 6.57958633e-03f,
9.55073644e-01f, 2.96368579e-01f, -8.12611205e-01f, 5.82806168e-01f, 8.52673116e-01f, -5.22444789e-01f, 8.89623492e-01f, 4.56694694e-01f,
-7.90967741e-01f, -6.11857853e-01f, -5.36345181e-01f, 8.43998724e-01f, 3.60805033e-01f, 9.32641264e-01f, 7.80240434e-01f, 6.25479708e-01f,
9.28664637e-01f, 3.70920465e-01f, 9.77255105e-01f, 2.12067113e-01f, 9.92788684e-01f, 1.19877556e-01f, 9.97717704e-01f, 6.75232040e-02f,
9.99278087e-01f, 3.79908578e-02f, 9.99771692e-01f, 2.13673430e-02f, 9.99927801e-01f, 1.20163657e-02f, 9.99977168e-01f, 6.75741050e-03f,
2.66642932e-01f, 9.63795386e-01f, -9.98210360e-01f, 5.98003149e-02f, 9.72865350e-01f, -2.31372019e-01f, 7.94808390e-01f, 6.06860464e-01f,
-7.25932239e-01f, -6.87766228e-01f, -5.82933885e-01f, 8.12519591e-01f, 3.31136863e-01f, 9.43582735e-01f, 7.68994909e-01f, 6.39254902e-01f,
9.24909065e-01f, 3.80188402e-01f, 9.76047118e-01f, 2.17559242e-01f, 9.92404635e-01f, 1.23016426e-01f, 9.97596052e-01f, 6.92973125e-02f,
9.99239596e-01f, 3.89901151e-02f, 9.99759518e-01f, 2.19295531e-02f, 9.99923951e-01f, 1.23325701e-02f, 9.99975951e-01f, 6.93523400e-03f,
-6.66938062e-01f, 7.45113160e-01f, -8.76379442e-01f, -4.81621297e-01f, 9.96578984e-01f, 8.26458063e-02f, 6.74925652e-01f, 7.37885740e-01f,
-6.53643621e-01f, -7.56802495e-01f, -6.27679676e-01f, 7.78471723e-01f, 3.01137584e-01f, 9.53580702e-01f, 7.57506176e-01f, 6.52827997e-01f,
9.21061003e-01f, 3.89418320e-01f, 9.74808266e-01f, 2.23044491e-01f, 9.92010662e-01f, 1.26154060e-01f, 9.97471244e-01f, 7.10712093e-02f,
9.99200107e-01f, 3.99893370e-02f, 9.99747028e-01f, 2.24917562e-02f, 9.99920001e-01f, 1.26487732e-02f, 9.99974702e-01f, 7.11305774e-03f,
-9.87339278e-01f, -1.58622669e-01f, -4.84639397e-01f, -8.74714042e-01f, 9.21462347e-01f, 3.88467685e-01f, 5.33756100e-01f, 8.45638472e-01f,
-5.74824025e-01f, -8.18277056e-01f, -6.70441094e-01f, 7.41962761e-01f, 2.70837078e-01f, 9.62625201e-01f, 7.45777904e-01f, 6.66194655e-01f,
9.17120824e-01f, 3.98609325e-01f, 9.73538587e-01f, 2.28522688e-01f, 9.91606768e-01f, 1.29290439e-01f, 9.97343283e-01f, 7.28448814e-02f,
9.99159618e-01f, 4.09885153e-02f, 9.99734222e-01f, 2.30539504e-02f, 9.99915951e-01f, 1.29649751e-02f, 9.99973421e-01f, 7.29088079e-03f,
-3.99985315e-01f, -9.16521548e-01f, 5.63609403e-02f, -9.98410459e-01f, 7.54965347e-01f, 6.55764687e-01f, 3.75752152e-01f, 9.26720195e-01f,
-4.90260572e-01f, -8.71575913e-01f, -7.11082951e-01f, 7.03108126e-01f, 2.40265871e-01f, 9.70707119e-01f, 7.33813802e-01f, 6.79350649e-01f,
9.13088946e-01f, 4.07760441e-01f, 9.72238123e-01f, 2.33993657e-01f, 9.91192958e-01f, 1.32425525e-01f, 9.97212167e-01f, 7.46183157e-02f,
9.99118130e-01f, 4.19876562e-02f, 9.99721100e-01f, 2.36161391e-02f, 9.99911801e-01f, 1.32811756e-02f, 9.99972109e-01f, 7.46870408e-03f,
5.55113302e-01f, -8.31774743e-01f, 5.80003113e-01f, -8.14614258e-01f, 5.13598418e-01f, 8.58030690e-01f, 2.05897171e-01f, 9.78573633e-01f,
-4.00798997e-01f, -9.16166013e-01f, -7.49476759e-01f, 6.62030655e-01f, 2.09454419e-01f, 9.77818412e-01f, 7.21617654e-01f, 6.92291818e-01f,
9.08965759e-01f, 4.16870782e-01f, 9.70906914e-01f, 2.39457227e-01f, 9.90769236e-01f, 1.35559287e-01f, 9.97077898e-01f, 7.63915215e-02f,
9.99075642e-01f, 4.29867515e-02f, 9.99707662e-01f, 2.41783204e-02f, 9.99907551e-01f, 1.35973748e-02f, 9.99970765e-01f, 7.64652713e-03f,
9.99843309e-01f, 1.77019251e-02f, 9.25014669e-01f, -3.79931391e-01f, 2.21298174e-01f, 9.75206193e-01f, 2.95478207e-02f, 9.99563368e-01f,
-3.07332779e-01f, -9.51602103e-01f, -7.85501139e-01f, 6.18860211e-01f, 1.78433530e-01f, 9.83951968e-01f, 7.09193358e-01f, 7.05014029e-01f,
9.04751664e-01f, 4.25939463e-01f, 9.69545006e-01f, 2.44913210e-01f, 9.90335607e-01f, 1.38691694e-01f, 9.96940476e-01f, 7.81644856e-02f,
9.99032156e-01f, 4.39858075e-02f, 9.99693907e-01f, 2.47404922e-02f, 9.99903202e-01f, 1.39135727e-02f, 9.99969389e-01f, 7.82434947e-03f,
5.25321989e-01f, 8.50903525e-01f, 9.85138202e-01f, 1.71763569e-01f, -9.29481055e-02f, 9.95670955e-01f, -1.47732986e-01f, 9.89027282e-01f,
-2.10795799e-01f, -9.77530118e-01f, -8.19042201e-01f, 5.73733276e-01f, 1.47234222e-01f, 9.89101655e-01f, 6.96544759e-01f, 7.17513344e-01f,
9.00447108e-01f, 4.34965523e-01f, 9.68152431e-01f, 2.50361478e-01f, 9.89892074e-01f, 1.41822713e-01f, 9.96799902e-01f, 7.99371952e-02f,
9.98987671e-01f, 4.49848158e-02f, 9.99679836e-01f, 2.53026580e-02f, 9.99898752e-01f, 1.42297692e-02f, 9.99967982e-01f, 8.00217157e-03f,
-4.32177945e-01f, 9.01788348e-01f, 7.41858013e-01f, 6.70556998e-01f, -3.97976765e-01f, 9.17395495e-01f, -3.20354369e-01f, 9.47297777e-01f,
-1.12152622e-01f, -9.93690993e-01f, -8.49993909e-01f, 5.26792516e-01f, 1.15887692e-01f, 9.93262323e-01f, 6.83675900e-01f, 7.29785766e-01f,
8.96052507e-01f, 4.43948088e-01f, 9.66729248e-01f, 2.55801799e-01f, 9.89438642e-01f, 1.44952315e-01f, 9.96656175e-01f, 8.17096594e-02f,
9.98942186e-01f, 4.59837829e-02f, 9.99665450e-01f, 2.58648158e-02f, 9.99894202e-01f, 1.45459642e-02f, 9.99966543e-01f, 8.17999434e-03f,
-9.92335469e-01f, 1.23573123e-01f, 2.70098458e-01f, 9.62832708e-01f, -6.63538256e-01f, 7.48142355e-01f, -4.82871938e-01f, 8.75690979e-01f,
-1.23883774e-02f, -9.99923261e-01f, -8.78258409e-01f, 4.78186331e-01f, 8.44252840e-02f, 9.96429813e-01f, 6.70590848e-01f, 7.41827416e-01f,
8.91568289e-01f, 4.52886284e-01f, 9.65275487e-01f, 2.61234060e-01f, 9.88975318e-01f, 1.48080452e-01f, 9.96509297e-01f, 8.34818579e-02f,
9.98895703e-01f, 4.69827002e-02f, 9.99650747e-01f, 2.64269636e-02f, 9.99889552e-01f, 1.48621578e-02f, 9.99965073e-01f, 8.35781593e-03f,
-6.40144339e-01f, -7.68254661e-01f, -2.84846606e-01f, 9.58573112e-01f, -8.63296488e-01f, 5.04697111e-01f, -6.30159971e-01f, 7.76465332e-01f,
8.74991734e-02f, -9.96164592e-01f, -9.03746345e-01f, 4.28068388e-01f, 5.28784581e-02f, 9.98600956e-01f, 6.57293742e-01f, 7.53634485e-01f,
8.86994928e-01f, 4.61779166e-01f, 9.63791209e-01f, 2.66658031e-01f, 9.88502102e-01f, 1.51207123e-01f, 9.96359267e-01f, 8.52537997e-02f,
9.98848221e-01f, 4.79815705e-02f, 9.99635728e-01f, 2.69891049e-02f, 9.99884802e-01f, 1.51783490e-02f, 9.99963571e-01f, 8.53563725e-03f,
3.00592544e-01f, -9.53752653e-01f, -7.52063995e-01f, 6.59090090e-01f, -9.77442725e-01f, 2.11200659e-01f, -7.57573076e-01f, 6.52750361e-01f,
1.86512463e-01f, -9.82452595e-01f, -9.26377138e-01f, 3.76597130e-01f, 2.12787581e-02f, 9.99773582e-01f, 6.43788833e-01f, 7.65203201e-01f,
8.82332868e-01f, 4.70625870e-01f, 9.62276453e-01f, 2.72073570e-01f, 9.88019001e-01f, 1.54332282e-01f, 9.96206087e-01f, 8.70254719e-02f,
9.98799740e-01f, 4.89803966e-02f, 9.99620393e-01f, 2.75512376e-02f, 9.99879952e-01f, 1.54945396e-02f, 9.99962037e-01f, 8.71345923e-03f,
9.64966028e-01f, -2.62374854e-01f, -9.87659084e-01f, 1.56619074e-01f, -9.94656427e-01f, -1.03240463e-01f, -8.61092711e-01f, 5.08447974e-01f,
2.83662185e-01f, -9.58924275e-01f, -9.46079242e-01f, 3.23935282e-01f, -1.03422189e-02f, 9.99946518e-01f, 6.30080299e-01f, 7.76529984e-01f,
8.77582562e-01f, 4.79425539e-01f, 9.60731260e-01f, 2.77480534e-01f, 9.87526020e-01f, 1.57455897e-01f, 9.96049756e-01f, 8.87968616e-02f,
9.98750260e-01f, 4.99791700e-02f, 9.99604741e-01f, 2.81133598e-02f, 9.99875003e-01f, 1.58107286e-02f, 9.99960472e-01f, 8.89128000e-03f,
7.42154197e-01f, 6.70229176e-01f, -9.19073538e-01f, -3.94086072e-01f, -9.13230128e-01f, -4.07444148e-01f, -9.37454250e-01f, 3.48108502e-01f,
3.77977654e-01f, -9.25814718e-01f, -9.62790371e-01f, 2.70249331e-01f, -4.19528545e-02f, 9.99119591e-01f, 6.16172522e-01f, 7.87611213e-01f,
8.72744512e-01f, 4.88177239e-01f, 9.59155693e-01f, 2.82878695e-01f, 9.87023164e-01f, 1.60577938e-01f, 9.95890276e-01f, 9.05679778e-02f,
9.98699782e-01f, 5.09778971e-02f, 9.99588774e-01f, 2.86754749e-02f, 9.99869953e-01f, 1.61269170e-02f, 9.99958875e-01f, 9.06910049e-03f,
-1.62990781e-01f, 9.86627592e-01f, -5.67430029e-01f, -8.23421619e-01f, -7.41239965e-01f, -6.71240132e-01f, -9.84248472e-01f, 1.76790685e-01f,
4.68516924e-01f, -8.83454522e-01f, -9.76457693e-01f, 2.15709002e-01f, -7.35215408e-02f, 9.97293629e-01f, 6.02069899e-01f, 7.98443384e-01f,
8.67819189e-01f, 4.96880121e-01f, 9.57549788e-01f, 2.88267938e-01f, 9.86510437e-01f, 1.63698373e-01f, 9.95727646e-01f, 9.23388002e-02f,
9.98648305e-01f, 5.19765696e-02f, 9.99572491e-01f, 2.92375810e-02f, 9.99864803e-01f, 1.64431020e-02f, 9.99957246e-01f, 9.24692070e-03f,
-9.18282786e-01f, 3.95925150e-01f, -4.10281900e-02f, -9.99157989e-01f, -4.95741821e-01f, -8.68469946e-01f, -9.99999995e-01f, -1.03020676e-04f,
5.54374495e-01f, -8.32267336e-01f, -9.87037999e-01f, 1.60486722e-01f, -1.05016712e-01f, 9.94470457e-01f, 5.87776937e-01f, 8.09023036e-01f,
8.62807085e-01f, 5.05533317e-01f, 9.55913610e-01f, 2.93648038e-01f, 9.85987845e-01f, 1.66817172e-01f, 9.95561868e-01f, 9.41093381e-02f,
9.98595829e-01f, 5.29751937e-02f, 9.99555891e-01f, 2.97996760e-02f, 9.99859553e-01f, 1.67592871e-02f, 9.99955586e-01f, 9.42474155e-03f,
-8.29309833e-01f, -5.58789049e-01f, 4.98009600e-01f, -8.67171516e-01f, -2.01079620e-01f, -9.79574901e-01f, -9.84212024e-01f, -1.76993477e-01f,
6.34692950e-01f, -7.72764427e-01f, -9.94497866e-01f, 1.04756834e-01f, -1.36406875e-01f, 9.90652898e-01f, 5.73298061e-01f, 8.19346894e-01f,
8.57708701e-01f, 5.14135959e-01f, 9.54247195e-01f, 2.99018880e-01f, 9.85455396e-01f, 1.69934287e-01f, 9.95392941e-01f, 9.58795783e-02f,
9.98542354e-01f, 5.39737612e-02f, 9.99538975e-01f, 3.03617634e-02f, 9.99854204e-01f, 1.70754687e-02f, 9.99953894e-01f, 9.60256116e-03f,
2.21267563e-02f, -9.99755173e-01f, 8.83669314e-01f, -4.68111679e-01f, 1.13521777e-01f, -9.93535508e-01f, -9.37382505e-01f, -3.48301649e-01f,
7.08669774e-01f, -7.05540326e-01f, -9.98813646e-01f, 4.86959996e-02f, -1.67660642e-01f, 9.85844769e-01f, 5.58637897e-01f, 8.29411659e-01f,
8.52524516e-01f, 5.22687239e-01f, 9.52550613e-01f, 3.04380238e-01f, 9.84913090e-01f, 1.73049718e-01f, 9.95220867e-01f, 9.76495079e-02f,
9.98487881e-01f, 5.49722784e-02f, 9.99521744e-01f, 3.09238412e-02f, 9.99848754e-01f, 1.73916505e-02f, 9.99952171e-01f, 9.78038047e-03f,
8.53220108e-01f, -5.21551002e-01f, 9.97174636e-01f, 7.51182087e-02f, 4.16867074e-01f, -9.08967459e-01f, -8.60988417e-01f, -5.08624563e-01f,
7.75565818e-01f, -6.31266712e-01f, -9.99971734e-01f, -7.51878489e-03f, -1.98746880e-01f, 9.80050855e-01f, 5.43801080e-01f, 8.39214147e-01f,
8.47255110e-01f, 5.31186200e-01f, 9.50823909e-01f, 3.09731970e-01f, 9.84360935e-01f, 1.76163418e-01f, 9.95045645e-01f, 9.94191362e-02f,
9.98432410e-01f, 5.59707370e-02f, 9.99504196e-01f, 3.14859073e-02f, 9.99843204e-01f, 1.77078286e-02f, 9.99950416e-01f, 9.95820041e-03f,
8.99866827e-01f, 4.36164755e-01f, 8.03569087e-01f, 5.95211494e-01f, 6.78870211e-01f, -7.34258290e-01f, -7.57439190e-01f, -6.52905716e-01f,
8.34712942e-01f, -5.50685304e-01f, -9.97968467e-01f, -6.37097991e-02f, -2.29634270e-01f, 9.73276991e-01f, 5.28792303e-01f, 8.48751259e-01f,
8.41900979e-01f, 5.39632043e-01f, 9.49067129e-01f, 3.15073936e-01f, 9.83798936e-01f, 1.79275357e-01f, 9.94867276e-01f, 1.01188450e-01f,
9.98375940e-01f, 5.69691433e-02f, 9.99486332e-01f, 3.20479672e-02f, 9.99837554e-01f, 1.80240068e-02f, 9.99948629e-01f, 1.01360191e-02f,
1.19180135e-01f, 9.92872648e-01f, 3.62476666e-01f, 9.31992847e-01f, 8.73550510e-01f, -4.86733506e-01f, -6.30000714e-01f, -7.76594554e-01f,
8.85519606e-01f, -4.64602011e-01f, -9.92810180e-01f, -1.19699398e-01f, -2.60292045e-01f, 9.65529933e-01f, 5.13616311e-01f, 8.58019979e-01f,
8.36462659e-01f, 5.48023923e-01f, 9.47280345e-01f, 3.20405911e-01f, 9.83227099e-01f, 1.82385503e-01f, 9.94685763e-01f, 1.02957436e-01f,
9.98318471e-01f, 5.79674889e-02f, 9.99468152e-01f, 3.26100133e-02f, 9.99831805e-01f, 1.83401814e-02f, 9.99946811e-01f, 1.03138375e-02f,
-7.71080223e-01f, 6.36738007e-01f, -1.90249096e-01f, 9.81735851e-01f, 9.81602098e-01f, -1.90938005e-01f, -4.82692335e-01f, -8.75789992e-01f,
9.27478466e-01f, -3.73876576e-01f, -9.84513180e-01f, -1.75310575e-01f, -2.90689550e-01f, 9.56817425e-01f, 4.98277903e-01f, 8.67017376e-01f,
8.30940694e-01f, 5.56361001e-01f, 9.45463597e-01f, 3.25727781e-01f, 9.82645430e-01f, 1.85493825e-01f, 9.94501103e-01f, 1.04726105e-01f,
9.98260005e-01f, 5.89657802e-02f, 9.99449656e-01f, 3.31720491e-02f, 9.99825955e-01f, 1.86563560e-02f, 9.99944961e-01f, 1.04916564e-02f,
-9.52412980e-01f, -3.04810621e-01f, -6.84381916e-01f, 7.29123716e-01f, 9.92308319e-01f, 1.23790949e-01f, -3.20159180e-01f, -9.47363763e-01f,
9.60170287e-01f, -2.79415498e-01f, -9.73103698e-01f, -2.30367517e-01f, -3.20796390e-01f, 9.47148181e-01f, 4.82782035e-01f, 8.75740548e-01f,
8.25335635e-01f, 5.64642444e-01f, 9.43616960e-01f, 3.31039323e-01f, 9.82053934e-01f, 1.88600292e-01f, 9.94313298e-01f, 1.06494442e-01f,
9.98200540e-01f, 5.99640089e-02f, 9.99430844e-01f, 3.37340781e-02f, 9.99820005e-01f, 1.89725269e-02f, 9.99943080e-01f, 1.06694741e-02f,
-2.58101636e-01f, -9.66117770e-01f, -9.67739662e-01f, 2.51952269e-01f, 9.04607566e-01f, 4.26245412e-01f, -1.47529203e-01f, -9.89057700e-01f,
9.83268421e-01f, -1.82162598e-01f, -9.58617804e-01f, -2.84696165e-01f, -3.50582460e-01f, 9.36531867e-01f, 4.67133397e-01f, 8.84186852e-01f,
8.19648010e-01f, 5.72867472e-01f, 9.41740473e-01f, 3.36340425e-01f, 9.81452621e-01f, 1.91704858e-01f, 9.94122349e-01f, 1.08262435e-01f,
9.98140077e-01f, 6.09621813e-02f, 9.99411716e-01f, 3.42960927e-02f, 9.99813956e-01f, 1.92886978e-02f, 9.99941166e-01f, 1.08472915e-02f,
6.73507162e-01f, -7.39180697e-01f, -9.53050036e-01f, -3.02812861e-01f, 7.27198078e-01f, 6.86427677e-01f, 2.97537714e-02f, -9.99557259e-01f,
9.96542121e-01f, -8.30891177e-02f, -9.41101294e-01f, -3.38124763e-01f, -3.80017977e-01f, 9.24979101e-01f, 4.51337043e-01f, 8.92353559e-01f,
8.13878454e-01f, 5.81035164e-01f, 9.39834216e-01f, 3.41630863e-01f, 9.80841490e-01f, 1.94807522e-01f, 9.93928256e-01f, 1.10030093e-01f,
9.98078615e-01f, 6.19602890e-02f, 9.99392272e-01f, 3.48580964e-02f, 9.99807806e-01f, 1.96048648e-02f, 9.99939222e-01f, 1.10251085e-02f,
9.85896582e-01f, 1.67355700e-01f, -6.44837016e-01f, -7.64320105e-01f, 4.77671453e-01f, 8.78538550e-01f, 2.06098327e-01f, -9.78531287e-01f,
9.99858633e-01f, 1.68140912e-02f, -9.20609545e-01f, -3.90484398e-01f, -4.09073509e-01f, 9.12501433e-01f, 4.35397967e-01f, 9.00238085e-01f,
8.08027511e-01f, 5.89144754e-01f, 9.37898229e-01f, 3.46910525e-01f, 9.80220551e-01f, 1.97908238e-01f, 9.93731021e-01f, 1.11797395e-01f,
9.98016156e-01f, 6.29583348e-02f, 9.99372512e-01f, 3.54200929e-02f, 9.99801557e-01f, 1.99210318e-02f, 9.99937245e-01f, 1.12029262e-02f,
};

__device__ __forceinline__ unsigned cvt_pk_bf16(float lo, float hi) { unsigned r; asm volatile("v_cvt_pk_bf16_f32 %0, %1, %2" : "=v"(r) : "v"(lo), "v"(hi)); return r; }
__device__ __forceinline__ float bf2f(unsigned short b) { return __uint_as_float((unsigned)b << 16); }
__device__ __forceinline__ float bflo(unsigned w) { return __uint_as_float(w << 16); }
__device__ __forceinline__ float bfhi(unsigned w) { return __uint_as_float(w & 0xffff0000u); }
__device__ __forceinline__ unsigned short f2bf(float f) { unsigned u = __float_as_uint(f); return (unsigned short)((u + 0x7fffu + ((u >> 16) & 1u)) >> 16); }
__device__ __forceinline__ float wave_sum(float v, const int lane) {
#pragma unroll
    for (int o = 1; o < 64; o <<= 1) v += __int_as_float(__builtin_amdgcn_ds_bpermute((lane ^ o) << 2, __float_as_int(v)));
    return v;
}
template <int N> __device__ __forceinline__ void wave_sum_n(float (&s)[N], const int lane) {
#pragma unroll
    for (int o = 1; o < 64; o <<= 1) { float t[N]; const int idx = (lane ^ o) << 2;
#pragma unroll
        for (int q = 0; q < N; ++q) t[q] = __int_as_float(__builtin_amdgcn_ds_bpermute(idx, __float_as_int(s[q])));
#pragma unroll
        for (int q = 0; q < N; ++q) s[q] += t[q]; }
}
__device__ __forceinline__ int lane_id_() { return (int)__builtin_amdgcn_mbcnt_hi(~0u, __builtin_amdgcn_mbcnt_lo(~0u, 0u)); }
__device__ __forceinline__ int tid_from_(int wave_s) { int l; int w = wave_s; asm volatile("v_mbcnt_lo_u32_b32 %0, -1, 0\n\tv_mbcnt_hi_u32_b32 %0, -1, %0" : "=v"(l), "+s"(w)); return w * 64 + l; }
__device__ __forceinline__ float sigmoidf_(float x) { return __builtin_amdgcn_rcpf(1.0f + __expf(-x)); }

namespace pg8 {
constexpr int BM = 256, BK = 64, HALF = 128, HTB = HALF * BK * 2, STAGE_BYTES = 8 * HTB, NXCD = 8, WGM = 8;
__host__ __device__ __forceinline__ int lds_byte(int r, int c) { const int st = (r >> 4) * 2 + (c >> 5), rr = r & 15, cc = c & 31, ob = rr * 64 + cc * 2; return st * 1024 + (ob ^ (((ob >> 9) & 1) << 5)); }
__host__ __device__ __forceinline__ void stage_rc(int b, int& R, int& C) { const int st = b / 1024, sb = b % 1024, swz = sb ^ (((sb >> 9) & 1) << 5); R = (st >> 1) * 16 + swz / 64; C = (st & 1) * 32 + (swz % 64) / 2; }
__host__ __device__ __forceinline__ int perm32(int rho) { const int n = rho >> 4, i = rho & 15; return 8 * (i >> 2) + 4 * n + (i & 3); }

struct Unit { int pm, pn, k0, nt, split; };
struct Gemm { const bf16_t* A; const bf16_t* Bt; int M, N, K, lda; };

struct StaticOrder {
    int nM, nN, nwg, G, c, ntk;
    __host__ __device__ __forceinline__ void init(int M, int N, int G_, int c_, int K) { nM = M / BM; nN = N / BM; nwg = nM * nN; G = G_; c = c_; ntk = K / BK; }
    __host__ __device__ __forceinline__ bool next(int i, Unit& u) const {
        const int L = i * G + c; const bool ok = L < nwg;
        int wgid = ok ? L : 0; { const int q = nwg / NXCD, r = nwg % NXCD, xcd = wgid % NXCD, off = wgid / NXCD; wgid = (xcd < r ? xcd * (q + 1) : r * (q + 1) + (xcd - r) * q) + off; }
        const int nig = WGM * nN, gid = wgid / nig, fm = gid * WGM, gsz = (nM - fm) < WGM ? (nM - fm) : WGM;
        u.pm = fm + ((wgid % nig) % gsz); u.pn = (wgid % nig) / gsz; u.k0 = 0; u.nt = ntk; u.split = 0; return ok;
    }
    __device__ __forceinline__ void a_ready(const Unit&) const {}
    __device__ __forceinline__ void done(const Unit&) const {}
};

struct CtxSplitOrder {
    StaticOrder lat; int with_ctx, nl;
    __host__ __device__ __forceinline__ void init(int N, int G_, int c_, int K, int with_ctx_) { lat.init(NLAT, N, G_, c_, K); with_ctx = with_ctx_; nl = (lat.nwg - c_ + G_ - 1) / G_; if (nl < 0) nl = 0; }
    __host__ __device__ __forceinline__ bool next(int i, Unit& u) const {
        Unit a; const bool va = lat.next(i, a);
        const int nctx = (NCTXR / BM) * lat.nN; constexpr int S = 8;
        const bool use_lat = i < nl;
        const int sub = (use_lat ? 0 : (i - nl) * lat.G) + lat.c;
        const bool vc = with_ctx && !use_lat && sub < nctx * S;
        const int uu = sub / S, sl = sub % S, cnt = lat.ntk / S;
        u.pm = use_lat ? a.pm : NLAT / BM + (uu / lat.nN) % (NCTXR / BM); u.pn = use_lat ? a.pn : uu % lat.nN; u.nt = use_lat ? a.nt : cnt; u.k0 = use_lat ? 0 : sl * cnt * BK; u.split = use_lat ? 0 : 1 + sl;
        return use_lat ? va : vc;
    }
    __device__ __forceinline__ void a_ready(const Unit&) const {}
    __device__ __forceinline__ void done(const Unit&) const {}
};

template <int ACT  > struct EpiBf16 {
    static constexpr bool PERM = true, AFTER_DRAIN = false;
    bf16_t* O; int ldc;
    __device__ __forceinline__ void operator()(const f32x4 (&acc)[2][2][4][2], const Unit& u, int wr, int wc, int fr, int fq) const {
        const int row0 = u.pm * BM + wr * 64 + fr; const int col0 = u.pn * BM + wc * 32 + 8 * fq;
#pragma unroll
        for (int ai = 0; ai < 2; ++ai)
#pragma unroll
            for (int m = 0; m < 4; ++m) { bf16_t* rowp = O + (size_t)(row0 + ai * HALF + m * 16) * ldc + col0;
#pragma unroll
                for (int bj = 0; bj < 2; ++bj) { f32x4 v0 = acc[ai][bj][m][0], v1 = acc[ai][bj][m][1];
                    if (ACT == 2) {
#pragma unroll
                        for (int e = 0; e < 4; ++e) { float a = v0[e] > 0.f ? v0[e] : 0.f; v0[e] = a * a; float b = v1[e] > 0.f ? v1[e] : 0.f; v1[e] = b * b; } }
                    u32x4 w; w.x = cvt_pk_bf16(v0[0], v0[1]); w.y = cvt_pk_bf16(v0[2], v0[3]); w.z = cvt_pk_bf16(v1[0], v1[1]); w.w = cvt_pk_bf16(v1[2], v1[3]);
                    *(u32x4*)(rowp + bj * HALF) = w; } }
    }
};
struct EpiResid {
    static constexpr bool PERM = false, AFTER_DRAIN = false;
    const float* res_lat; const float* res_ctx; float* out; const float* gate; float* slab;
    __device__ __forceinline__ void operator()(const f32x4 (&acc)[2][2][4][2], const Unit& u, int wr, int wc, int fr, int fq) const {
        const int col0 = u.pn * BM + wc * 32 + 4 * fq;
        const bool lat = u.pm < (NLAT / BM);
        const int mrow = lat ? (u.pm >> 4) : 4;
        const float* resb = lat ? res_lat + (size_t)u.pm * BM * DM : res_ctx + (size_t)(u.pm - NLAT / BM) * BM * DM;
        float* outb = out + (size_t)u.pm * BM * DM;
        const float* gp = gate + (size_t)mrow * MODW + col0;
        if (u.split) {
            float* sb = slab + ((size_t)(u.split - 1) * NCTXR + (size_t)(u.pm - NLAT / BM) * BM) * DM + col0;
#pragma unroll
            for (int ai = 0; ai < 2; ++ai)
#pragma unroll
                for (int m = 0; m < 4; ++m) { float* op = sb + (size_t)(ai * HALF + wr * 64 + m * 16 + fr) * DM;
#pragma unroll
                    for (int bj = 0; bj < 2; ++bj)
#pragma unroll
                        for (int n = 0; n < 2; ++n) *(f32x4*)(op + bj * HALF + n * 16) = acc[ai][bj][m][n]; }
            return;
        }
        f32x4 gv[2][2];
#pragma unroll
        for (int bj = 0; bj < 2; ++bj)
#pragma unroll
            for (int n = 0; n < 2; ++n) gv[bj][n] = *(const f32x4*)(gp + bj * HALF + n * 16);
#pragma unroll
        for (int ai = 0; ai < 2; ++ai)
#pragma unroll
            for (int mp = 0; mp < 2; ++mp) {
                f32x4 bs[2][2][2];
#pragma unroll
                for (int mm = 0; mm < 2; ++mm) { const size_t off = (size_t)(ai * HALF + wr * 64 + (2 * mp + mm) * 16 + fr) * DM + col0;
#pragma unroll
                    for (int bj = 0; bj < 2; ++bj)
#pragma unroll
                        for (int n = 0; n < 2; ++n) bs[mm][bj][n] = *(const f32x4*)(resb + off + bj * HALF + n * 16); }
#pragma unroll
                for (int mm = 0; mm < 2; ++mm) { const size_t off = (size_t)(ai * HALF + wr * 64 + (2 * mp + mm) * 16 + fr) * DM + col0;
#pragma unroll
                    for (int bj = 0; bj < 2; ++bj)
#pragma unroll
                        for (int n = 0; n < 2; ++n) *(f32x4*)(outb + off + bj * HALF + n * 16) = bs[mm][bj][n] + gv[bj][n] * acc[ai][bj][2 * mp + mm][n]; }
                asm volatile("" ::: "memory");
            }
    }
};

template <class Epi, class Sched, bool ALIGN_EPI = false, bool SP2 = false>
__device__ __forceinline__ void gemm_phase(LAS unsigned char* lds, const Gemm g, const Sched& S, const Epi& E, const int wave_s) {
    const int tid_ = tid_from_(wave_s);
    const int tid = tid_, wid = __builtin_amdgcn_readfirstlane(tid >> 6), lane = tid & 63, wr = wid >> 2, wc = wid & 3, fr = lane & 15, fq = lane >> 4;
    const int K = g.K, lda = g.lda;
    unsigned voffA[2], voffB[2];
#pragma unroll
    for (int i = 0; i < 2; ++i) { int R, C; stage_rc(tid * 16 + i * 8192, R, C); const int Rb = Epi::PERM ? ((R & ~31) + perm32(R & 31)) : R;
        voffA[i] = (unsigned)(R * lda + C) * 2u; voffB[i] = (unsigned)(Rb * K + C) * 2u; }
    const size_t kstep = (size_t)(BK * 2);
    const size_t hstepA = (size_t)HALF * lda * 2, hstepB = (size_t)HALF * K * 2;
    const size_t tstepA = 2 * hstepA, tstepB = 2 * hstepB;
    const unsigned ldsw = (unsigned)wid * 1024u;
    const int aoff = lds_byte(wr * 64 + fr, fq * 8), boff = lds_byte(wc * 32 + fr, fq * 8);
#define PG8_SA(b, h) (((b) * 2 + (h)) * HTB)
#define PG8_SB(b, h) ((4 + (b) * 2 + (h)) * HTB)
#define PG8_STAGE(bufoff, gbase, voff) do { _Pragma("unroll") for (int _i = 0; _i < 2; ++_i) \
        __builtin_amdgcn_global_load_lds((const unsigned*)((const char*)(gbase) + (voff)[_i]), (LAS unsigned*)(lds + (bufoff) + ldsw + _i * 8192), 16, 0, 0); } while (0)
#define PG8_LDA(dst, b, h) do { _Pragma("unroll") for (int m = 0; m < 4; ++m) _Pragma("unroll") for (int k = 0; k < 2; ++k) dst[m][k] = *(const LAS bf16x8*)(lds + PG8_SA(b, h) + aoff + m * 2048 + k * 1024); } while (0)
#define PG8_LDB(dst, b, h) do { _Pragma("unroll") for (int n = 0; n < 2; ++n) _Pragma("unroll") for (int k = 0; k < 2; ++k) dst[n][k] = *(const LAS bf16x8*)(lds + PG8_SB(b, h) + boff + n * 2048 + k * 1024); } while (0)
#define PG8_MMA(ai, bj, At, Bt) do { __builtin_amdgcn_s_setprio(1); _Pragma("unroll") for (int m = 0; m < 4; ++m) _Pragma("unroll") for (int n = 0; n < 2; ++n) _Pragma("unroll") for (int k = 0; k < 2; ++k) \
        acc[ai][bj][m][n] = __builtin_amdgcn_mfma_f32_16x16x32_bf16(Bt[n][k], At[m][k], acc[ai][bj][m][n], 0, 0, 0); __builtin_amdgcn_s_setprio(0); } while (0)
#define PG8_WAIT_V(n) asm volatile("s_waitcnt vmcnt(" #n ")" ::: "memory")
#define PG8_WAIT_L(n) asm volatile("s_waitcnt lgkmcnt(" #n ")" ::: "memory")
#define PG8_BAR __builtin_amdgcn_s_barrier()
#define PG8_SCHED __builtin_amdgcn_sched_barrier(0)
    Unit cur, nxt; int ui = 0;
    if (!S.next(0, cur)) return;
    f32x4 acc[2][2][4][2];
#pragma unroll
    for (int a = 0; a < 2; ++a)
#pragma unroll
        for (int b = 0; b < 2; ++b)
#pragma unroll
            for (int m = 0; m < 4; ++m)
#pragma unroll
                for (int n = 0; n < 2; ++n) acc[a][b][m][n] = (f32x4){0.f, 0.f, 0.f, 0.f};
    bf16x8 At[4][2], B0[2][2], B1[2][2];
    const char* cA = (const char*)g.A + (size_t)cur.pm * tstepA + (size_t)cur.k0 * 2; const char* cB = (const char*)g.Bt + (size_t)cur.pn * tstepB + (size_t)cur.k0 * 2;
    S.a_ready(cur);
    if constexpr (SP2) {
        PG8_STAGE(PG8_SB(0, 0), cB, voffB); PG8_STAGE(PG8_SB(0, 1), cB + hstepB, voffB); PG8_STAGE(PG8_SA(0, 0), cA, voffA); PG8_STAGE(PG8_SA(0, 1), cA + hstepA, voffA);
        if (wr == 1) PG8_BAR;
        PG8_WAIT_V(2); PG8_BAR;
        PG8_STAGE(PG8_SB(1, 0), cB + kstep, voffB); PG8_STAGE(PG8_SA(1, 0), cA + kstep, voffA); PG8_STAGE(PG8_SB(1, 1), cB + hstepB + kstep, voffB);
        PG8_WAIT_V(6); PG8_BAR;
    } else {
        PG8_STAGE(PG8_SB(0, 0), cB, voffB); PG8_STAGE(PG8_SA(0, 0), cA, voffA); PG8_STAGE(PG8_SB(0, 1), cB + hstepB, voffB); PG8_STAGE(PG8_SA(0, 1), cA + hstepA, voffA);
        if (wr == 1) PG8_BAR;
        PG8_WAIT_V(4); PG8_BAR;
        PG8_STAGE(PG8_SB(1, 0), cB + kstep, voffB); PG8_STAGE(PG8_SA(1, 0), cA + kstep, voffA); PG8_STAGE(PG8_SB(1, 1), cB + hstepB + kstep, voffB);
        PG8_WAIT_V(6); PG8_BAR;
    }
    for (;;) {
        const bool has_next = S.next(ui + 1, nxt);
        const char* nA = has_next ? (const char*)g.A + (size_t)nxt.pm * tstepA + (size_t)nxt.k0 * 2 : cA; const char* nB = has_next ? (const char*)g.Bt + (size_t)nxt.pn * tstepB + (size_t)nxt.k0 * 2 : cB;
        const int nt = cur.nt;
        for (int t = 0; t < nt; t += 2) {
            const bool last = (t == nt - 2);
            const char* a1 = cA + (size_t)(t + 1) * kstep;
            const char* a2 = last ? nA : cA + (size_t)(t + 2) * kstep; const char* b2 = last ? nB : cB + (size_t)(t + 2) * kstep;
            const char* a3 = a2 + kstep; const char* b3 = b2 + kstep;
            if (last && has_next) S.a_ready(nxt);
            if constexpr (SP2) {
            PG8_LDB(B0, 0, 0); PG8_LDB(B1, 0, 1); PG8_SCHED; PG8_LDA(At, 0, 0); PG8_STAGE(PG8_SA(1, 1), a1 + hstepA, voffA);
            PG8_WAIT_V(8); PG8_WAIT_L(0); PG8_BAR; PG8_MMA(0, 0, At, B0); PG8_MMA(0, 1, At, B1); PG8_BAR; PG8_SCHED;
            PG8_LDA(At, 0, 1); PG8_STAGE(PG8_SB(0, 0), b2, voffB); PG8_STAGE(PG8_SB(0, 1), b2 + hstepB, voffB); PG8_STAGE(PG8_SA(0, 0), a2, voffA);
            PG8_WAIT_V(8); PG8_WAIT_L(0); PG8_BAR; PG8_MMA(1, 0, At, B0); PG8_MMA(1, 1, At, B1); PG8_BAR; PG8_SCHED;
            PG8_LDB(B0, 1, 0); PG8_LDB(B1, 1, 1); PG8_SCHED; PG8_LDA(At, 1, 0); PG8_STAGE(PG8_SA(0, 1), a2 + hstepA, voffA);
            PG8_WAIT_V(8); PG8_WAIT_L(0); PG8_BAR; PG8_MMA(0, 0, At, B0); PG8_MMA(0, 1, At, B1); PG8_BAR; PG8_SCHED;
            PG8_LDA(At, 1, 1); PG8_STAGE(PG8_SB(1, 0), b3, voffB); PG8_STAGE(PG8_SB(1, 1), b3 + hstepB, voffB); PG8_STAGE(PG8_SA(1, 0), a3, voffA);
            PG8_WAIT_V(8); PG8_WAIT_L(0); PG8_BAR; PG8_MMA(1, 0, At, B0); PG8_MMA(1, 1, At, B1); PG8_BAR; PG8_SCHED;
            } else {
            PG8_LDB(B0, 0, 0); PG8_SCHED; PG8_LDA(At, 0, 0); PG8_STAGE(PG8_SA(1, 1), a1 + hstepA, voffA);
            PG8_WAIT_L(8); PG8_BAR; PG8_WAIT_L(0); PG8_MMA(0, 0, At, B0); PG8_BAR; PG8_SCHED;
            PG8_LDB(B1, 0, 1); PG8_STAGE(PG8_SB(0, 0), b2, voffB);
            PG8_BAR; PG8_WAIT_L(0); PG8_MMA(0, 1, At, B1); PG8_BAR;
            PG8_LDA(At, 0, 1); PG8_STAGE(PG8_SA(0, 0), a2, voffA);
            PG8_BAR; PG8_WAIT_L(0); PG8_MMA(1, 0, At, B0); PG8_BAR; PG8_SCHED;
            PG8_STAGE(PG8_SB(0, 1), b2 + hstepB, voffB);
            PG8_WAIT_V(6); PG8_BAR; PG8_MMA(1, 1, At, B1); PG8_BAR;
            PG8_LDB(B0, 1, 0); PG8_SCHED; PG8_LDA(At, 1, 0); PG8_STAGE(PG8_SA(0, 1), a2 + hstepA, voffA);
            PG8_WAIT_L(8); PG8_BAR; PG8_WAIT_L(0); PG8_MMA(0, 0, At, B0); PG8_BAR; PG8_SCHED;
            PG8_LDB(B1, 1, 1); PG8_STAGE(PG8_SB(1, 0), b3, voffB);
            PG8_BAR; PG8_WAIT_L(0); PG8_MMA(0, 1, At, B1); PG8_BAR;
            PG8_LDA(At, 1, 1); PG8_STAGE(PG8_SA(1, 0), a3, voffA);
            PG8_BAR; PG8_WAIT_L(0); PG8_MMA(1, 0, At, B0); PG8_BAR; PG8_SCHED;
            PG8_STAGE(PG8_SB(1, 1), b3 + hstepB, voffB);
            PG8_WAIT_V(6); PG8_BAR; PG8_MMA(1, 1, At, B1); PG8_BAR;
            }
        }
        if constexpr (ALIGN_EPI) { if (wr == 0) PG8_BAR; }
        if constexpr (!Epi::AFTER_DRAIN) { E(acc, cur, wr, wc, fr, fq); S.done(cur); }
        if (!has_next) break;
#pragma unroll
        for (int a = 0; a < 2; ++a)
#pragma unroll
            for (int b = 0; b < 2; ++b)
#pragma unroll
                for (int m = 0; m < 4; ++m)
#pragma unroll
                    for (int n = 0; n < 2; ++n) acc[a][b][m][n] = (f32x4){0.f, 0.f, 0.f, 0.f};
        cur = nxt; cA = nA; cB = nB; ++ui;
        if constexpr (ALIGN_EPI) { if (wr == 1) PG8_BAR; }
    }
    PG8_WAIT_V(0);
    if constexpr (!ALIGN_EPI) { if (wr == 0) PG8_BAR; }
    PG8_BAR;
#undef PG8_SA
#undef PG8_SB
#undef PG8_STAGE
#undef PG8_LDA
#undef PG8_LDB
#undef PG8_MMA
#undef PG8_WAIT_V
#undef PG8_WAIT_L
#undef PG8_BAR
#undef PG8_SCHED
}
}

namespace att {
constexpr int NW = 8, QBLK = 32, KVBLK = 64;
constexpr float THR = 8.f;
#define SBAR() __builtin_amdgcn_sched_barrier(0)
__device__ __forceinline__ int crow(int r, int hi) { return (r & 3) + 8 * (r >> 2) + 4 * hi; }
__device__ __forceinline__ unsigned cvtpk(float lo, float hi) { unsigned r; asm volatile("v_cvt_pk_bf16_f32 %0, %1, %2" : "=v"(r) : "v"(lo), "v"(hi)); return r; }

struct UnitP {
    const bf16_t* Q; int ldq;
    const bf16_t* Kn; int ldkn;
    const bf16_t* Kp; int ldkp;
    const bf16_t* V; int ldv;
    bf16_t* O; int ldo;
    int base0, n0, base1, NT;
    int masked;
    int kpos1, qpos0;
    int rope;
    int has_sink; float sink;
};

__device__ __forceinline__ void partialSM(f32x16& p0, f32x16& p1, float& m_reg, float& mn, float& alpha, const float C, const float THRS) {
  float pmax = p0[0];
#pragma unroll
  for (int r = 1; r < 16; ++r) pmax = fmaxf(pmax, p0[r]);
#pragma unroll
  for (int r = 0; r < 16; ++r) pmax = fmaxf(pmax, p1[r]);
  { auto rr = __builtin_amdgcn_permlane32_swap(__float_as_uint(pmax), __float_as_uint(pmax), false, false);
    pmax = fmaxf(__uint_as_float(rr[0]), __uint_as_float(rr[1])); }
  if (__builtin_expect(__all(pmax - m_reg <= THRS), 1)) { mn = m_reg; alpha = 1.f; }
  else { mn = fmaxf(m_reg, pmax); alpha = __builtin_amdgcn_exp2f((m_reg - mn) * C); m_reg = mn; }
  float mnC = -mn * C;
#pragma unroll
  for (int r = 0; r < 16; ++r) p0[r] = fmaf(p0[r], C, mnC);
#pragma unroll
  for (int r = 0; r < 16; ++r) p1[r] = fmaf(p1[r], C, mnC);
#pragma unroll
  for (int r = 0; r < 16; ++r) p0[r] = __builtin_amdgcn_exp2f(p0[r]);
}
__device__ __forceinline__ void finishSM(f32x16& p0, f32x16& p1, float alpha, float& l_reg, bf16x8& pa0, bf16x8& pa1, bf16x8& pa2, bf16x8& pa3) {
#pragma unroll
  for (int r = 0; r < 16; ++r) p1[r] = __builtin_amdgcn_exp2f(p1[r]);
  float ps = 0;
#pragma unroll
  for (int r = 0; r < 16; ++r) ps += p0[r];
#pragma unroll
  for (int r = 0; r < 16; ++r) ps += p1[r];
  { auto rr = __builtin_amdgcn_permlane32_swap(__float_as_uint(ps), __float_as_uint(ps), false, false);
    ps = __uint_as_float(rr[0]) + __uint_as_float(rr[1]); }
  l_reg = l_reg * alpha + ps;
#define PK4(P, BASE, OUT) do { unsigned a0 = cvtpk(P[BASE + 0], P[BASE + 1]), a1 = cvtpk(P[BASE + 2], P[BASE + 3]);   \
    unsigned b0 = cvtpk(P[BASE + 4], P[BASE + 5]), b1 = cvtpk(P[BASE + 6], P[BASE + 7]);                              \
    auto r0 = __builtin_amdgcn_permlane32_swap(a0, b0, false, false); auto r1 = __builtin_amdgcn_permlane32_swap(a1, b1, false, false); \
    u32x4 w = {r0[0], r1[0], r0[1], r1[1]}; OUT = *reinterpret_cast<bf16x8*>(&w); } while (0)
  PK4(p0, 0, pa0); PK4(p0, 8, pa1); PK4(p1, 0, pa2); PK4(p1, 8, pa3);
#undef PK4
}
template <int NQK, int NKN>
__device__ __forceinline__ void qkt(f32x16& p0, f32x16& p1, const char* Kn, const char* Kp, const bf16x8* qr, int r32, int hi) {
  p0 = f32x16{}; p1 = f32x16{};
  const int swz = (r32 & 7) << 4;
#define KFRAG(d0, B0, B1) do { if ((d0) < 8 * NKN) { const int cb = ((d0) * 16 + hi * 8) * 2; \
      B0 = *reinterpret_cast<const bf16x8*>(Kn + r32 * 256 + (cb ^ swz)); B1 = *reinterpret_cast<const bf16x8*>(Kn + (32 + r32) * 256 + (cb ^ swz)); } \
    else { const int cb = (((d0) - 8 * NKN) * 16 + hi * 8) * 2; \
      B0 = *reinterpret_cast<const bf16x8*>(Kp + r32 * 128 + (cb ^ swz)); B1 = *reinterpret_cast<const bf16x8*>(Kp + (32 + r32) * 128 + (cb ^ swz)); } } while (0)
  bf16x8 a0, a1, n0, n1;
  KFRAG(0, a0, a1);
#pragma unroll
  for (int d0 = 0; d0 < NQK; ++d0) {
    if (d0 + 1 < NQK) { KFRAG(d0 + 1, n0, n1); }
    __builtin_amdgcn_sched_barrier(0);
    p0 = __builtin_amdgcn_mfma_f32_32x32x16_bf16(a0, qr[d0], p0, 0, 0, 0);
    p1 = __builtin_amdgcn_mfma_f32_32x32x16_bf16(a1, qr[d0], p1, 0, 0, 0);
    __builtin_amdgcn_sched_barrier(0);
    a0 = n0; a1 = n1;
  }
#undef KFRAG
}
__device__ __forceinline__ void glds16(const void* gsrc, unsigned lds_dst) { unsigned keep;
  asm volatile("s_mov_b32 %0, m0\n\ts_mov_b32 m0, %2\n\ts_nop 0\n\tglobal_load_lds_dwordx4 %1, off\n\ts_mov_b32 m0, %0" : "=&s"(keep) : "v"(gsrc), "s"(lds_dst) : "memory"); }
template <int NDV> __device__ __forceinline__ int v_st(int k, int c) { const int kk = (k & ~0xC) | ((k & 4) << 1) | ((k & 8) >> 1); return ((kk >> 3) * NDV + (c >> 5)) * 512 + ((kk & 7) * 32 + (c & 31)) * 2; }
__device__ __forceinline__ int v_rd_base(int lane) { return ((lane & 3) << 3) | (((lane >> 2) & 3) << 6) | (((lane >> 4) & 1) << 5) | (((lane >> 5) & 1) << 8); }
template <int NDV> constexpr int v_rd_off(int d0, int ks, int half) { return d0 * 512 + ks * (NDV * 1024) + half * (NDV * 512); }
template <int OFF> __device__ __forceinline__ s16x4 tr_read(int vb) {
  s16x4 r; asm volatile("ds_read_b64_tr_b16 %0, %1 offset:%2" : "=&v"(r) : "v"(vb), "i"(OFF) : "memory"); return r;
}
template <int NDV, int D0> __device__ __forceinline__ void pv_one(f32x16& od, int vb, bf16x8 pa0, bf16x8 pa1, bf16x8 pa2, bf16x8 pa3) {
  const s16x4 l0 = tr_read<v_rd_off<NDV>(D0, 0, 0)>(vb), h0 = tr_read<v_rd_off<NDV>(D0, 0, 1)>(vb), l1 = tr_read<v_rd_off<NDV>(D0, 1, 0)>(vb), h1 = tr_read<v_rd_off<NDV>(D0, 1, 1)>(vb);
  const s16x4 l2 = tr_read<v_rd_off<NDV>(D0, 2, 0)>(vb), h2 = tr_read<v_rd_off<NDV>(D0, 2, 1)>(vb), l3 = tr_read<v_rd_off<NDV>(D0, 3, 0)>(vb), h3 = tr_read<v_rd_off<NDV>(D0, 3, 1)>(vb);
  asm volatile("s_waitcnt lgkmcnt(0)" ::: "memory"); SBAR();
#define PK(L, H) (bf16x8){L[0], L[1], L[2], L[3], H[0], H[1], H[2], H[3]}
  od = __builtin_amdgcn_mfma_f32_32x32x16_bf16(pa0, PK(l0, h0), od, 0, 0, 0);
  od = __builtin_amdgcn_mfma_f32_32x32x16_bf16(pa1, PK(l1, h1), od, 0, 0, 0);
  od = __builtin_amdgcn_mfma_f32_32x32x16_bf16(pa2, PK(l2, h2), od, 0, 0, 0);
  od = __builtin_amdgcn_mfma_f32_32x32x16_bf16(pa3, PK(l3, h3), od, 0, 0, 0);
#undef PK
}
template <int NDV> __device__ __forceinline__ void pv_all(f32x16* o, int vb, bf16x8 pa0, bf16x8 pa1, bf16x8 pa2, bf16x8 pa3) {
  pv_one<NDV, 0>(o[0], vb, pa0, pa1, pa2, pa3); pv_one<NDV, 1>(o[1], vb, pa0, pa1, pa2, pa3);
  if constexpr (NDV == 4) { pv_one<NDV, 2>(o[2], vb, pa0, pa1, pa2, pa3); pv_one<NDV, 3>(o[3], vb, pa0, pa1, pa2, pa3); }
}
__device__ __forceinline__ void wmask(f32x16& p0, f32x16& p1, int kd  , int hi) {
#pragma unroll
  for (int r = 0; r < 16; ++r) { const int d = kd + crow(r, hi); if (d < -128 || d > 128) p0[r] = -1e30f; if (d + 32 < -128 || d + 32 > 128) p1[r] = -1e30f; }
}

template <int NQK, int NDV, int NKN>
__device__ __forceinline__ void attn_unit(const UnitP& P, char* lds, const float C, const float THRS, const int wave_s) {
  constexpr int KN_B = NKN * 64 * 256, KP_B = 64 * 128, SHM_K = KN_B + KP_B, SHM_V = 64 * NDV * 64, NVC = NDV / 2  ;
  const int tid_ = tid_from_(wave_s);
  const int tid = tid_, lane = tid & 63, r32 = lane & 31, hi = lane >> 5; const int wid = __builtin_amdgcn_readfirstlane(tid >> 6);
  char* V_lds = lds; char* K_lds = lds + 2 * SHM_V;
  float* ws = (float*)(lds + 2 * SHM_V + 2 * SHM_K) + wid * 64; float* li_l = ws; float* al_l = ws + 32;
  const unsigned lds0 = (unsigned)(uintptr_t)lds;
  float m_reg = -1e30f, l_reg = 0; f32x16 o[NDV]; bf16x8 qr[NQK];
#pragma unroll
  for (int d = 0; d < NDV; ++d) o[d] = f32x16{};
  const int qrow = wid * QBLK + r32;
  unsigned offKn[2], offKp, offV[2];
#pragma unroll
  for (int i = 0; i < 2; ++i) { const int q = i * 512 + tid, row = q >> 4, cp = q & 15, c = (cp & 8) | ((cp & 7) ^ (row & 7)); offKn[i] = (unsigned)(row * P.ldkn + c * 8); }
  { const int row = tid >> 3, cp = tid & 7, c = cp ^ (row & 7); offKp = (unsigned)(row * P.ldkp + c * 8); }
#pragma unroll
  for (int i = 0; i < NVC; ++i) { const int q = i * 512 + tid, sub = q >> 5, rem = q & 31, kk = (sub / NDV) * 8 + (rem >> 2), c = (sub % NDV) * 32 + (rem & 3) * 8;
    const int k = (kk & ~0xC) | ((kk & 4) << 1) | ((kk & 8) >> 1); offV[i] = (unsigned)(k * P.ldv + c); }
#define TROW(j) ((j) < P.n0 ? P.base0 + 64 * (j) : P.base1 + 64 * ((j) - P.n0))
#define DMA_K(j, b) do { const int row0_ = TROW(j); const unsigned kd_ = lds0 + 2 * SHM_V + (b) * SHM_K + wid * 1024; \
    if constexpr (NKN == 1) { const bf16_t* s_ = P.Kn + (size_t)row0_ * P.ldkn; glds16(s_ + offKn[0], kd_); glds16(s_ + offKn[1], kd_ + 8192); } \
    glds16(P.Kp + (size_t)row0_ * P.ldkp + offKp, kd_ + KN_B); } while (0)
#define DMA_V(j, b) do { const int row0_ = TROW(j); const unsigned vd_ = lds0 + (b) * SHM_V + wid * 1024; const bf16_t* s_ = P.V + (size_t)row0_ * P.ldv; \
    glds16(s_ + offV[0], vd_); if constexpr (NVC == 2) glds16(s_ + offV[1], vd_ + 8192); } while (0)
#define WAIT_BAR(N) asm volatile("s_waitcnt vmcnt(" #N ") lgkmcnt(0)\n\ts_barrier" ::: "memory")
#define LBAR() asm volatile("s_waitcnt lgkmcnt(0)\n\ts_barrier" ::: "memory")
#define WAIT_BAR_V() do { if constexpr (NVC == 2) WAIT_BAR(2); else WAIT_BAR(1); } while (0)
  DMA_K(0, 0); DMA_V(0, 0); DMA_K(1, 1);
  const bf16_t* Qw = P.Q + (size_t)qrow * P.ldq + hi * 8;
#pragma unroll
  for (int d0 = 0; d0 < NQK; ++d0) qr[d0] = *reinterpret_cast<const bf16x8*>(Qw + d0 * 16);
  if (P.rope) {
    const int t = P.qpos0 + qrow; const int pr = t >> 6, pc = t & 63;
#pragma unroll
    for (int a = 0; a < 2; ++a) {
      const float* tb = ROPE_TAB + ((a ? pc : pr) * 16 + hi * 8) * 2;
      bf16x8 x1 = qr[NQK - 4 + 2 * a], x2 = qr[NQK - 3 + 2 * a];
#pragma unroll
      for (int j = 0; j < 8; ++j) { const float c = tb[2 * j], s = tb[2 * j + 1]; const float f1 = bf2f((unsigned short)x1[j]), f2 = bf2f((unsigned short)x2[j]);
        x1[j] = (short)f2bf(f1 * c - f2 * s); x2[j] = (short)f2bf(f2 * c + f1 * s); }
      qr[NQK - 4 + 2 * a] = x1; qr[NQK - 3 + 2 * a] = x2;
    }
  }
  const int vb0 = (int)lds0 + v_rd_base(lane);
#define RESC(a) do { if (__any((a) < 1.f)) { if (hi == 0) al_l[r32] = (a); asm volatile("s_waitcnt lgkmcnt(0)" ::: "memory"); \
    _Pragma("unroll") for (int d = 0; d < NDV; ++d) _Pragma("unroll") for (int r = 0; r < 16; ++r) o[d][r] *= al_l[crow(r, hi)]; } } while (0)
#define MASK(P0, P1, j) do { if (P.masked && (j) >= P.n0) { const int kd0_ = P.kpos1 + 64 * ((j) - P.n0) - (P.qpos0 + wid * QBLK); \
    if (kd0_ + 63 > 128 || kd0_ - 31 < -128) wmask(P0, P1, P.kpos1 + 64 * ((j) - P.n0) - (P.qpos0 + qrow), hi); } } while (0)
#define QKT(P0, P1, b) qkt<NQK, NKN>(P0, P1, K_lds + (b) * SHM_K, K_lds + (b) * SHM_K + KN_B, qr, r32, hi)
  f32x16 pA0, pA1, pB0, pB1; float mnA, mnB, alA, alB; bf16x8 pa0, pa1, pa2, pa3; const int NT = P.NT;
  WAIT_BAR(0);
  QKT(pA0, pA1, 0); MASK(pA0, pA1, 0); partialSM(pA0, pA1, m_reg, mnA, alA, C, THRS);
  DMA_V(1, 1);
  for (int j = 1; j + 1 < NT; j += 2) {
    DMA_K(j + 1, 0);
    SBAR(); finishSM(pA0, pA1, alA, l_reg, pa0, pa1, pa2, pa3); SBAR();
    QKT(pB0, pB1, 1); MASK(pB0, pB1, j); SBAR();
    pv_all<NDV>(o, vb0, pa0, pa1, pa2, pa3); partialSM(pB0, pB1, m_reg, mnB, alB, C, THRS);
    LBAR();
    DMA_V(j + 1, 0);
    RESC(alB);
    WAIT_BAR_V();
    DMA_K(j + 2, 1);
    SBAR(); finishSM(pB0, pB1, alB, l_reg, pa0, pa1, pa2, pa3); SBAR();
    QKT(pA0, pA1, 0); MASK(pA0, pA1, j + 1); SBAR();
    pv_all<NDV>(o, vb0 + SHM_V, pa0, pa1, pa2, pa3); partialSM(pA0, pA1, m_reg, mnA, alA, C, THRS);
    LBAR();
    DMA_V(j + 2, 1);
    RESC(alA);
    WAIT_BAR_V();
  }
  SBAR(); finishSM(pA0, pA1, alA, l_reg, pa0, pa1, pa2, pa3); SBAR();
  QKT(pB0, pB1, 1); MASK(pB0, pB1, NT - 1); SBAR();
  pv_all<NDV>(o, vb0, pa0, pa1, pa2, pa3); partialSM(pB0, pB1, m_reg, mnB, alB, C, THRS);
  WAIT_BAR(0); RESC(alB);
  finishSM(pB0, pB1, alB, l_reg, pa0, pa1, pa2, pa3); SBAR();
  pv_all<NDV>(o, vb0 + SHM_V, pa0, pa1, pa2, pa3);
  if (P.has_sink) l_reg += __builtin_amdgcn_exp2f(P.sink * 1.4426950408889634f - m_reg * C);
  if (hi == 0) li_l[r32] = l_reg; asm volatile("s_waitcnt lgkmcnt(0)" ::: "memory");
  float rli[16];
#pragma unroll
  for (int r = 0; r < 16; ++r) rli[r] = __builtin_amdgcn_rcpf(li_l[crow(r, hi)]);
  bf16_t* Ow = P.O + (size_t)(wid * QBLK) * P.ldo;
#pragma unroll
  for (int r = 0; r < 16; ++r) { const int orow = crow(r, hi);
#pragma unroll
    for (int d0 = 0; d0 < NDV; ++d0) Ow[(size_t)orow * P.ldo + d0 * 32 + r32] = f2bf(o[d0][r] * rli[r]); }
  LBAR();
#undef TROW
#undef DMA_K
#undef DMA_V
#undef WAIT_BAR
#undef WAIT_BAR_V
#undef LBAR
#undef RESC
#undef MASK
#undef QKT
}
#undef SBAR
}

struct Ctx {
    unsigned char* lds; LAS unsigned char* lds3;
    int tid, lane, wave, G, bx, vcu;
};

#define LDS_BAR() asm volatile("s_waitcnt lgkmcnt(0)\n\ts_barrier" ::: "memory")
__device__ __forceinline__ Ctx make_ctx(unsigned char* lds, const int wave_s) {
    Ctx T; const int tid_ = tid_from_(wave_s);
    T.lds = lds; T.lds3 = (LAS unsigned char*)lds; T.tid = tid_; T.lane = tid_ & 63; T.wave = __builtin_amdgcn_readfirstlane(tid_ >> 6);
    T.G = gridDim.x; T.bx = blockIdx.x; T.vcu = (T.G % 8 == 0) ? (T.bx % 8) * (T.G / 8) + T.bx / 8 : T.bx;
    return T;
}
__device__ __forceinline__ void transpose_item(const float* W, int K, int N, bf16_t* WT, LAS float* scr, int item, int lane) {
    const int nblk = N / 32, kb = item / nblk, nb = item % nblk, k0 = 64 * kb, n0 = 32 * nb;
    float wv[32];
#pragma unroll
    for (int i = 0; i < 32; ++i) wv[i] = W[(size_t)(k0 + 2 * i + (lane >> 5)) * N + n0 + (lane & 31)];
#pragma unroll
    for (int i = 0; i < 32; ++i) scr[(2 * i + (lane >> 5)) * 33 + (lane & 31)] = wv[i];
    asm volatile("s_waitcnt lgkmcnt(0)" ::: "memory");
    const int c = lane & 7;
#pragma unroll
    for (int j = 0; j < 4; ++j) { const int n = (lane >> 3) + 8 * j; const LAS float* s = scr + (8 * c) * 33 + n;
        u32x4 o; o.x = cvt_pk_bf16(s[0 * 33], s[1 * 33]); o.y = cvt_pk_bf16(s[2 * 33], s[3 * 33]); o.z = cvt_pk_bf16(s[4 * 33], s[5 * 33]); o.w = cvt_pk_bf16(s[6 * 33], s[7 * 33]);
        *(u32x4*)(WT + (size_t)(n0 + n) * K + k0 + 8 * c) = o; }
    asm volatile("s_waitcnt lgkmcnt(0)" ::: "memory");
}

struct Params { const float* in[23]; float* out; unsigned char* ws; int ph_lo, ph_hi; };
enum { I_X = 0, I_C, I_CTX, I_CCTX, I_ADAW, I_ADAB, I_NMIX, I_NMLP, I_WIN, I_QN, I_WUQ, I_KVN, I_WUKV, I_SINK, I_CONVW, I_CONVB, I_LNG, I_LNB, I_ONORM, I_WOUT, I_W1, I_W2, I_FNORM };

__device__ __forceinline__ void prologue_phase(const Ctx& T, const Params& p) {
    float* mod = (float*)(p.ws + WS_MOD);
    {
        float* sil = (float*)T.lds;
        float* red = sil + 5 * DM;
        for (int i = T.tid; i < 5 * DM; i += 512) { const int r = i >> 11, k = i & (DM - 1); const float v = r < 4 ? p.in[I_C][r * DM + k] : p.in[I_CCTX][k]; sil[i] = v * sigmoidf_(v); }
        __syncthreads();
        for (int item = T.bx; item < 2 * 96; item += T.G) {
            const int l = item / 96, cb = item % 96, col = cb * 128 + 2 * T.lane;
            const float* W = p.in[I_ADAW] + (size_t)l * DM * MODW + col;
            float a0[5], a1[5];
#pragma unroll
            for (int r = 0; r < 5; ++r) { a0[r] = 0.f; a1[r] = 0.f; }
            const int k0 = T.wave * 256;
            for (int k = k0; k < k0 + 256; k += 16) {
                f32x2 w[16];
#pragma unroll
                for (int i = 0; i < 16; ++i) w[i] = *(const f32x2*)(W + (size_t)(k + i) * MODW);
#pragma unroll
                for (int i = 0; i < 16; ++i)
#pragma unroll
                    for (int r = 0; r < 5; ++r) { const float s = sil[r * DM + k + i]; a0[r] += s * w[i].x; a1[r] += s * w[i].y; }
            }
#pragma unroll
            for (int r = 0; r < 5; ++r) { red[(T.wave * 5 + r) * 128 + 2 * T.lane] = a0[r]; red[(T.wave * 5 + r) * 128 + 2 * T.lane + 1] = a1[r]; }
            __syncthreads();
            for (int i = T.tid; i < 5 * 128; i += 512) { const int r = i >> 7, cc = i & 127; float s = 0.f;
#pragma unroll
                for (int w = 0; w < 8; ++w) s += red[(w * 5 + r) * 128 + cc];
                mod[(size_t)(l * 5 + r) * MODW + cb * 128 + cc] = s + p.in[I_ADAB][l * MODW + cb * 128 + cc]; }
            __syncthreads();
        }
    }
    {
        LAS float* scr = (LAS float*)(T.lds3 + T.wave * 16384);
        const int gw = T.bx * 8 + T.wave, NGW = T.G * 8;
        constexpr int I_IN = (DM / 64) * (INW / 32), I_UQ = (512 / 64) * (QW / 32), I_UKV = (512 / 64) * (KVW / 32), I_OUT = (DM / 64) * (DM / 32), I_1 = (DM / 64) * (FF / 32), I_2 = (FF / 64) * (DM / 32);
        constexpr int PER_L = I_IN + I_UQ + I_UKV + I_OUT + I_1 + I_2;
        for (int it = gw; it < 2 * PER_L; it += NGW) {
            const int l = it / PER_L; int r = it % PER_L;
            unsigned char* wl = p.ws + WS_WL + (size_t)l * WL_SIZE;
            if (r < I_IN) { transpose_item(p.in[I_WIN] + (size_t)l * DM * INW, DM, INW, (bf16_t*)(wl + WL_IN), scr, r, T.lane); continue; } r -= I_IN;
            if (r < I_UQ) { transpose_item(p.in[I_WUQ] + (size_t)l * 512 * QW, 512, QW, (bf16_t*)(wl + WL_UQ), scr, r, T.lane); continue; } r -= I_UQ;
            if (r < I_UKV) { transpose_item(p.in[I_WUKV] + (size_t)l * 512 * KVW, 512, KVW, (bf16_t*)(wl + WL_UKV), scr, r, T.lane); continue; } r -= I_UKV;
            if (r < I_OUT) { transpose_item(p.in[I_WOUT] + (size_t)l * DM * DM, DM, DM, (bf16_t*)(wl + WL_OUT), scr, r, T.lane); continue; } r -= I_OUT;
            if (r < I_1) { transpose_item(p.in[I_W1] + (size_t)l * DM * FF, DM, FF, (bf16_t*)(wl + WL_W1), scr, r, T.lane); continue; } r -= I_1;
            transpose_item(p.in[I_W2] + (size_t)l * FF * DM, FF, DM, (bf16_t*)(wl + WL_W2), scr, r, T.lane);
        }
        const int gt = T.bx * 512 + T.tid, NGT = T.G * 512;
        constexpr int PADV = (INWP - INW) * DM * 2 / 16;
        for (int i = gt; i < 2 * PADV; i += NGT) { const int l = i / PADV, j = i % PADV;
            *(u32x4*)(p.ws + WS_WL + (size_t)l * WL_SIZE + WL_IN + (size_t)INW * DM * 2 + (size_t)j * 16) = (u32x4){0u, 0u, 0u, 0u}; }
    }
}

template <int TR, bool SLABS>
__device__ __forceinline__ void norm_tile(const Ctx& T, float* red, const float* xb  , const f32x4 gs, const f32x4 sh4, bf16_t* ob  ,
                                          const float* sb  , const f32x4 gt, float* xo  ) {
    f32x4 v[TR];
#pragma unroll
    for (int i = 0; i < TR; ++i) v[i] = *(const f32x4*)(xb + (size_t)i * DM);
    if constexpr (SLABS) {
        f32x4 sv[TR][8];
#pragma unroll
        for (int i = 0; i < TR; ++i)
#pragma unroll
            for (int sl = 0; sl < 8; ++sl) sv[i][sl] = *(const f32x4*)(sb + ((size_t)sl * NCTXR + i) * DM);
#pragma unroll
        for (int i = 0; i < TR; ++i) { const f32x4 a = ((sv[i][0] + sv[i][1]) + (sv[i][2] + sv[i][3])) + ((sv[i][4] + sv[i][5]) + (sv[i][6] + sv[i][7]));
            v[i] += gt * a; *(f32x4*)(xo + (size_t)i * DM) = v[i]; }
    }
    { float ss[TR];
#pragma unroll
      for (int i = 0; i < TR; ++i) ss[i] = (v[i].x * v[i].x + v[i].y * v[i].y) + (v[i].z * v[i].z + v[i].w * v[i].w);
      wave_sum_n<TR>(ss, T.lane);
#pragma unroll
      for (int i = 0; i < TR; ++i) if (T.lane == i) red[i * 8 + T.wave] = ss[i]; }
    LDS_BAR();
#pragma unroll
    for (int i = 0; i < TR; ++i) { const f32x4 a = *(const f32x4*)(red + i * 8), b = *(const f32x4*)(red + i * 8 + 4);
        const float rstd = 1.0f / sqrtf((((a.x + a.y) + (a.z + a.w)) + ((b.x + b.y) + (b.z + b.w))) * (1.0f / DM) + EPS);
        const f32x4 y = v[i] * rstd * gs + sh4;
        u32x2 w; w.x = cvt_pk_bf16(y.x, y.y); w.y = cvt_pk_bf16(y.z, y.w); *(u32x2*)(ob + (size_t)i * DM) = w; }
    LDS_BAR();
}
__device__ __forceinline__ void modnorm_phase(const Ctx& T, const float* src_lat, const float* src_ctx, int nrows, const float* gw, const float* modl, int sh_off, int sc_off, bf16_t* out, const float* slab, const float* gate, float* xout) {
    float* red = (float*)T.lds;
    const int col = 4 * T.tid;
    const f32x4 g4 = *(const f32x4*)(gw + col);
    for (int t = T.bx; t < NLAT / 16; t += T.G) {
        const int r0 = t * 16; const float* mr = modl + (size_t)(r0 >> 12) * MODW + col;
        const f32x4 gs = g4 * (*(const f32x4*)(mr + sc_off) + 1.0f), sh4 = *(const f32x4*)(mr + sh_off);
        norm_tile<16, false>(T, red, src_lat + (size_t)r0 * DM + col, gs, sh4, out + (size_t)r0 * DM + col, nullptr, gs, nullptr);
    }
    if (nrows > NLAT) {
        const float* mr = modl + (size_t)4 * MODW + col;
        const f32x4 gs = g4 * (*(const f32x4*)(mr + sc_off) + 1.0f), sh4 = *(const f32x4*)(mr + sh_off);
        for (int t = T.bx; t < NCTXR / 4; t += T.G) {
            const int rc = t * 4;
            if (slab) { const f32x4 gt = *(const f32x4*)(gate + (size_t)4 * MODW + col);
                norm_tile<4, true>(T, red, src_ctx + (size_t)rc * DM + col, gs, sh4, out + (size_t)(NLAT + rc) * DM + col, slab + (size_t)rc * DM + col, gt, xout + (size_t)(NLAT + rc) * DM + col); }
            else norm_tile<4, false>(T, red, src_ctx + (size_t)rc * DM + col, gs, sh4, out + (size_t)(NLAT + rc) * DM + col, nullptr, gs, nullptr);
        }
    }
}
__device__ __forceinline__ void finalnorm_phase(const Ctx& T, const float* x, const float* gw, float* out) {
    constexpr int TR = 16;
    float* red = (float*)T.lds;
    const int col = 4 * T.tid;
    const f32x4 g4 = *(const f32x4*)(gw + col);
    for (int t = T.bx; t < NLAT / TR; t += T.G) {
        const int r0 = t * TR;
        f32x4 v[TR];
#pragma unroll
        for (int i = 0; i < TR; ++i) v[i] = *(const f32x4*)(x + (size_t)(r0 + i) * DM + col);
        { float ss[TR];
#pragma unroll
          for (int i = 0; i < TR; ++i) ss[i] = (v[i].x * v[i].x + v[i].y * v[i].y) + (v[i].z * v[i].z + v[i].w * v[i].w);
          wave_sum_n<TR>(ss, T.lane);
#pragma unroll
          for (int i = 0; i < TR; ++i) if (T.lane == i) red[i * 8 + T.wave] = ss[i]; }
        LDS_BAR();
#pragma unroll
        for (int i = 0; i < TR; ++i) { const f32x4 a = *(const f32x4*)(red + i * 8), b = *(const f32x4*)(red + i * 8 + 4);
            const float rstd = 1.0f / sqrtf((((a.x + a.y) + (a.z + a.w)) + ((b.x + b.y) + (b.z + b.w))) * (1.0f / DM) + EPS);
            *(f32x4*)(out + (size_t)(r0 + i) * DM + col) = v[i] * rstd * g4; }
        LDS_BAR();
    }
}

__device__ __forceinline__ void unpack8(const u32x4 w, float* f) { f[0] = bflo(w.x); f[1] = bfhi(w.x); f[2] = bflo(w.y); f[3] = bfhi(w.y); f[4] = bflo(w.z); f[5] = bfhi(w.z); f[6] = bflo(w.w); f[7] = bfhi(w.w); }
__device__ __forceinline__ u32x4 pack8(const float* f) { u32x4 w; w.x = cvt_pk_bf16(f[0], f[1]); w.y = cvt_pk_bf16(f[2], f[3]); w.z = cvt_pk_bf16(f[4], f[5]); w.w = cvt_pk_bf16(f[6], f[7]); return w; }

__device__ __forceinline__ void prep_phase(const Ctx& T, bf16_t* U, const float* qn, const float* kvn) {
    constexpr int RR = 4;
    const int gwv = T.bx * 8 + T.wave, NGW = T.G * 8, lane = T.lane;
    float gq[8], gk[8];
#pragma unroll
    for (int j = 0; j < 8; ++j) { gq[j] = qn[8 * lane + j]; gk[j] = kvn[8 * lane + j]; }
    const int a = (lane >> 4) & 1, fi = lane & 15;
    for (int r0 = gwv * RR; r0 < NROW; r0 += NGW * RR) {
        u32x4 vq[RR], vk[RR], va[RR], vg[RR]; unsigned short x1a[RR], x2a[RR], x1b[RR], x2b[RR]; f32x2 rcs[RR];
        const bool lat = r0 < NLAT;
        const int ia = U_AKR + 32 * a + fi, ib = U_BK + (lane >> 5) * 64 + 32 * a + fi;
#pragma unroll
        for (int i = 0; i < RR; ++i) { const bf16_t* ur = U + (size_t)(r0 + i) * INWP;
            vq[i] = ((const u32x4*)(ur + U_AQ))[lane]; vk[i] = ((const u32x4*)(ur + U_AKV))[lane]; va[i] = ((const u32x4*)(ur + U_CA))[lane]; vg[i] = ((const u32x4*)(ur + U_CG))[lane];
            if (lat) { x1a[i] = ur[ia]; x2a[i] = ur[ia + 16]; x1b[i] = ur[ib]; x2b[i] = ur[ib + 16];
                const int t = (r0 + i) & (SEQ - 1), pos = a ? (t & 63) : (t >> 6); rcs[i] = *(const f32x2*)(ROPE_TAB + (pos * 16 + fi) * 2); } }
        float ssq[2 * RR];
#pragma unroll
        for (int i = 0; i < RR; ++i) { float f[8]; unpack8(vq[i], f); float s = 0.f;
#pragma unroll
            for (int j = 0; j < 8; ++j) s += f[j] * f[j];
            ssq[2 * i] = s; unpack8(vk[i], f); s = 0.f;
#pragma unroll
            for (int j = 0; j < 8; ++j) s += f[j] * f[j];
            ssq[2 * i + 1] = s; }
        wave_sum_n<2 * RR>(ssq, lane);
#pragma unroll
        for (int i = 0; i < RR; ++i) { bf16_t* ur = U + (size_t)(r0 + i) * INWP; float f[8];
            { unpack8(vq[i], f); const float rstd = 1.0f / sqrtf(ssq[2 * i] * (1.0f / 512.0f) + EPS);
#pragma unroll
              for (int j = 0; j < 8; ++j) f[j] = f[j] * rstd * gq[j];
              ((u32x4*)(ur + U_AQ))[lane] = pack8(f); }
            { unpack8(vk[i], f); const float rstd = 1.0f / sqrtf(ssq[2 * i + 1] * (1.0f / 512.0f) + EPS);
#pragma unroll
              for (int j = 0; j < 8; ++j) f[j] = f[j] * rstd * gk[j];
              ((u32x4*)(ur + U_AKV))[lane] = pack8(f); }
            if (lat) {
                const float c = rcs[i].x, s = rcs[i].y;
                if (lane < 32) { const float x1 = bf2f(x1a[i]), x2 = bf2f(x2a[i]); ur[ia] = f2bf(x1 * c - x2 * s); ur[ia + 16] = f2bf(x2 * c + x1 * s); }
                { const float x1 = bf2f(x1b[i]), x2 = bf2f(x2b[i]); ur[ib] = f2bf(x1 * c - x2 * s); ur[ib + 16] = f2bf(x2 * c + x1 * s); }
            }
            { float fg[8]; unpack8(va[i], f); unpack8(vg[i], fg);
#pragma unroll
              for (int j = 0; j < 8; ++j) f[j] = f[j] * sigmoidf_(fg[j]);
              ((u32x4*)(ur + U_CA))[lane] = pack8(f); }
        }
    }
}

__device__ __forceinline__ void mergenorm_phase(const Ctx& T, bf16_t* MIX, const float* on, int nrows) {
    constexpr int RR = 4;
    const int gwv = T.bx * 8 + T.wave, NGW = T.G * 8, lane = T.lane;
    float g0[8], g1[8], g2[8], g3[8];
#pragma unroll
    for (int j = 0; j < 8; ++j) { g0[j] = on[8 * lane + j]; g1[j] = on[512 + 8 * lane + j]; g2[j] = on[1024 + 8 * lane + j]; g3[j] = on[1536 + 8 * lane + j]; }
    for (int r0 = gwv * RR; r0 < nrows; r0 += NGW * RR) {
        u32x4 v0[RR], v1[RR], v2[RR], v3[RR];
#pragma unroll
        for (int i = 0; i < RR; ++i) { const u32x4* mr = (const u32x4*)(MIX + (size_t)(r0 + i) * MIXW) + lane; v0[i] = mr[0]; v1[i] = mr[64]; v2[i] = mr[128]; v3[i] = mr[192]; }
        float ssq[3 * RR];
#pragma unroll
        for (int i = 0; i < RR; ++i) { float f[8], h[8]; unpack8(v0[i], f); unpack8(v1[i], h); float s = 0.f;
#pragma unroll
            for (int j = 0; j < 8; ++j) s += f[j] * f[j] + h[j] * h[j];
            ssq[3 * i] = s; unpack8(v2[i], f); s = 0.f;
#pragma unroll
            for (int j = 0; j < 8; ++j) s += f[j] * f[j];
            ssq[3 * i + 1] = s; unpack8(v3[i], f); s = 0.f;
#pragma unroll
            for (int j = 0; j < 8; ++j) s += f[j] * f[j];
            ssq[3 * i + 2] = s; }
        wave_sum_n<3 * RR>(ssq, lane);
#pragma unroll
        for (int i = 0; i < RR; ++i) { u32x4* mr = (u32x4*)(MIX + (size_t)(r0 + i) * MIXW) + lane; float f[8], h[8];
            { unpack8(v0[i], f); unpack8(v1[i], h); const float rstd = 1.0f / sqrtf(ssq[3 * i] * (1.0f / 1024.0f) + EPS);
#pragma unroll
              for (int j = 0; j < 8; ++j) { f[j] = f[j] * rstd * g0[j]; h[j] = h[j] * rstd * g1[j]; }
              mr[0] = pack8(f); mr[64] = pack8(h); }
            { unpack8(v2[i], f); const float rstd = 1.0f / sqrtf(ssq[3 * i + 1] * (1.0f / 512.0f) + EPS);
#pragma unroll
              for (int j = 0; j < 8; ++j) f[j] = f[j] * rstd * g2[j];
              mr[128] = pack8(f); }
            { unpack8(v3[i], f); const float rstd = 1.0f / sqrtf(ssq[3 * i + 2] * (1.0f / 512.0f) + EPS);
#pragma unroll
              for (int j = 0; j < 8; ++j) f[j] = f[j] * rstd * g3[j];
              mr[192] = pack8(f); }
        }
    }
}

__device__ __forceinline__ void conv_phase(const Ctx& T, const bf16_t* U, bf16_t* MIX, const float* cw, const float* cb, const float* lng, const float* lnb, int nitems) {
    constexpr int CR = 16, NL = CR + 30;
    const int c = T.tid;
    float w[31];
#pragma unroll
    for (int k = 0; k < 31; ++k) w[k] = cw[k * 512 + c];
    const float bias = cb[c], g = lng[c], b = lnb[c];
    float* red = (float*)T.lds;
    unsigned short hv[NL], hn[NL];
#define CONV_LOAD(dst, it) do { const int r0_ = (it) * CR; int s0_, s1_; \
        if (r0_ < NLAT) { s0_ = r0_ & ~(SEQ - 1); s1_ = s0_ + SEQ; } else { s0_ = NLAT + ((r0_ - NLAT) & ~(CTXL - 1)); s1_ = s0_ + CTXL; } \
        _Pragma("unroll") for (int j = 0; j < NL; ++j) { int rr = r0_ - 15 + j; rr = rr < s0_ ? s0_ : (rr >= s1_ ? s1_ - 1 : rr); dst[j] = U[(size_t)rr * INWP + U_CA + c]; } } while (0)
    int item = T.bx; asm volatile("" : "+s"(item));
    if (item < nitems) CONV_LOAD(hv, item);
    while (item < nitems) {
        const int nxt = item + T.G;
        if (nxt < nitems) CONV_LOAD(hn, nxt);
        const int r0 = item * CR;
        int seg0, seg1;
        if (r0 < NLAT) { seg0 = r0 & ~(SEQ - 1); seg1 = seg0 + SEQ; } else { seg0 = NLAT + ((r0 - NLAT) & ~(CTXL - 1)); seg1 = seg0 + CTXL; }
        float acc[CR];
#pragma unroll
        for (int i = 0; i < CR; ++i) acc[i] = bias;
#pragma unroll
        for (int j = 0; j < NL; ++j) {
            const int rr = r0 - 15 + j;
            const float v = (rr >= seg0 && rr < seg1) ? bf2f(hv[j]) : 0.f;
#pragma unroll
            for (int i = 0; i < CR; ++i) { const int k = j - i; if (k >= 0 && k < 31) acc[i] += w[k] * v; }
        }
        float s[2 * CR];
#pragma unroll
        for (int i = 0; i < CR; ++i) { s[i] = acc[i]; s[CR + i] = acc[i] * acc[i]; }
        wave_sum_n<2 * CR>(s, T.lane);
#pragma unroll
        for (int q = 0; q < 2 * CR; ++q) if (T.lane == q) red[T.wave * 2 * CR + q] = s[q];
        LDS_BAR();
#pragma unroll
        for (int i = 0; i < CR; ++i) {
            float sm = 0.f, sq = 0.f;
#pragma unroll
            for (int wv = 0; wv < 8; ++wv) { sm += red[wv * 2 * CR + i]; sq += red[wv * 2 * CR + CR + i]; }
            const float mean = sm * (1.0f / 512.0f); const float var = fmaxf(sq * (1.0f / 512.0f) - mean * mean, 0.f);
            const float y = (acc[i] - mean) * __builtin_amdgcn_rsqf(var + EPS) * g + b;
            MIX[(size_t)(r0 + i) * MIXW + 1536 + c] = f2bf(y * sigmoidf_(y));
        }
        LDS_BAR();
#pragma unroll
        for (int j = 0; j < NL; ++j) hv[j] = hn[j];
        item = nxt;
    }
#undef CONV_LOAD
}

#define XB_TMO      128
#define XB_XCNT(j)  (256  + 64 * (j))
#define XB_XSUB(j)  (1280 + 64 * (j))
#define XB_XGEN(j)  (2304 + 64 * (j))
#define XB_TOP      3328
#define XB_TOPGEN   3392
#define XCD_BAR_WORDS 3456
#define XB_SPIN_CAP (1u << 20)
__device__ __forceinline__ unsigned xb_ld(unsigned* p)              { return __hip_atomic_load(p, __ATOMIC_RELAXED, __HIP_MEMORY_SCOPE_AGENT); }
__device__ __forceinline__ unsigned xb_add(unsigned* p, unsigned v) { return __hip_atomic_fetch_add(p, v, __ATOMIC_RELAXED, __HIP_MEMORY_SCOPE_AGENT); }
__device__ __forceinline__ unsigned xb_xcc_id() { return (unsigned)__builtin_amdgcn_s_getreg((3 << 11) | 20) & 0xFu; }
#define XB_SPIN(cond, bar) do { unsigned _sp = 0; while (cond) { __builtin_amdgcn_s_sleep(1); \
    if ((++_sp & 255u) == 0u) { if (xb_ld(&(bar)[XB_TMO])) break; if (_sp > XB_SPIN_CAP) { atomicAdd(&(bar)[XB_TMO], 1u); break; } } } } while (0)
struct XcdBarrier { unsigned* bar; unsigned x; volatile LAS unsigned* st; };
__device__ __forceinline__ XcdBarrier xcd_barrier_post(unsigned* bar, volatile LAS unsigned* st, const int tid) {
    XcdBarrier b; b.bar = bar; b.x = xb_xcc_id(); b.st = st;
    if (tid == 0) (void)xb_add(&bar[XB_XCNT(b.x)], 1u);
    return b;
}
__device__ __forceinline__ void xcd_barrier_complete(unsigned* bar, unsigned x, unsigned& nloc, unsigned& nx) {
    const unsigned G = gridDim.x * gridDim.y * gridDim.z;
    unsigned sum, cnt, mine, sp = 0u;
    for (;;) {
        sum = 0u; cnt = 0u; mine = 0u;
#pragma unroll
        for (unsigned j = 0; j < 16; ++j) { const unsigned c = xb_ld(&bar[XB_XCNT(j)]); sum += c; cnt += (c > 0u) ? 1u : 0u; mine = (j == x) ? c : mine; }
        if (sum == G) break;
        __builtin_amdgcn_s_sleep(1);
        if ((++sp & 255u) == 0u) { if (xb_ld(&bar[XB_TMO])) break; if (sp > XB_SPIN_CAP) { atomicAdd(&bar[XB_TMO], 1u); break; } }
    }
    nloc = mine > 0u ? mine : 1u; nx = cnt > 0u ? cnt : 1u;
}
__device__ __forceinline__ void xcd_barrier(const XcdBarrier& b, const int tid) {
    asm volatile("s_waitcnt vmcnt(0)" ::: "memory");
    __syncthreads();
    if (tid == 0) {
        unsigned* bar = b.bar;
        __builtin_amdgcn_s_waitcnt(0);
        unsigned nloc = b.st[0], nx = b.st[1];
        if (nloc == 0u) { xcd_barrier_complete(bar, b.x, nloc, nx); b.st[0] = nloc; b.st[1] = nx; }
        const unsigned old = xb_add(&bar[XB_XSUB(b.x)], 1u);
        const unsigned gen = old / nloc;
        if (old + 1u == (gen + 1u) * nloc) {
            __builtin_amdgcn_fence(__ATOMIC_RELEASE, "agent");
            asm volatile("s_waitcnt vmcnt(0)" ::: "memory");
            const unsigned og = xb_add(&bar[XB_TOP], 1u);
            const unsigned tg = og / nx;
            if (og + 1u == (tg + 1u) * nx) xb_add(&bar[XB_TOPGEN], 1u);
            else XB_SPIN(xb_ld(&bar[XB_TOPGEN]) == tg, bar);
            __builtin_amdgcn_fence(__ATOMIC_ACQUIRE, "agent");
            xb_add(&bar[XB_XGEN(b.x)], 1u);
            asm volatile("s_waitcnt vmcnt(0)" ::: "memory");
        } else {
            XB_SPIN(xb_ld(&bar[XB_XGEN(b.x)]) == gen, bar);
            __builtin_amdgcn_fence(__ATOMIC_ACQUIRE, "agent");
            asm volatile("s_waitcnt vmcnt(0)" ::: "memory");
        }
    }
    __syncthreads();
}

#ifndef PH_MASK
#define PH_MASK 0xFFFF
#endif
#ifndef DUP_MASK
#define DUP_MASK 0
#endif
#ifndef DUP_SUB
#define DUP_SUB 0
#endif
#ifndef DUP_BAR
#define DUP_BAR 0
#endif
#ifndef DUP_L
#define DUP_L 3
#endif
__global__ void __launch_bounds__(512, 2) mega_fwd(Params p) {
    extern __shared__ __attribute__((aligned(16))) unsigned char lds[];
    cg::grid_group grid = cg::this_grid();
    unsigned char* ws = p.ws;
    float* mod = (float*)(ws + WS_MOD);
    float* XB = (float*)(ws + WS_X);
    bf16_t* HN = (bf16_t*)(ws + WS_HN); bf16_t* U = (bf16_t*)(ws + WS_U); bf16_t* QB = (bf16_t*)(ws + WS_Q); bf16_t* KVB = (bf16_t*)(ws + WS_KV);
    bf16_t* MIX = (bf16_t*)(ws + WS_MIX); bf16_t* ACT = (bf16_t*)(ws + WS_ACT); float* SLAB = (float*)(ws + WS_SLAB);
    const int wave_s = __builtin_amdgcn_readfirstlane((int)threadIdx.x >> 6);
    { volatile LAS unsigned* m = (volatile LAS unsigned*)((LAS unsigned char*)lds + 131072); const int t0 = tid_from_(wave_s); if (t0 < 64) m[t0] = 0u; }
    __syncthreads();
    if (p.ph_hi - p.ph_lo > 1) (void)xcd_barrier_post((unsigned*)(ws + WS_CTL), (volatile LAS unsigned*)((LAS unsigned char*)lds + 131072) + 8, tid_from_(wave_s));
    int ph = 0; int l_ = 0;
#define RUN(k) ((k) >= p.ph_lo && (k) < p.ph_hi)
#define GBAR() do { XcdBarrier xb_; xb_.bar = (unsigned*)(p.ws + WS_CTL); xb_.x = xb_xcc_id(); xb_.st = (volatile LAS unsigned*)((LAS unsigned char*)lds + 131072) + 8; xcd_barrier(xb_, tid_from_(wave_s)); } while (0)
#define SEAM() do { if (ph >= p.ph_lo && ph + 1 < p.ph_hi) { if (p.ph_lo < 0) grid.sync();   for (int rb_ = 0; rb_ <= DUP_BAR; ++rb_) { XcdBarrier xb_; xb_.bar = (unsigned*)(p.ws + WS_CTL); xb_.x = xb_xcc_id(); xb_.st = (volatile LAS unsigned*)((LAS unsigned char*)lds + 131072) + 8; xcd_barrier(xb_, tid_from_(wave_s)); } } ++ph; } while (0)

    if (((PH_MASK >> 0) & 1) && RUN(ph)) { for (int rep_ = 0; rep_ < 1 + ((DUP_MASK >> 0) & 1) * ((DUP_L >> l_) & 1); ++rep_) { if (rep_) GBAR(); { const Ctx T = make_ctx(lds, wave_s); prologue_phase(T, p); } } }
    SEAM();

    for (int l = 0; l < DEPTH; ++l) { l_ = l;
        const unsigned char* wl = ws + WS_WL + (size_t)l * WL_SIZE;
        const float* modl = mod + (size_t)l * 5 * MODW;
        const float* res_lat = l == 0 ? p.in[I_X] : XB;
        const float* res_ctx = l == 0 ? p.in[I_CTX] : XB + (size_t)NLAT * DM;
        const int mrows = l == 0 ? NROW : NLAT;
        if (((PH_MASK >> 1) & 1) && RUN(ph)) { for (int rep_ = 0; rep_ < 1 + ((DUP_MASK >> 1) & 1) * ((DUP_L >> l_) & 1); ++rep_) { if (rep_) GBAR(); { const Ctx T = make_ctx(lds, wave_s); modnorm_phase(T, res_lat, res_ctx, NROW, p.in[I_NMIX] + l * DM, modl, 0 * DM, 1 * DM, HN, l == 1 ? SLAB : nullptr, mod + 5 * DM, XB); } } }
        SEAM();
        if (((PH_MASK >> 2) & 1) && RUN(ph)) { for (int rep_ = 0; rep_ < 1 + ((DUP_MASK >> 2) & 1) * ((DUP_L >> l_) & 1); ++rep_) { if (rep_) GBAR(); { const Ctx T = make_ctx(lds, wave_s);  pg8::Gemm g{HN, (const bf16_t*)(wl + WL_IN), NROW, INWP, DM, DM}; pg8::StaticOrder S; S.init(NROW, INWP, T.G, T.bx, DM);
            pg8::EpiBf16<0> E{U, INWP}; pg8::gemm_phase<pg8::EpiBf16<0>, pg8::StaticOrder, true, true>(T.lds3, g, S, E, wave_s); } } }
        SEAM();
        if (((PH_MASK >> 3) & 1) && RUN(ph)) { for (int rep_ = 0; rep_ < 1 + ((DUP_MASK >> 3) & 1) * ((DUP_L >> l_) & 1); ++rep_) { if (rep_) GBAR(); { const Ctx T = make_ctx(lds, wave_s); prep_phase(T, U, p.in[I_QN] + l * 512, p.in[I_KVN] + l * 512); } } }
        SEAM();
        if (((PH_MASK >> 4) & 1) && RUN(ph)) { for (int rep_ = 0; rep_ < 1 + ((DUP_MASK >> 4) & 1) * ((DUP_L >> l_) & 1); ++rep_) { if (rep_) GBAR(); { const Ctx T = make_ctx(lds, wave_s);
            for (int gi = 0; gi < 2; ++gi) {
                const int Mg = gi == 0 ? mrows : NROW, Ng = gi == 0 ? QW : KVW;
                pg8::Gemm g{U + (gi == 0 ? U_AQ : U_AKV), (const bf16_t*)(wl + (gi == 0 ? WL_UQ : WL_UKV)), Mg, Ng, 512, INWP}; pg8::StaticOrder S; S.init(Mg, Ng, T.G, T.bx, 512);
                pg8::EpiBf16<0> E{gi == 0 ? QB : KVB, Ng}; pg8::gemm_phase<pg8::EpiBf16<0>, pg8::StaticOrder, true, true>(T.lds3, g, S, E, wave_s);
            }
        } } }
        SEAM();
        if (((PH_MASK >> 5) & 1) && RUN(ph)) { for (int rep_ = 0; rep_ < 1 + ((DUP_MASK >> 5) & 1) * ((DUP_L >> l_) & 1); ++rep_) { if (rep_) GBAR(); { const Ctx T = make_ctx(lds, wave_s);
            const float CA = MLA_SCALE * 1.4426950408889634f, CB = SWA_SCALE * 1.4426950408889634f;
            const int nu = l == 0 ? 544 : 512;
            for (int rs_ = 0; rs_ < 1 + (DUP_SUB & 1); ++rs_)
            for (int u = T.vcu; u < nu; u += T.G) {
                att::UnitP P; P.ldq = QW; P.ldkn = KVW; P.Kp = U + U_AKR; P.ldkp = INWP; P.ldv = KVW; P.ldo = MIXW; P.masked = 0; P.kpos1 = 0; P.has_sink = 0; P.sink = 0.f;
                if (u < 512) { const int bh = u >> 4, qb = u & 15, b = bh >> 3, h = bh & 7; const size_t q0 = (size_t)b * SEQ + qb * 256;
                    P.Q = QB + q0 * QW + h * 192; P.Kn = KVB + h * 256; P.V = KVB + h * 256 + 128; P.O = MIX + q0 * MIXW + h * 128;
                    P.base0 = b * SEQ; P.n0 = 64; P.base1 = NLAT + b * CTXL; P.NT = 68; P.qpos0 = qb * 256; P.rope = 1; }
                else { const int bh = u - 512, b = bh >> 3, h = bh & 7; const size_t q0 = (size_t)NLAT + b * CTXL;
                    P.Q = QB + q0 * QW + h * 192; P.Kn = KVB + h * 256; P.V = KVB + h * 256 + 128; P.O = MIX + q0 * MIXW + h * 128;
                    P.base0 = NLAT + b * CTXL; P.n0 = 4; P.base1 = 0; P.NT = 4; P.qpos0 = 0; P.rope = 0; }
#ifndef NO_MLA
                att::attn_unit<12, 4, 1>(P, (char*)lds, CA, att::THR / MLA_SCALE, wave_s);
#endif
            }
            for (int rs_ = 0; rs_ < 1 + ((DUP_SUB >> 1) & 1); ++rs_)
            for (int u = T.vcu; u < nu; u += T.G) {
                att::UnitP P; P.ldq = INWP; P.Kn = nullptr; P.ldkn = 0; P.ldkp = INWP; P.ldv = INWP; P.ldo = MIXW; P.has_sink = 1;
                if (u < 512) { const int bh = u >> 4, qb = u & 15, b = bh >> 3, h = bh & 7, kvh = h >> 2; const size_t q0 = (size_t)b * SEQ + qb * 256;
                    const int kt0 = qb * 256 - 128 < 0 ? 0 : qb * 256 - 128, kt1 = qb * 256 + 384 > SEQ ? SEQ : qb * 256 + 384;
                    P.Q = U + q0 * INWP + U_BQ + h * 64; P.Kp = U + U_BK + kvh * 64; P.V = U + U_BV + kvh * 64; P.O = MIX + q0 * MIXW + 1024 + h * 64;
                    P.base0 = NLAT + b * CTXL; P.n0 = 4; P.base1 = b * SEQ + kt0; P.NT = 4 + (kt1 - kt0) / 64; P.masked = 1; P.kpos1 = kt0; P.qpos0 = qb * 256; P.rope = 1; P.sink = p.in[I_SINK][l * 8 + h]; }
                else { const int bh = u - 512, b = bh >> 3, h = bh & 7, kvh = h >> 2; const size_t q0 = (size_t)NLAT + b * CTXL;
                    P.Q = U + q0 * INWP + U_BQ + h * 64; P.Kp = U + U_BK + kvh * 64; P.V = U + U_BV + kvh * 64; P.O = MIX + q0 * MIXW + 1024 + h * 64;
                    P.base0 = NLAT + b * CTXL; P.n0 = 4; P.base1 = 0; P.NT = 4; P.masked = 0; P.kpos1 = 0; P.qpos0 = 0; P.rope = 0; P.sink = p.in[I_SINK][l * 8 + h]; }
#ifndef NO_SWA
                att::attn_unit<4, 2, 0>(P, (char*)lds, CB, att::THR / SWA_SCALE, wave_s);
#endif
            }
#ifndef NO_CONV
            for (int rs_ = 0; rs_ < 1 + ((DUP_SUB >> 2) & 1); ++rs_)
            { const Ctx T2 = make_ctx(lds, wave_s);
            conv_phase(T2, U, MIX, p.in[I_CONVW] + l * 31 * 512, p.in[I_CONVB] + l * 512, p.in[I_LNG] + l * 512, p.in[I_LNB] + l * 512, mrows / 16); }
#endif
        } } }
        SEAM();
        if (((PH_MASK >> 6) & 1) && RUN(ph)) { for (int rep_ = 0; rep_ < 1 + ((DUP_MASK >> 6) & 1) * ((DUP_L >> l_) & 1); ++rep_) { if (rep_) GBAR(); { const Ctx T = make_ctx(lds, wave_s); mergenorm_phase(T, MIX, p.in[I_ONORM] + l * MIXW, mrows); } } }
        SEAM();
        if (((PH_MASK >> 7) & 1) && RUN(ph)) { for (int rep_ = 0; rep_ < 1 + ((DUP_MASK >> 7) & 1) * ((DUP_L >> l_) & 1); ++rep_) { if (rep_) GBAR(); { const Ctx T = make_ctx(lds, wave_s);  pg8::Gemm g{MIX, (const bf16_t*)(wl + WL_OUT), mrows, DM, DM, DM}; pg8::CtxSplitOrder S; S.init(DM, T.G, T.bx, DM, l == 0);
            pg8::EpiResid E{res_lat, res_ctx, XB, modl + 2 * DM, SLAB}; pg8::gemm_phase<pg8::EpiResid, pg8::CtxSplitOrder, true, true>(T.lds3, g, S, E, wave_s); } } }
        SEAM();
        if (((PH_MASK >> 8) & 1) && RUN(ph)) { for (int rep_ = 0; rep_ < 1 + ((DUP_MASK >> 8) & 1) * ((DUP_L >> l_) & 1); ++rep_) { if (rep_) GBAR(); { const Ctx T = make_ctx(lds, wave_s); modnorm_phase(T, XB, l == 0 ? p.in[I_CTX] : XB + (size_t)NLAT * DM, mrows, p.in[I_NMLP] + l * DM, modl, 3 * DM, 4 * DM, HN, l == 0 ? SLAB : nullptr, mod + 2 * DM, XB); } } }
        SEAM();
        if (((PH_MASK >> 9) & 1) && RUN(ph)) { for (int rep_ = 0; rep_ < 1 + ((DUP_MASK >> 9) & 1) * ((DUP_L >> l_) & 1); ++rep_) { if (rep_) GBAR(); { const Ctx T = make_ctx(lds, wave_s);  pg8::Gemm g{HN, (const bf16_t*)(wl + WL_W1), mrows, FF, DM, DM}; pg8::StaticOrder S; S.init(mrows, FF, T.G, T.bx, DM);
            pg8::EpiBf16<2> E{ACT, FF}; pg8::gemm_phase<pg8::EpiBf16<2>, pg8::StaticOrder, true, true>(T.lds3, g, S, E, wave_s); } } }
        SEAM();
        if (((PH_MASK >> 10) & 1) && RUN(ph)) { for (int rep_ = 0; rep_ < 1 + ((DUP_MASK >> 10) & 1) * ((DUP_L >> l_) & 1); ++rep_) { if (rep_) GBAR(); { const Ctx T = make_ctx(lds, wave_s);  pg8::Gemm g{ACT, (const bf16_t*)(wl + WL_W2), mrows, DM, FF, FF}; pg8::CtxSplitOrder S; S.init(DM, T.G, T.bx, FF, l == 0);
            pg8::EpiResid E{XB, XB + (size_t)NLAT * DM, XB, modl + 5 * DM, SLAB}; pg8::gemm_phase<pg8::EpiResid, pg8::CtxSplitOrder, true, true>(T.lds3, g, S, E, wave_s); } } }
        SEAM();
    }
    if (((PH_MASK >> 11) & 1) && RUN(ph)) { for (int rep_ = 0; rep_ < 1 + ((DUP_MASK >> 11) & 1) * ((DUP_L >> l_) & 1); ++rep_) { if (rep_) GBAR(); { const Ctx T = make_ctx(lds, wave_s); finalnorm_phase(T, XB, p.in[I_FNORM], p.out); } } }
#undef RUN
#undef SEAM
}

constexpr int LDS_BYTES = 131072 + 1024;
constexpr int N_PHASES = 1 + 10 * DEPTH + 1;
#ifndef MK_ONE_LAUNCH
#define MK_ONE_LAUNCH 1
#endif
extern "C" void kernel_launch(void* const* d_in, const int* in_sizes, int n_in, void* d_out, int out_size, void* d_ws, size_t ws_size, hipStream_t stream) {
    static int grid = 0;
    if (grid == 0) {
        if (n_in != 23 || ws_size < WS_END || out_size != NLAT * DM) { fprintf(stderr, "kernel_launch: unexpected shapes: n_in %d ws %zu (need %zu) out %d\n", n_in, ws_size, (size_t)WS_END, out_size); grid = -1; return; }
        int dev = 0, cus = 0, per_cu = 0;
        hipGetDevice(&dev); hipDeviceGetAttribute(&cus, hipDeviceAttributeMultiprocessorCount, dev);
        if (hipFuncSetAttribute((const void*)mega_fwd, hipFuncAttributeMaxDynamicSharedMemorySize, LDS_BYTES) != hipSuccess) { fprintf(stderr, "kernel_launch: hipFuncSetAttribute failed\n"); grid = -1; return; }
        hipOccupancyMaxActiveBlocksPerMultiprocessor(&per_cu, (const void*)mega_fwd, 512, LDS_BYTES);
        (void)hipGetLastError();
        if (per_cu < 1) { fprintf(stderr, "kernel_launch: occupancy query says %d blocks per CU\n", per_cu); per_cu = 1; }
        grid = cus;
    }
    if (grid < 0) return;
    (void)hipMemsetAsync((char*)d_ws + WS_CTL, 0, 16384, stream);
    Params p{};
    for (int i = 0; i < 23; ++i) p.in[i] = (const float*)d_in[i];
    p.out = (float*)d_out; p.ws = (unsigned char*)d_ws;
#if MK_ONE_LAUNCH
    p.ph_lo = 0; p.ph_hi = N_PHASES;
    void* args[] = {&p};
    hipError_t e = hipLaunchCooperativeKernel((const void*)mega_fwd, dim3(grid), dim3(512), args, LDS_BYTES, stream);
    if (e != hipSuccess) fprintf(stderr, "kernel_launch: cooperative launch failed: %s (grid %d)\n", hipGetErrorString(e), grid);
#else
    for (int k = 0; k < N_PHASES; ++k) { p.ph_lo = k; p.ph_hi = k + 1; hipLaunchKernelGGL(mega_fwd, dim3(grid), dim3(512), LDS_BYTES, stream, p); }
#endif
}
```

```cpp
#include <hip/hip_runtime.h>
#include <hip/hip_cooperative_groups.h>
#include <cstdio>
#include <cstdint>
namespace cg = cooperative_groups;

#define LAS __attribute__((address_space(3)))
typedef unsigned short bf16_t;
typedef short bf16x8 __attribute__((ext_vector_type(8)));
typedef short s16x4 __attribute__((ext_vector_type(4)));
typedef float f32x4 __attribute__((ext_vector_type(4)));
typedef float f32x2 __attribute__((ext_vector_type(2)));
typedef float f32x16 __attribute__((ext_vector_type(16)));
typedef unsigned u32x4 __attribute__((ext_vector_type(4)));
typedef unsigned u32x2 __attribute__((ext_vector_type(2)));

constexpr int DM = 2048, NB = 4, SEQ = 4096, CTXL = 256, NLAT = NB * SEQ, NCTXR = NB * CTXL, NROW = NLAT + NCTXR, DEPTH = 2;
constexpr int INW = 2880, INWP = 3072, QW = 1536, KVW = 2048, FF = 8192, MODW = 6 * DM, MIXW = 2048;
constexpr int U_AQ = 0, U_AKV = 512, U_AKR = 1024, U_BQ = 1088, U_BK = 1600, U_BV = 1728, U_CA = 1856, U_CG = 2368;
constexpr float EPS = 1e-6f;
constexpr float MLA_SCALE = 0.07216878364870322f;
constexpr float SWA_SCALE = 0.125f;


constexpr size_t MiB = 1u << 20;
constexpr size_t WS_MOD = 0;
constexpr size_t WS_CTL = 512 * 1024;
constexpr size_t WS_WL = 1 * MiB;
constexpr size_t WL_IN = 0, WL_UQ = 12 * MiB, WL_UKV = WL_UQ + 1536 * 1024, WL_OUT = WL_UKV + 2 * MiB, WL_W1 = WL_OUT + 8 * MiB, WL_W2 = WL_W1 + 32 * MiB, WL_SIZE = WL_W2 + 32 * MiB;
constexpr size_t WS_X = WS_WL + 2 * WL_SIZE;
constexpr size_t WS_HN = WS_X + (size_t)NROW * DM * 4;
constexpr size_t WS_U = WS_HN + (size_t)NROW * DM * 2;
constexpr size_t WS_Q = WS_U + (size_t)NROW * INWP * 2;
constexpr size_t WS_KV = WS_Q + (size_t)NROW * QW * 2;
constexpr size_t WS_MIX = WS_KV + (size_t)NROW * KVW * 2;
constexpr size_t WS_ACT = WS_U;
constexpr size_t WS_SLAB = WS_MIX + (size_t)NROW * MIXW * 2;
constexpr size_t WS_END = WS_SLAB + (size_t)8 * NCTXR * DM * 4;
static_assert(WS_ACT + (size_t)NROW * FF * 2 <= WS_SLAB, "act overlay");

__device__ const float ROPE_TAB[64 * 16 * 2] = {
1.00000000e+00f, 0.00000000e+00f, 1.00000000e+00f, 0.00000000e+00f, 1.00000000e+00f, 0.00000000e+00f, 1.00000000e+00f, 0.00000000e+00f,
1.00000000e+00f, 0.00000000e+00f, 1.00000000e+00f, 0.00000000e+00f, 1.00000000e+00f, 0.00000000e+00f, 1.00000000e+00f, 0.00000000e+00f,
1.00000000e+00f, 0.00000000e+00f, 1.00000000e+00f, 0.00000000e+00f, 1.00000000e+00f, 0.00000000e+00f, 1.00000000e+00f, 0.00000000e+00f,
1.00000000e+00f, 0.00000000e+00f, 1.00000000e+00f, 0.00000000e+00f, 1.00000000e+00f, 0.00000000e+00f, 1.00000000e+00f, 0.00000000e+00f,
5.40302306e-01f, 8.41470985e-01f, 8.46009106e-01f, 5.33168446e-01f, 9.50415281e-01f, 3.10983591e-01f, 9.84230235e-01f, 1.76892185e-01f,
9.95004165e-01f, 9.98334181e-02f, 9.98419278e-01f, 5.62044992e-02f, 9.99500042e-01f, 3.16175047e-02f, 9.99841890e-01f, 1.77818571e-02f,
9.99950000e-01f, 9.99983311e-03f, 9.99984189e-01f, 5.62338361e-03f, 9.99995000e-01f, 3.16227236e-03f, 9.99998419e-01f, 1.77827849e-03f,
9.99999500e-01f, 9.99999881e-04f, 9.99999842e-01f, 5.62341272e-04f, 9.99999950e-01f, 3.16227752e-04f, 9.99999984e-01f, 1.77827939e-04f,
-4.16146837e-01f, 9.09297427e-01f, 4.31462816e-01f, 9.02130721e-01f, 8.06578412e-01f, 5.91127114e-01f, 9.37418310e-01f, 3.48205273e-01f,
9.80066577e-01f, 1.98669334e-01f, 9.93682109e-01f, 1.12231311e-01f, 9.98000667e-01f, 6.32033945e-02f, 9.99367611e-01f, 3.55580912e-02f,
9.99800007e-01f, 1.99986662e-02f, 9.99936755e-01f, 1.12465894e-02f, 9.99980000e-01f, 6.32451310e-03f, 9.99993675e-01f, 3.55655136e-03f,
9.99998000e-01f, 1.99999876e-03f, 9.99999368e-01f, 1.12468237e-03f, 9.99999800e-01f, 6.32455472e-04f, 9.99999937e-01f, 3.55655873e-04f,
-9.89992497e-01f, 1.41120008e-01f, -1.15966163e-01f, 9.93253165e-01f, 5.82753640e-01f, 8.12648876e-01f, 8.61040659e-01f, 5.08536117e-01f,
9.55336486e-01f, 2.95520218e-01f, 9.85803469e-01f, 1.67903306e-01f, 9.95503374e-01f, 9.47260862e-02f, 9.98577312e-01f, 5.33230830e-02f,
9.99550034e-01f, 2.99954995e-02f, 9.99857701e-01f, 1.68694395e-02f, 9.99955000e-01f, 9.48669035e-03f, 9.99985770e-01f, 5.33481299e-03f,
9.99995500e-01f, 2.99999553e-03f, 9.99998577e-01f, 1.68702310e-03f, 9.99999550e-01f, 9.48683100e-04f, 9.99999858e-01f, 5.33483781e-04f,
-6.53643621e-01f, -7.56802495e-01f, -6.27679676e-01f, 7.78471723e-01f, 3.01137471e-01f, 9.53580738e-01f, 7.57506176e-01f, 6.52827997e-01f,
9.21060992e-01f, 3.89418348e-01f, 9.74808266e-01f, 2.23044491e-01f, 9.92010662e-01f, 1.26154060e-01f, 9.97471244e-01f, 7.10712093e-02f,
9.99200107e-01f, 3.99893333e-02f, 9.99747028e-01f, 2.24917562e-02f, 9.99920001e-01f, 1.26487732e-02f, 9.99974702e-01f, 7.11305774e-03f,
9.99992000e-01f, 3.99998952e-03f, 9.99997470e-01f, 2.24936331e-03f, 9.99999200e-01f, 1.26491069e-03f, 9.99999747e-01f, 7.11311701e-04f,
2.83662185e-01f, -9.58924275e-01f, -9.46079242e-01f, 3.23935282e-01f, -1.03423381e-02f, 9.99946517e-01f, 6.30080299e-01f, 7.76529984e-01f,
8.77582562e-01f, 4.79425539e-01f, 9.60731260e-01f, 2.77480534e-01f, 9.87526022e-01f, 1.57455882e-01f, 9.96049756e-01f, 8.87968616e-02f,
9.98750261e-01f, 4.99791663e-02f, 9.99604741e-01f, 2.81133616e-02f, 9.99875003e-01f, 1.58107286e-02f, 9.99960472e-01f, 8.89128000e-03f,
9.99987500e-01f, 4.99997952e-03f, 9.99996047e-01f, 2.81170292e-03f, 9.99998750e-01f, 1.58113816e-03f, 9.99999605e-01f, 8.89139598e-04f,
9.60170287e-01f, -2.79415498e-01f, -9.73103698e-01f, -2.30367517e-01f, -3.20796390e-01f, 9.47148181e-01f, 4.82782035e-01f, 8.75740548e-01f,
8.25335601e-01f, 5.64642493e-01f, 9.43616960e-01f, 3.31039323e-01f, 9.82053937e-01f, 1.88600277e-01f, 9.94313298e-01f, 1.06494442e-01f,
9.98200540e-01f, 5.99640051e-02f, 9.99430844e-01f, 3.37340781e-02f, 9.99820005e-01f, 1.89725269e-02f, 9.99943080e-01f, 1.06694741e-02f,
9.99982000e-01f, 5.99996405e-03f, 9.99994308e-01f, 3.37404141e-03f, 9.99998200e-01f, 1.89736535e-03f, 9.99999431e-01f, 1.06696741e-03f,
7.53902254e-01f, 6.56986599e-01f, -7.00429814e-01f, -7.13721287e-01f, -5.99437453e-01f, 8.00421602e-01f, 3.20257002e-01f, 9.47330699e-01f,
7.64842195e-01f, 6.44217678e-01f, 9.23519457e-01f, 3.83551578e-01f, 9.75599879e-01f, 2.19556087e-01f, 9.92262418e-01f, 1.24158339e-01f,
9.97551000e-01f, 6.99428476e-02f, 9.99225342e-01f, 3.93537258e-02f, 9.99755010e-01f, 2.21341355e-02f, 9.99922525e-01f, 1.24476345e-02f,
9.99975500e-01f, 6.99994305e-03f, 9.99992252e-01f, 3.93637883e-03f, 9.99997550e-01f, 2.21359246e-03f, 9.99999225e-01f, 1.24479530e-03f,
-1.45500034e-01f, 9.89358247e-01f, -2.12036448e-01f, -9.77261759e-01f, -8.18632447e-01f, 5.74317783e-01f, 1.47631213e-01f, 9.89042479e-01f,
6.96706701e-01f, 7.17356099e-01f, 9.00502310e-01f, 4.34851228e-01f, 9.68170306e-01f, 2.50292345e-01f, 9.89897766e-01f, 1.41782975e-01f,
9.96801706e-01f, 7.99146922e-02f, 9.98988242e-01f, 4.49721329e-02f, 9.99680017e-01f, 2.52955226e-02f, 9.99898809e-01f, 1.42257556e-02f,
9.99968000e-01f, 7.99991505e-03f, 9.99989881e-01f, 4.49871524e-03f, 9.99996800e-01f, 2.52981936e-03f, 9.99998988e-01f, 1.42262304e-03f,
-9.11130262e-01f, 4.12118485e-01f, 3.41660255e-01f, -9.39823531e-01f, -9.56644168e-01f, 2.91259224e-01f, -2.96507962e-02f, 9.99560318e-01f,
6.21609940e-01f, 7.83326932e-01f, 8.74638261e-01f, 4.84776146e-01f, 9.59772644e-01f, 2.80778331e-01f, 9.87220090e-01f, 1.59362777e-01f,
9.95952733e-01f, 8.98785453e-02f, 9.98719551e-01f, 5.05891178e-02f, 9.99595027e-01f, 2.84566569e-02f, 9.99871931e-01f, 1.60038307e-02f,
9.99959500e-01f, 8.99987904e-03f, 9.99987193e-01f, 5.06105023e-03f, 9.99995950e-01f, 2.84604600e-03f, 9.99998719e-01f, 1.60045073e-03f,
-8.39071529e-01f, -5.44021111e-01f, 7.90131866e-01f, -6.12936893e-01f, -9.99786072e-01f, -2.06835699e-02f, -2.05997633e-01f, 9.78552490e-01f,
5.40302306e-01f, 8.41470985e-01f, 8.46009106e-01f, 5.33168446e-01f, 9.50415290e-01f, 3.10983563e-01f, 9.84230235e-01f, 1.76892185e-01f,
9.95004166e-01f, 9.98334107e-02f, 9.98419278e-01f, 5.62044992e-02f, 9.99500042e-01f, 3.16175047e-02f, 9.99841890e-01f, 1.77818571e-02f,
9.99950000e-01f, 9.99983404e-03f, 9.99984189e-01f, 5.62338361e-03f, 9.99995000e-01f, 3.16227236e-03f, 9.99998419e-01f, 1.77827849e-03f,
4.42569799e-03f, -9.99990207e-01f, 9.95257399e-01f, -9.72764577e-02f, -9.43779739e-01f, -3.30574959e-01f, -3.75847400e-01f, 9.26681570e-01f,
4.53596100e-01f, 8.91207371e-01f, 8.14705342e-01f, 5.79875164e-01f, 9.40107590e-01f, 3.40877865e-01f, 9.80929147e-01f, 1.94365656e-01f,
9.93956098e-01f, 1.09778300e-01f, 9.98087432e-01f, 6.18181033e-02f, 9.99395061e-01f, 3.47780401e-02f, 9.99808688e-01f, 1.95598272e-02f,
9.99939501e-01f, 1.09997790e-02f, 9.99980868e-01f, 6.18571475e-03f, 9.99993950e-01f, 3.47849840e-03f, 9.99998087e-01f, 1.95610608e-03f,
8.43853959e-01f, -5.36572918e-01f, 8.93861614e-01f, 4.48342965e-01f, -7.94179352e-01f, -6.07683434e-01f, -5.33843014e-01f, 8.45583607e-01f,
3.62357710e-01f, 9.32039103e-01f, 7.80825933e-01f, 6.24748639e-01f, 9.28859871e-01f, 3.70431289e-01f, 9.77317868e-01f, 2.11777679e-01f,
9.92808636e-01f, 1.19712205e-01f, 9.97724024e-01f, 6.74297562e-02f, 9.99280086e-01f, 3.79382239e-02f, 9.99772325e-01f, 2.13377337e-02f,
9.99928001e-01f, 1.19997121e-02f, 9.99977232e-01f, 6.74804441e-03f, 9.99992800e-01f, 3.79472386e-03f, 9.99997723e-01f, 2.13393360e-03f,
9.07446781e-01f, 4.20167037e-01f, 5.17172845e-01f, 8.55880978e-01f, -5.65820493e-01f, -8.24528453e-01f, -6.75001666e-01f, 7.37816204e-01f,
2.67498760e-01f, 9.63558205e-01f, 7.44477987e-01f, 6.67647007e-01f, 9.16683370e-01f, 3.99614314e-01f, 9.73397544e-01f, 2.29122720e-01f,
9.91561894e-01f, 1.29634138e-01f, 9.97329065e-01f, 7.30392768e-02f, 9.99155119e-01f, 4.10980321e-02f, 9.99732799e-01f, 2.31155726e-02f,
9.99915501e-01f, 1.29996341e-02f, 9.99973279e-01f, 7.31037192e-03f, 9.99991550e-01f, 4.11094918e-03f, 9.99997328e-01f, 2.31176106e-03f,
1.36737218e-01f, 9.90607356e-01f, -1.87961516e-02f, 9.99823337e-01f, -2.81349481e-01f, -9.59605372e-01f, -7.94870905e-01f, 6.06778580e-01f,
1.69967166e-01f, 9.85449726e-01f, 7.05776374e-01f, 7.08434690e-01f, 9.03590249e-01f, 4.28397784e-01f, 9.69169414e-01f, 2.46395308e-01f,
9.90215996e-01f, 1.39543115e-01f, 9.96902569e-01f, 7.86464803e-02f, 9.99020160e-01f, 4.42574256e-02f, 9.99690113e-01f, 2.48933403e-02f,
9.99902002e-01f, 1.39995431e-02f, 9.99969010e-01f, 7.87269666e-03f, 9.99990200e-01f, 4.42717408e-03f, 9.99996901e-01f, 2.48958868e-03f,
-7.59687913e-01f, 6.50287840e-01f, -5.48975472e-01f, 8.35838460e-01f, 3.10223509e-02f, -9.99518691e-01f, -8.89670427e-01f, 4.56603254e-01f,
7.07372017e-02f, 9.97494987e-01f, 6.64843529e-01f, 7.46982651e-01f, 8.89593626e-01f, 4.56752865e-01f, 9.64634817e-01f, 2.63589966e-01f,
9.88771079e-01f, 1.49438124e-01f, 9.96444547e-01f, 8.42512043e-02f, 9.98875211e-01f, 4.74163803e-02f, 9.99644265e-01f, 2.66710293e-02f,
9.99887502e-01f, 1.49994381e-02f, 9.99964425e-01f, 8.43501985e-03f, 9.99988750e-01f, 4.74339854e-03f, 9.99996442e-01f, 2.66741598e-03f,
-9.57659480e-01f, -2.87903317e-01f, -9.10081090e-01f, 4.14430224e-01f, 3.40318168e-01f, -9.40310345e-01f, -9.56410050e-01f, 2.92027082e-01f,
-2.91995461e-02f, 9.99573602e-01f, 6.21808819e-01f, 7.83169070e-01f, 8.74707484e-01f, 4.84651232e-01f, 9.59795176e-01f, 2.80701301e-01f,
9.87227284e-01f, 1.59318203e-01f, 9.95955015e-01f, 8.98532639e-02f, 9.98720273e-01f, 5.05748570e-02f, 9.99595256e-01f, 2.84486321e-02f,
9.99872003e-01f, 1.59993181e-02f, 9.99959523e-01f, 8.99733943e-03f, 9.99987200e-01f, 5.05962253e-03f, 9.99995952e-01f, 2.84524320e-03f,
-2.75163338e-01f, -9.61397492e-01f, -9.90897960e-01f, -1.34615131e-01f, 6.15864792e-01f, -7.87851863e-01f, -9.92984984e-01f, 1.18240524e-01f,
-1.28844542e-01f, 9.91664804e-01f, 5.76808296e-01f, 8.16879544e-01f, 8.58946708e-01f, 5.12064988e-01f, 9.54652029e-01f, 2.97723872e-01f,
9.85584767e-01f, 1.69182351e-01f, 9.95433988e-01f, 9.54524822e-02f, 9.98555348e-01f, 5.37328280e-02f, 9.99543086e-01f, 3.02261450e-02f,
9.99855503e-01f, 1.69991821e-02f, 9.99954305e-01f, 9.55965617e-03f, 9.99985550e-01f, 5.37584601e-03f, 9.99995431e-01f, 3.02307034e-03f,
6.60316708e-01f, -7.50987247e-01f, -7.66536540e-01f, -6.42200695e-01f, 8.30336128e-01f, -5.57262877e-01f, -9.98241661e-01f, -5.92755186e-02f,
-2.27202164e-01f, 9.73847615e-01f, 5.29984176e-01f, 8.48007532e-01f, 8.42327058e-01f, 5.38966722e-01f, 9.49207011e-01f, 3.14652269e-01f,
9.83843694e-01f, 1.79029566e-01f, 9.94881482e-01f, 1.01048682e-01f, 9.98380437e-01f, 5.68902654e-02f, 9.99487755e-01f, 3.20035622e-02f,
9.99838004e-01f, 1.79990291e-02f, 9.99948772e-01f, 1.01219708e-02f, 9.99983800e-01f, 5.69206895e-03f, 9.99994877e-01f, 3.20089737e-03f,
9.88704618e-01f, 1.49877210e-01f, -3.06095406e-01f, -9.52000842e-01f, 9.62463796e-01f, -2.71410100e-01f, -9.72014272e-01f, -2.34921804e-01f,
-3.23289544e-01f, 9.46300095e-01f, 4.81484589e-01f, 8.76454557e-01f, 8.24865151e-01f, 5.65329535e-01f, 9.43461826e-01f, 3.31481196e-01f,
9.82004236e-01f, 1.88858893e-01f, 9.94297517e-01f, 1.06641679e-01f, 9.98195543e-01f, 6.00471302e-02f, 9.99429263e-01f, 3.37808820e-02f,
9.99819505e-01f, 1.89988581e-02f, 9.99942921e-01f, 1.06842813e-02f, 9.99981950e-01f, 6.00829132e-03f, 9.99994292e-01f, 3.37872454e-03f,
4.08082062e-01f, 9.12945251e-01f, 2.48616731e-01f, -9.68601941e-01f, 9.99144380e-01f, 4.13582902e-02f, -9.15129950e-01f, -4.03158994e-01f,
-4.16146837e-01f, 9.09297427e-01f, 4.31462816e-01f, 9.02130721e-01f, 8.06578448e-01f, 5.91127066e-01f, 9.37418310e-01f, 3.48205273e-01f,
9.80066580e-01f, 1.98669319e-01f, 9.93682109e-01f, 1.12231311e-01f, 9.98000667e-01f, 6.32033945e-02f, 9.99367611e-01f, 3.55580912e-02f,
9.99800007e-01f, 1.99986681e-02f, 9.99936755e-01f, 1.12465894e-02f, 9.99980000e-01f, 6.32451310e-03f, 9.99993675e-01f, 3.55655136e-03f,
-5.47729260e-01f, 8.36655639e-01f, 7.26760256e-01f, -6.86891207e-01f, 9.36740452e-01f, 3.50024751e-01f, -8.29382949e-01f, -5.58680521e-01f,
-5.04846228e-01f, 8.63209294e-01f, 3.80076998e-01f, 9.24954850e-01f, 7.87485197e-01f, 6.16333566e-01f, 9.31078354e-01f, 3.64819269e-01f,
9.78030916e-01f, 2.08459893e-01f, 9.93035277e-01f, 1.17817394e-01f, 9.97795810e-01f, 6.63590305e-02f, 9.99302799e-01f, 3.73351880e-02f,
9.99779508e-01f, 2.09984581e-02f, 9.99930273e-01f, 1.18088930e-02f, 9.99977950e-01f, 6.64073424e-03f, 9.99993027e-01f, 3.73437808e-03f,
-9.99960826e-01f, -8.85130929e-03f, 9.81074582e-01f, -1.93630229e-01f, 7.81440393e-01f, 6.23979898e-01f, -7.17477463e-01f, -6.96581718e-01f,
-5.88501156e-01f, 8.08496376e-01f, 3.27489589e-01f, 9.44854787e-01f, 7.67604563e-01f, 6.40923736e-01f, 9.24443984e-01f, 3.81317874e-01f,
9.75897450e-01f, 2.18229622e-01f, 9.92357044e-01f, 1.23399744e-01f, 9.97580976e-01f, 6.95140029e-02f, 9.99234826e-01f, 3.91121704e-02f,
9.99758010e-01f, 2.19982271e-02f, 9.99923474e-01f, 1.23711928e-02f, 9.99975800e-01f, 6.95695471e-03f, 9.99992347e-01f, 3.91220468e-03f,
-5.32833020e-01f, -8.46220404e-01f, 9.33235772e-01f, 3.59264517e-01f, 5.48645256e-01f, 8.36055251e-01f, -5.82943235e-01f, -8.12512883e-01f,
-6.66275986e-01f, 7.45705244e-01f, 2.73866839e-01f, 9.61767620e-01f, 7.46956388e-01f, 6.64873036e-01f, 9.17517275e-01f, 3.97695927e-01f,
9.73666397e-01f, 2.27977513e-01f, 9.91647429e-01f, 1.28978199e-01f, 9.97356166e-01f, 7.26682802e-02f, 9.99163694e-01f, 4.08890255e-02f,
9.99735512e-01f, 2.29979741e-02f, 9.99916359e-01f, 1.29334897e-02f, 9.99973550e-01f, 7.27317449e-03f, 9.99991636e-01f, 4.09003138e-03f,
4.24179007e-01f, -9.05578362e-01f, 5.97977171e-01f, 8.01513133e-01f, 2.61441688e-01f, 9.65219272e-01f, -4.30023272e-01f, -9.02817803e-01f,
-7.37393780e-01f, 6.75463110e-01f, 2.19378275e-01f, 9.75639878e-01f, 7.25561320e-01f, 6.88157519e-01f, 9.10300429e-01f, 4.13948220e-01f,
9.71337976e-01f, 2.37702621e-01f, 9.90906456e-01f, 1.34552575e-01f, 9.97121382e-01f, 7.58218234e-02f, 9.99089402e-01f, 4.26657512e-02f,
9.99712014e-01f, 2.39976963e-02f, 9.99908928e-01f, 1.34957815e-02f, 9.99971200e-01f, 7.58939308e-03f, 9.99990893e-01f, 4.26785749e-03f,
9.91202812e-01f, -1.32351750e-01f, 7.85522636e-02f, 9.96909997e-01f, -5.16893290e-02f, 9.98663213e-01f, -2.63540593e-01f, -9.64648307e-01f,
-8.01143616e-01f, 5.98472144e-01f, 1.64196159e-01f, 9.86427707e-01f, 7.03440751e-01f, 7.10753902e-01f, 9.02795741e-01f, 4.30069588e-01f,
9.68912422e-01f, 2.47403959e-01f, 9.90134147e-01f, 1.40122697e-01f, 9.96876627e-01f, 7.89746157e-02f, 9.99011951e-01f, 4.44423420e-02f,
9.99687516e-01f, 2.49973963e-02f, 9.99901180e-01f, 1.40580691e-02f, 9.99968750e-01f, 7.90561137e-03f, 9.99990118e-01f, 4.44568393e-03f,
6.46919322e-01f, 7.62558450e-01f, -4.65064496e-01f, 8.85276801e-01f, -3.59694339e-01f, 9.33070191e-01f, -8.87455026e-02f, -9.96054334e-01f,
-8.56888827e-01f, 5.15501249e-01f, 1.08494947e-01f, 9.94097001e-01f, 6.80616801e-01f, 7.32639591e-01f, 8.95005558e-01f, 4.46054986e-01f,
9.66389981e-01f, 2.57080543e-01f, 9.89330528e-01f, 1.45688387e-01f, 9.96621904e-01f, 8.21266183e-02f, 9.98931341e-01f, 4.62187923e-02f,
9.99662019e-01f, 2.59970713e-02f, 9.99893117e-01f, 1.46203532e-02f, 9.99966200e-01f, 8.22182888e-03f, 9.99989312e-01f, 4.62350977e-03f,
-2.92138809e-01f, 9.56375928e-01f, -8.65450634e-01f, 5.00994211e-01f, -6.32028631e-01f, 7.74945037e-01f, 8.88481164e-02f, -9.96045186e-01f,
-9.04072162e-01f, 4.27379837e-01f, 5.24506144e-02f, 9.98623519e-01f, 6.57112291e-01f, 7.53792702e-01f, 8.86932371e-01f, 4.61899307e-01f,
9.63770901e-01f, 2.66731418e-01f, 9.88495623e-01f, 1.51249471e-01f, 9.96357214e-01f, 8.52777923e-02f, 9.98847571e-01f, 4.79951001e-02f,
9.99635522e-01f, 2.69967203e-02f, 9.99884737e-01f, 1.51826317e-02f, 9.99963550e-01f, 8.53804556e-03f, 9.99988474e-01f, 4.80133592e-03f,
-9.62605866e-01f, 2.70905788e-01f, -9.99293409e-01f, -3.75856620e-02f, -8.41684939e-01f, 5.39968946e-01f, 2.63639511e-01f, -9.64621277e-01f,
-9.42222325e-01f, 3.34988195e-01f, -3.75941901e-03f, 9.99992933e-01f, 6.32950677e-01f, 7.74192121e-01f, 8.78578705e-01f, 4.77597592e-01f,
9.61055438e-01f, 2.76355650e-01f, 9.87629462e-01f, 1.56805757e-01f, 9.96082561e-01f, 8.84281209e-02f, 9.98760643e-01f, 4.97712524e-02f,
9.99608026e-01f, 2.79963423e-02f, 9.99876041e-01f, 1.57449054e-02f, 9.99960800e-01f, 8.85426139e-03f, 9.99987604e-01f, 4.97916193e-03f,
-7.48057530e-01f, -6.63633884e-01f, -8.25371633e-01f, -5.64589822e-01f, -9.67871508e-01f, 2.51445312e-01f, 4.30115848e-01f, -9.02773702e-01f,
-9.70958188e-01f, 2.39249237e-01f, -5.99575673e-02f, 9.98200927e-01f, 6.08156211e-01f, 7.93817374e-01f, 8.69947214e-01f, 4.93144851e-01f,
9.58243878e-01f, 2.85952217e-01f, 9.86732067e-01f, 1.62357098e-01f, 9.95797946e-01f, 9.15775651e-02f, 9.98670557e-01f, 5.15472474e-02f,
9.99579529e-01f, 2.89959364e-02f, 9.99867029e-01f, 1.63071750e-02f, 9.99957950e-01f, 9.17047633e-03f, 9.99986703e-01f, 5.15698731e-03f,
1.54251450e-01f, -9.88031624e-01f, -3.97251862e-01f, -9.17709626e-01f, -9.98075227e-01f, -6.20148391e-02f, 5.83026938e-01f, -8.12452823e-01f,
-9.89992497e-01f, 1.41120008e-01f, -1.15966163e-01f, 9.93253165e-01f, 5.82753640e-01f, 8.12648876e-01f, 8.61040659e-01f, 5.08536117e-01f,
9.55336494e-01f, 2.95520190e-01f, 9.85803469e-01f, 1.67903306e-01f, 9.95503374e-01f, 9.47260937e-02f, 9.98577312e-01f, 5.33230830e-02f,
9.99550034e-01f, 2.99955014e-02f, 9.99857701e-01f, 1.68694395e-02f, 9.99955000e-01f, 9.48669035e-03f, 9.99985770e-01f, 5.33481299e-03f,
9.14742358e-01f, -4.04037645e-01f, 1.53215476e-01f, -9.88192804e-01f, -9.29300295e-01f, -3.69325007e-01f, 7.17549222e-01f, -6.96507799e-01f,
-9.99135156e-01f, 4.15805195e-02f, -1.71608138e-01f, 9.85165289e-01f, 5.56768364e-01f, 8.30667797e-01f, 8.51861797e-01f, 5.23766626e-01f,
9.52333569e-01f, 3.05058639e-01f, 9.84843697e-01f, 1.73444204e-01f, 9.95198847e-01f, 9.78736675e-02f, 9.98480910e-01f, 5.50987464e-02f,
9.99519538e-01f, 3.09950364e-02f, 9.99848056e-01f, 1.74316968e-02f, 9.99951950e-01f, 9.80290343e-03f, 9.99984805e-01f, 5.51263804e-03f,
8.34223361e-01f, 5.51426681e-01f, 6.56495179e-01f, -7.54330219e-01f, -7.68367089e-01f, -6.40009388e-01f, 8.29440367e-01f, -5.58595272e-01f,
-9.98294773e-01f, -5.83741910e-02f, -2.26707585e-01f, 9.73962869e-01f, 5.30226367e-01f, 8.47856120e-01f, 8.42413559e-01f, 5.38831509e-01f,
9.49235420e-01f, 3.14566554e-01f, 9.83852782e-01f, 1.78979618e-01f, 9.94884368e-01f, 1.01020270e-01f, 9.98381351e-01f, 5.68742354e-02f,
9.99488044e-01f, 3.19945405e-02f, 9.99838096e-01f, 1.79939505e-02f, 9.99948800e-01f, 1.01191155e-02f, 9.99983809e-01f, 5.69046338e-03f,
-1.32767472e-02f, 9.99911860e-01f, 9.57586074e-01f, -2.88147378e-01f, -5.31235279e-01f, -8.47224338e-01f, 9.15171383e-01f, -4.03064932e-01f,
-9.87479777e-01f, -1.57745647e-01f, -2.81090307e-01f, 9.59681322e-01f, 5.03154187e-01f, 8.64196658e-01f, 8.32698933e-01f, 5.53726003e-01f,
9.46042349e-01f, 3.24043013e-01f, 9.82830754e-01f, 1.84509371e-01f, 9.94559939e-01f, 1.04165862e-01f, 9.98278634e-01f, 5.86495447e-02f,
9.99455549e-01f, 3.29940106e-02f, 9.99827819e-01f, 1.85561985e-02f, 9.99945550e-01f, 1.04353266e-02f, 9.99982781e-01f, 5.86828853e-03f,
-8.48570275e-01f, 5.29082686e-01f, 9.63757533e-01f, 2.66779718e-01f, -2.41421115e-01f, -9.70420448e-01f, 9.72038357e-01f, -2.34822129e-01f,
-9.66798168e-01f, -2.55541194e-01f, -3.34584379e-01f, 9.42365796e-01f, 4.75578896e-01f, 8.79673072e-01f, 8.22720991e-01f, 5.68445398e-01f,
9.42754664e-01f, 3.33487096e-01f, 9.81777647e-01f, 1.90033290e-01f, 9.94225566e-01f, 1.07310406e-01f, 9.98172760e-01f, 6.04246684e-02f,
9.99422056e-01f, 3.39934516e-02f, 9.99817226e-01f, 1.91184387e-02f, 9.99942201e-01f, 1.07515367e-02f, 9.99981722e-01f, 6.04611304e-03f,
-9.03692205e-01f, -4.28182669e-01f, 6.73110268e-01f, 7.39542134e-01f, 7.23346672e-02f, -9.97380417e-01f, 9.98247762e-01f, -5.91726788e-02f,
-9.36456687e-01f, -3.50783228e-01f, -3.87020682e-01f, 9.22071034e-01f, 4.47528065e-01f, 8.94269887e-01f, 8.12482924e-01f, 5.82984990e-01f,
9.39372715e-01f, 3.42897802e-01f, 9.80693494e-01f, 1.95551199e-01f, 9.93881250e-01f, 1.10453883e-01f, 9.98063730e-01f, 6.21996048e-02f,
9.99387563e-01f, 3.49928548e-02f, 9.99806317e-01f, 1.96806747e-02f, 9.99938751e-01f, 1.10677456e-02f, 9.99980631e-01f, 6.22393783e-03f,
-1.27963690e-01f, -9.91778853e-01f, 1.75156534e-01f, 9.84540598e-01f, 3.78916172e-01f, -9.25430999e-01f, 9.92972826e-01f, 1.18342584e-01f,
-8.96758353e-01f, -4.42520572e-01f, -4.38233547e-01f, 8.98861145e-01f, 4.19029744e-01f, 9.07972507e-01f, 8.01987899e-01f, 5.97340280e-01f,
9.35896829e-01f, 3.52274219e-01f, 9.79578328e-01f, 2.01062925e-01f, 9.93526995e-01f, 1.13596256e-01f, 9.97951544e-01f, 6.39743371e-02f,
9.99352070e-01f, 3.59922267e-02f, 9.99795091e-01f, 2.02429046e-02f, 9.99935201e-01f, 1.13839535e-02f, 9.99979509e-01f, 6.40176195e-03f,
7.65414052e-01f, -6.43538133e-01f, -3.76742289e-01f, 9.26318114e-01f, 6.47921689e-01f, -7.61706955e-01f, 9.56380030e-01f, 2.92125382e-01f,
-8.48100006e-01f, -5.29836181e-01f, -4.88060852e-01f, 8.72809604e-01f, 3.90112429e-01f, 9.20767231e-01f, 7.91239269e-01f, 6.11506680e-01f,
9.32327344e-01f, 3.61615436e-01f, 9.78432188e-01f, 2.06568278e-01f, 9.93162805e-01f, 1.16737493e-01f, 9.97836202e-01f, 6.57488745e-02f,
9.99315578e-01f, 3.69915589e-02f, 9.99783550e-01f, 2.08051261e-02f, 9.99931551e-01f, 1.17001602e-02f, 9.99978354e-01f, 6.57958633e-03f,
9.55073644e-01f, 2.96368579e-01f, -8.12611205e-01f, 5.82806168e-01f, 8.52673116e-01f, -5.22444789e-01f, 8.89623492e-01f, 4.56694694e-01f,
-7.90967741e-01f, -6.11857853e-01f, -5.36345181e-01f, 8.43998724e-01f, 3.60805033e-01f, 9.32641264e-01f, 7.80240434e-01f, 6.25479708e-01f,
9.28664637e-01f, 3.70920465e-01f, 9.77255105e-01f, 2.12067113e-01f, 9.92788684e-01f, 1.19877556e-01f, 9.97717704e-01f, 6.75232040e-02f,
9.99278087e-01f, 3.79908578e-02f, 9.99771692e-01f, 2.13673430e-02f, 9.99927801e-01f, 1.20163657e-02f, 9.99977168e-01f, 6.75741050e-03f,
2.66642932e-01f, 9.63795386e-01f, -9.98210360e-01f, 5.98003149e-02f, 9.72865350e-01f, -2.31372019e-01f, 7.94808390e-01f, 6.06860464e-01f,
-7.25932239e-01f, -6.87766228e-01f, -5.82933885e-01f, 8.12519591e-01f, 3.31136863e-01f, 9.43582735e-01f, 7.68994909e-01f, 6.39254902e-01f,
9.24909065e-01f, 3.80188402e-01f, 9.76047118e-01f, 2.17559242e-01f, 9.92404635e-01f, 1.23016426e-01f, 9.97596052e-01f, 6.92973125e-02f,
9.99239596e-01f, 3.89901151e-02f, 9.99759518e-01f, 2.19295531e-02f, 9.99923951e-01f, 1.23325701e-02f, 9.99975951e-01f, 6.93523400e-03f,
-6.66938062e-01f, 7.45113160e-01f, -8.76379442e-01f, -4.81621297e-01f, 9.96578984e-01f, 8.26458063e-02f, 6.74925652e-01f, 7.37885740e-01f,
-6.53643621e-01f, -7.56802495e-01f, -6.27679676e-01f, 7.78471723e-01f, 3.01137584e-01f, 9.53580702e-01f, 7.57506176e-01f, 6.52827997e-01f,
9.21061003e-01f, 3.89418320e-01f, 9.74808266e-01f, 2.23044491e-01f, 9.92010662e-01f, 1.26154060e-01f, 9.97471244e-01f, 7.10712093e-02f,
9.99200107e-01f, 3.99893370e-02f, 9.99747028e-01f, 2.24917562e-02f, 9.99920001e-01f, 1.26487732e-02f, 9.99974702e-01f, 7.11305774e-03f,
-9.87339278e-01f, -1.58622669e-01f, -4.84639397e-01f, -8.74714042e-01f, 9.21462347e-01f, 3.88467685e-01f, 5.33756100e-01f, 8.45638472e-01f,
-5.74824025e-01f, -8.18277056e-01f, -6.70441094e-01f, 7.41962761e-01f, 2.70837078e-01f, 9.62625201e-01f, 7.45777904e-01f, 6.66194655e-01f,
9.17120824e-01f, 3.98609325e-01f, 9.73538587e-01f, 2.28522688e-01f, 9.91606768e-01f, 1.29290439e-01f, 9.97343283e-01f, 7.28448814e-02f,
9.99159618e-01f, 4.09885153e-02f, 9.99734222e-01f, 2.30539504e-02f, 9.99915951e-01f, 1.29649751e-02f, 9.99973421e-01f, 7.29088079e-03f,
-3.99985315e-01f, -9.16521548e-01f, 5.63609403e-02f, -9.98410459e-01f, 7.54965347e-01f, 6.55764687e-01f, 3.75752152e-01f, 9.26720195e-01f,
-4.90260572e-01f, -8.71575913e-01f, -7.11082951e-01f, 7.03108126e-01f, 2.40265871e-01f, 9.70707119e-01f, 7.33813802e-01f, 6.79350649e-01f,
9.13088946e-01f, 4.07760441e-01f, 9.72238123e-01f, 2.33993657e-01f, 9.91192958e-01f, 1.32425525e-01f, 9.97212167e-01f, 7.46183157e-02f,
9.99118130e-01f, 4.19876562e-02f, 9.99721100e-01f, 2.36161391e-02f, 9.99911801e-01f, 1.32811756e-02f, 9.99972109e-01f, 7.46870408e-03f,
5.55113302e-01f, -8.31774743e-01f, 5.80003113e-01f, -8.14614258e-01f, 5.13598418e-01f, 8.58030690e-01f, 2.05897171e-01f, 9.78573633e-01f,
-4.00798997e-01f, -9.16166013e-01f, -7.49476759e-01f, 6.62030655e-01f, 2.09454419e-01f, 9.77818412e-01f, 7.21617654e-01f, 6.92291818e-01f,
9.08965759e-01f, 4.16870782e-01f, 9.70906914e-01f, 2.39457227e-01f, 9.90769236e-01f, 1.35559287e-01f, 9.97077898e-01f, 7.63915215e-02f,
9.99075642e-01f, 4.29867515e-02f, 9.99707662e-01f, 2.41783204e-02f, 9.99907551e-01f, 1.35973748e-02f, 9.99970765e-01f, 7.64652713e-03f,
9.99843309e-01f, 1.77019251e-02f, 9.25014669e-01f, -3.79931391e-01f, 2.21298174e-01f, 9.75206193e-01f, 2.95478207e-02f, 9.99563368e-01f,
-3.07332779e-01f, -9.51602103e-01f, -7.85501139e-01f, 6.18860211e-01f, 1.78433530e-01f, 9.83951968e-01f, 7.09193358e-01f, 7.05014029e-01f,
9.04751664e-01f, 4.25939463e-01f, 9.69545006e-01f, 2.44913210e-01f, 9.90335607e-01f, 1.38691694e-01f, 9.96940476e-01f, 7.81644856e-02f,
9.99032156e-01f, 4.39858075e-02f, 9.99693907e-01f, 2.47404922e-02f, 9.99903202e-01f, 1.39135727e-02f, 9.99969389e-01f, 7.82434947e-03f,
5.25321989e-01f, 8.50903525e-01f, 9.85138202e-01f, 1.71763569e-01f, -9.29481055e-02f, 9.95670955e-01f, -1.47732986e-01f, 9.89027282e-01f,
-2.10795799e-01f, -9.77530118e-01f, -8.19042201e-01f, 5.73733276e-01f, 1.47234222e-01f, 9.89101655e-01f, 6.96544759e-01f, 7.17513344e-01f,
9.00447108e-01f, 4.34965523e-01f, 9.68152431e-01f, 2.50361478e-01f, 9.89892074e-01f, 1.41822713e-01f, 9.96799902e-01f, 7.99371952e-02f,
9.98987671e-01f, 4.49848158e-02f, 9.99679836e-01f, 2.53026580e-02f, 9.99898752e-01f, 1.42297692e-02f, 9.99967982e-01f, 8.00217157e-03f,
-4.32177945e-01f, 9.01788348e-01f, 7.41858013e-01f, 6.70556998e-01f, -3.97976765e-01f, 9.17395495e-01f, -3.20354369e-01f, 9.47297777e-01f,
-1.12152622e-01f, -9.93690993e-01f, -8.49993909e-01f, 5.26792516e-01f, 1.15887692e-01f, 9.93262323e-01f, 6.83675900e-01f, 7.29785766e-01f,
8.96052507e-01f, 4.43948088e-01f, 9.66729248e-01f, 2.55801799e-01f, 9.89438642e-01f, 1.44952315e-01f, 9.96656175e-01f, 8.17096594e-02f,
9.98942186e-01f, 4.59837829e-02f, 9.99665450e-01f, 2.58648158e-02f, 9.99894202e-01f, 1.45459642e-02f, 9.99966543e-01f, 8.17999434e-03f,
-9.92335469e-01f, 1.23573123e-01f, 2.70098458e-01f, 9.62832708e-01f, -6.63538256e-01f, 7.48142355e-01f, -4.82871938e-01f, 8.75690979e-01f,
-1.23883774e-02f, -9.99923261e-01f, -8.78258409e-01f, 4.78186331e-01f, 8.44252840e-02f, 9.96429813e-01f, 6.70590848e-01f, 7.41827416e-01f,
8.91568289e-01f, 4.52886284e-01f, 9.65275487e-01f, 2.61234060e-01f, 9.88975318e-01f, 1.48080452e-01f, 9.96509297e-01f, 8.34818579e-02f,
9.98895703e-01f, 4.69827002e-02f, 9.99650747e-01f, 2.64269636e-02f, 9.99889552e-01f, 1.48621578e-02f, 9.99965073e-01f, 8.35781593e-03f,
-6.40144339e-01f, -7.68254661e-01f, -2.84846606e-01f, 9.58573112e-01f, -8.63296488e-01f, 5.04697111e-01f, -6.30159971e-01f, 7.76465332e-01f,
8.74991734e-02f, -9.96164592e-01f, -9.03746345e-01f, 4.28068388e-01f, 5.28784581e-02f, 9.98600956e-01f, 6.57293742e-01f, 7.53634485e-01f,
8.86994928e-01f, 4.61779166e-01f, 9.63791209e-01f, 2.66658031e-01f, 9.88502102e-01f, 1.51207123e-01f, 9.96359267e-01f, 8.52537997e-02f,
9.98848221e-01f, 4.79815705e-02f, 9.99635728e-01f, 2.69891049e-02f, 9.99884802e-01f, 1.51783490e-02f, 9.99963571e-01f, 8.53563725e-03f,
3.00592544e-01f, -9.53752653e-01f, -7.52063995e-01f, 6.59090090e-01f, -9.77442725e-01f, 2.11200659e-01f, -7.57573076e-01f, 6.52750361e-01f,
1.86512463e-01f, -9.82452595e-01f, -9.26377138e-01f, 3.76597130e-01f, 2.12787581e-02f, 9.99773582e-01f, 6.43788833e-01f, 7.65203201e-01f,
8.82332868e-01f, 4.70625870e-01f, 9.62276453e-01f, 2.72073570e-01f, 9.88019001e-01f, 1.54332282e-01f, 9.96206087e-01f, 8.70254719e-02f,
9.98799740e-01f, 4.89803966e-02f, 9.99620393e-01f, 2.75512376e-02f, 9.99879952e-01f, 1.54945396e-02f, 9.99962037e-01f, 8.71345923e-03f,
9.64966028e-01f, -2.62374854e-01f, -9.87659084e-01f, 1.56619074e-01f, -9.94656427e-01f, -1.03240463e-01f, -8.61092711e-01f, 5.08447974e-01f,
2.83662185e-01f, -9.58924275e-01f, -9.46079242e-01f, 3.23935282e-01f, -1.03422189e-02f, 9.99946518e-01f, 6.30080299e-01f, 7.76529984e-01f,
8.77582562e-01f, 4.79425539e-01f, 9.60731260e-01f, 2.77480534e-01f, 9.87526020e-01f, 1.57455897e-01f, 9.96049756e-01f, 8.87968616e-02f,
9.98750260e-01f, 4.99791700e-02f, 9.99604741e-01f, 2.81133598e-02f, 9.99875003e-01f, 1.58107286e-02f, 9.99960472e-01f, 8.89128000e-03f,
7.42154197e-01f, 6.70229176e-01f, -9.19073538e-01f, -3.94086072e-01f, -9.13230128e-01f, -4.07444148e-01f, -9.37454250e-01f, 3.48108502e-01f,
3.77977654e-01f, -9.25814718e-01f, -9.62790371e-01f, 2.70249331e-01f, -4.19528545e-02f, 9.99119591e-01f, 6.16172522e-01f, 7.87611213e-01f,
8.72744512e-01f, 4.88177239e-01f, 9.59155693e-01f, 2.82878695e-01f, 9.87023164e-01f, 1.60577938e-01f, 9.95890276e-01f, 9.05679778e-02f,
9.98699782e-01f, 5.09778971e-02f, 9.99588774e-01f, 2.86754749e-02f, 9.99869953e-01f, 1.61269170e-02f, 9.99958875e-01f, 9.06910049e-03f,
-1.62990781e-01f, 9.86627592e-01f, -5.67430029e-01f, -8.23421619e-01f, -7.41239965e-01f, -6.71240132e-01f, -9.84248472e-01f, 1.76790685e-01f,
4.68516924e-01f, -8.83454522e-01f, -9.76457693e-01f, 2.15709002e-01f, -7.35215408e-02f, 9.97293629e-01f, 6.02069899e-01f, 7.98443384e-01f,
8.67819189e-01f, 4.96880121e-01f, 9.57549788e-01f, 2.88267938e-01f, 9.86510437e-01f, 1.63698373e-01f, 9.95727646e-01f, 9.23388002e-02f,
9.98648305e-01f, 5.19765696e-02f, 9.99572491e-01f, 2.92375810e-02f, 9.99864803e-01f, 1.64431020e-02f, 9.99957246e-01f, 9.24692070e-03f,
-9.18282786e-01f, 3.95925150e-01f, -4.10281900e-02f, -9.99157989e-01f, -4.95741821e-01f, -8.68469946e-01f, -9.99999995e-01f, -1.03020676e-04f,
5.54374495e-01f, -8.32267336e-01f, -9.87037999e-01f, 1.60486722e-01f, -1.05016712e-01f, 9.94470457e-01f, 5.87776937e-01f, 8.09023036e-01f,
8.62807085e-01f, 5.05533317e-01f, 9.55913610e-01f, 2.93648038e-01f, 9.85987845e-01f, 1.66817172e-01f, 9.95561868e-01f, 9.41093381e-02f,
9.98595829e-01f, 5.29751937e-02f, 9.99555891e-01f, 2.97996760e-02f, 9.99859553e-01f, 1.67592871e-02f, 9.99955586e-01f, 9.42474155e-03f,
-8.29309833e-01f, -5.58789049e-01f, 4.98009600e-01f, -8.67171516e-01f, -2.01079620e-01f, -9.79574901e-01f, -9.84212024e-01f, -1.76993477e-01f,
6.34692950e-01f, -7.72764427e-01f, -9.94497866e-01f, 1.04756834e-01f, -1.36406875e-01f, 9.90652898e-01f, 5.73298061e-01f, 8.19346894e-01f,
8.57708701e-01f, 5.14135959e-01f, 9.54247195e-01f, 2.99018880e-01f, 9.85455396e-01f, 1.69934287e-01f, 9.95392941e-01f, 9.58795783e-02f,
9.98542354e-01f, 5.39737612e-02f, 9.99538975e-01f, 3.03617634e-02f, 9.99854204e-01f, 1.70754687e-02f, 9.99953894e-01f, 9.60256116e-03f,
2.21267563e-02f, -9.99755173e-01f, 8.83669314e-01f, -4.68111679e-01f, 1.13521777e-01f, -9.93535508e-01f, -9.37382505e-01f, -3.48301649e-01f,
7.08669774e-01f, -7.05540326e-01f, -9.98813646e-01f, 4.86959996e-02f, -1.67660642e-01f, 9.85844769e-01f, 5.58637897e-01f, 8.29411659e-01f,
8.52524516e-01f, 5.22687239e-01f, 9.52550613e-01f, 3.04380238e-01f, 9.84913090e-01f, 1.73049718e-01f, 9.95220867e-01f, 9.76495079e-02f,
9.98487881e-01f, 5.49722784e-02f, 9.99521744e-01f, 3.09238412e-02f, 9.99848754e-01f, 1.73916505e-02f, 9.99952171e-01f, 9.78038047e-03f,
8.53220108e-01f, -5.21551002e-01f, 9.97174636e-01f, 7.51182087e-02f, 4.16867074e-01f, -9.08967459e-01f, -8.60988417e-01f, -5.08624563e-01f,
7.75565818e-01f, -6.31266712e-01f, -9.99971734e-01f, -7.51878489e-03f, -1.98746880e-01f, 9.80050855e-01f, 5.43801080e-01f, 8.39214147e-01f,
8.47255110e-01f, 5.31186200e-01f, 9.50823909e-01f, 3.09731970e-01f, 9.84360935e-01f, 1.76163418e-01f, 9.95045645e-01f, 9.94191362e-02f,
9.98432410e-01f, 5.59707370e-02f, 9.99504196e-01f, 3.14859073e-02f, 9.99843204e-01f, 1.77078286e-02f, 9.99950416e-01f, 9.95820041e-03f,
8.99866827e-01f, 4.36164755e-01f, 8.03569087e-01f, 5.95211494e-01f, 6.78870211e-01f, -7.34258290e-01f, -7.57439190e-01f, -6.52905716e-01f,
8.34712942e-01f, -5.50685304e-01f, -9.97968467e-01f, -6.37097991e-02f, -2.29634270e-01f, 9.73276991e-01f, 5.28792303e-01f, 8.48751259e-01f,
8.41900979e-01f, 5.39632043e-01f, 9.49067129e-01f, 3.15073936e-01f, 9.83798936e-01f, 1.79275357e-01f, 9.94867276e-01f, 1.01188450e-01f,
9.98375940e-01f, 5.69691433e-02f, 9.99486332e-01f, 3.20479672e-02f, 9.99837554e-01f, 1.80240068e-02f, 9.99948629e-01f, 1.01360191e-02f,
1.19180135e-01f, 9.92872648e-01f, 3.62476666e-01f, 9.31992847e-01f, 8.73550510e-01f, -4.86733506e-01f, -6.30000714e-01f, -7.76594554e-01f,
8.85519606e-01f, -4.64602011e-01f, -9.92810180e-01f, -1.19699398e-01f, -2.60292045e-01f, 9.65529933e-01f, 5.13616311e-01f, 8.58019979e-01f,
8.36462659e-01f, 5.48023923e-01f, 9.47280345e-01f, 3.20405911e-01f, 9.83227099e-01f, 1.82385503e-01f, 9.94685763e-01f, 1.02957436e-01f,
9.98318471e-01f, 5.79674889e-02f, 9.99468152e-01f, 3.26100133e-02f, 9.99831805e-01f, 1.83401814e-02f, 9.99946811e-01f, 1.03138375e-02f,
-7.71080223e-01f, 6.36738007e-01f, -1.90249096e-01f, 9.81735851e-01f, 9.81602098e-01f, -1.90938005e-01f, -4.82692335e-01f, -8.75789992e-01f,
9.27478466e-01f, -3.73876576e-01f, -9.84513180e-01f, -1.75310575e-01f, -2.90689550e-01f, 9.56817425e-01f, 4.98277903e-01f, 8.67017376e-01f,
8.30940694e-01f, 5.56361001e-01f, 9.45463597e-01f, 3.25727781e-01f, 9.82645430e-01f, 1.85493825e-01f, 9.94501103e-01f, 1.04726105e-01f,
9.98260005e-01f, 5.89657802e-02f, 9.99449656e-01f, 3.31720491e-02f, 9.99825955e-01f, 1.86563560e-02f, 9.99944961e-01f, 1.04916564e-02f,
-9.52412980e-01f, -3.04810621e-01f, -6.84381916e-01f, 7.29123716e-01f, 9.92308319e-01f, 1.23790949e-01f, -3.20159180e-01f, -9.47363763e-01f,
9.60170287e-01f, -2.79415498e-01f, -9.73103698e-01f, -2.30367517e-01f, -3.20796390e-01f, 9.47148181e-01f, 4.82782035e-01f, 8.75740548e-01f,
8.25335635e-01f, 5.64642444e-01f, 9.43616960e-01f, 3.31039323e-01f, 9.82053934e-01f, 1.88600292e-01f, 9.94313298e-01f, 1.06494442e-01f,
9.98200540e-01f, 5.99640089e-02f, 9.99430844e-01f, 3.37340781e-02f, 9.99820005e-01f, 1.89725269e-02f, 9.99943080e-01f, 1.06694741e-02f,
-2.58101636e-01f, -9.66117770e-01f, -9.67739662e-01f, 2.51952269e-01f, 9.04607566e-01f, 4.26245412e-01f, -1.47529203e-01f, -9.89057700e-01f,
9.83268421e-01f, -1.82162598e-01f, -9.58617804e-01f, -2.84696165e-01f, -3.50582460e-01f, 9.36531867e-01f, 4.67133397e-01f, 8.84186852e-01f,
8.19648010e-01f, 5.72867472e-01f, 9.41740473e-01f, 3.36340425e-01f, 9.81452621e-01f, 1.91704858e-01f, 9.94122349e-01f, 1.08262435e-01f,
9.98140077e-01f, 6.09621813e-02f, 9.99411716e-01f, 3.42960927e-02f, 9.99813956e-01f, 1.92886978e-02f, 9.99941166e-01f, 1.08472915e-02f,
6.73507162e-01f, -7.39180697e-01f, -9.53050036e-01f, -3.02812861e-01f, 7.27198078e-01f, 6.86427677e-01f, 2.97537714e-02f, -9.99557259e-01f,
9.96542121e-01f, -8.30891177e-02f, -9.41101294e-01f, -3.38124763e-01f, -3.80017977e-01f, 9.24979101e-01f, 4.51337043e-01f, 8.92353559e-01f,
8.13878454e-01f, 5.81035164e-01f, 9.39834216e-01f, 3.41630863e-01f, 9.80841490e-01f, 1.94807522e-01f, 9.93928256e-01f, 1.10030093e-01f,
9.98078615e-01f, 6.19602890e-02f, 9.99392272e-01f, 3.48580964e-02f, 9.99807806e-01f, 1.96048648e-02f, 9.99939222e-01f, 1.10251085e-02f,
9.85896582e-01f, 1.67355700e-01f, -6.44837016e-01f, -7.64320105e-01f, 4.77671453e-01f, 8.78538550e-01f, 2.06098327e-01f, -9.78531287e-01f,
9.99858633e-01f, 1.68140912e-02f, -9.20609545e-01f, -3.90484398e-01f, -4.09073509e-01f, 9.12501433e-01f, 4.35397967e-01f, 9.00238085e-01f,
8.08027511e-01f, 5.89144754e-01f, 9.37898229e-01f, 3.46910525e-01f, 9.80220551e-01f, 1.97908238e-01f, 9.93731021e-01f, 1.11797395e-01f,
9.98016156e-01f, 6.29583348e-02f, 9.99372512e-01f, 3.54200929e-02f, 9.99801557e-01f, 1.99210318e-02f, 9.99937245e-01f, 1.12029262e-02f,
};

__device__ __forceinline__ unsigned cvt_pk_bf16(float lo, float hi) { unsigned r; asm volatile("v_cvt_pk_bf16_f32 %0, %1, %2" : "=v"(r) : "v"(lo), "v"(hi)); return r; }
__device__ __forceinline__ float bf2f(unsigned short b) { return __uint_as_float((unsigned)b << 16); }
__device__ __forceinline__ float bflo(unsigned w) { return __uint_as_float(w << 16); }
__device__ __forceinline__ float bfhi(unsigned w) { return __uint_as_float(w & 0xffff0000u); }
__device__ __forceinline__ unsigned short f2bf(float f) { unsigned u = __float_as_uint(f); return (unsigned short)((u + 0x7fffu + ((u >> 16) & 1u)) >> 16); }
__device__ __forceinline__ float wave_sum(float v, const int lane) {
#pragma unroll
    for (int o = 1; o < 64; o <<= 1) v += __int_as_float(__builtin_amdgcn_ds_bpermute((lane ^ o) << 2, __float_as_int(v)));
    return v;
}
template <int N> __device__ __forceinline__ void wave_sum_n(float (&s)[N], const int lane) {
#pragma unroll
    for (int o = 1; o < 64; o <<= 1) { float t[N]; const int idx = (lane ^ o) << 2;
#pragma unroll
        for (int q = 0; q < N; ++q) t[q] = __int_as_float(__builtin_amdgcn_ds_bpermute(idx, __float_as_int(s[q])));
#pragma unroll
        for (int q = 0; q < N; ++q) s[q] += t[q]; }
}
__device__ __forceinline__ int lane_id_() { return (int)__builtin_amdgcn_mbcnt_hi(~0u, __builtin_amdgcn_mbcnt_lo(~0u, 0u)); }
__device__ __forceinline__ int tid_from_(int wave_s) { int l; int w = wave_s; asm volatile("v_mbcnt_lo_u32_b32 %0, -1, 0\n\tv_mbcnt_hi_u32_b32 %0, -1, %0" : "=v"(l), "+s"(w)); return w * 64 + l; }
__device__ __forceinline__ float sigmoidf_(float x) { return __builtin_amdgcn_rcpf(1.0f + __expf(-x)); }

namespace pg8 {
constexpr int BM = 256, BK = 64, HALF = 128, HTB = HALF * BK * 2, STAGE_BYTES = 8 * HTB, NXCD = 8, WGM = 8;
__host__ __device__ __forceinline__ int lds_byte(int r, int c) { const int st = (r >> 4) * 2 + (c >> 5), rr = r & 15, cc = c & 31, ob = rr * 64 + cc * 2; return st * 1024 + (ob ^ (((ob >> 9) & 1) << 5)); }
__host__ __device__ __forceinline__ void stage_rc(int b, int& R, int& C) { const int st = b / 1024, sb = b % 1024, swz = sb ^ (((sb >> 9) & 1) << 5); R = (st >> 1) * 16 + swz / 64; C = (st & 1) * 32 + (swz % 64) / 2; }
__host__ __device__ __forceinline__ int perm32(int rho) { const int n = rho >> 4, i = rho & 15; return 8 * (i >> 2) + 4 * n + (i & 3); }

struct Unit { int pm, pn, k0, nt, split; };
struct Gemm { const bf16_t* A; const bf16_t* Bt; int M, N, K, lda; };

struct StaticOrder {
    int nM, nN, nwg, G, c, ntk;
    __host__ __device__ __forceinline__ void init(int M, int N, int G_, int c_, int K) { nM = M / BM; nN = N / BM; nwg = nM * nN; G = G_; c = c_; ntk = K / BK; }
    __host__ __device__ __forceinline__ bool next(int i, Unit& u) const {
        const int L = i * G + c; const bool ok = L < nwg;
        int wgid = ok ? L : 0; { const int q = nwg / NXCD, r = nwg % NXCD, xcd = wgid % NXCD, off = wgid / NXCD; wgid = (xcd < r ? xcd * (q + 1) : r * (q + 1) + (xcd - r) * q) + off; }
        const int nig = WGM * nN, gid = wgid / nig, fm = gid * WGM, gsz = (nM - fm) < WGM ? (nM - fm) : WGM;
        u.pm = fm + ((wgid % nig) % gsz); u.pn = (wgid % nig) / gsz; u.k0 = 0; u.nt = ntk; u.split = 0; return ok;
    }
    __device__ __forceinline__ void a_ready(const Unit&) const {}
    __device__ __forceinline__ void done(const Unit&) const {}
};

struct CtxSplitOrder {
    StaticOrder lat; int with_ctx, nl;
    __host__ __device__ __forceinline__ void init(int N, int G_, int c_, int K, int with_ctx_) { lat.init(NLAT, N, G_, c_, K); with_ctx = with_ctx_; nl = (lat.nwg - c_ + G_ - 1) / G_; if (nl < 0) nl = 0; }
    __host__ __device__ __forceinline__ bool next(int i, Unit& u) const {
        Unit a; const bool va = lat.next(i, a);
        const int nctx = (NCTXR / BM) * lat.nN; constexpr int S = 8;
        const bool use_lat = i < nl;
        const int sub = (use_lat ? 0 : (i - nl) * lat.G) + lat.c;
        const bool vc = with_ctx && !use_lat && sub < nctx * S;
        const int uu = sub / S, sl = sub % S, cnt = lat.ntk / S;
        u.pm = use_lat ? a.pm : NLAT / BM + (uu / lat.nN) % (NCTXR / BM); u.pn = use_lat ? a.pn : uu % lat.nN; u.nt = use_lat ? a.nt : cnt; u.k0 = use_lat ? 0 : sl * cnt * BK; u.split = use_lat ? 0 : 1 + sl;
        return use_lat ? va : vc;
    }
    __device__ __forceinline__ void a_ready(const Unit&) const {}
    __device__ __forceinline__ void done(const Unit&) const {}
};

template <int ACT  > struct EpiBf16 {
    static constexpr bool PERM = true, AFTER_DRAIN = false;
    bf16_t* O; int ldc;
    __device__ __forceinline__ void operator()(const f32x4 (&acc)[2][2][4][2], const Unit& u, int wr, int wc, int fr, int fq) const {
        const int row0 = u.pm * BM + wr * 64 + fr; const int col0 = u.pn * BM + wc * 32 + 8 * fq;
#pragma unroll
        for (int ai = 0; ai < 2; ++ai)
#pragma unroll
            for (int m = 0; m < 4; ++m) { bf16_t* rowp = O + (size_t)(row0 + ai * HALF + m * 16) * ldc + col0;
#pragma unroll
                for (int bj = 0; bj < 2; ++bj) { f32x4 v0 = acc[ai][bj][m][0], v1 = acc[ai][bj][m][1];
                    if (ACT == 2) {
#pragma unroll
                        for (int e = 0; e < 4; ++e) { float a = v0[e] > 0.f ? v0[e] : 0.f; v0[e] = a * a; float b = v1[e] > 0.f ? v1[e] : 0.f; v1[e] = b * b; } }
                    u32x4 w; w.x = cvt_pk_bf16(v0[0], v0[1]); w.y = cvt_pk_bf16(v0[2], v0[3]); w.z = cvt_pk_bf16(v1[0], v1[1]); w.w = cvt_pk_bf16(v1[2], v1[3]);
                    *(u32x4*)(rowp + bj * HALF) = w; } }
    }
};
struct EpiResid {
    static constexpr bool PERM = false, AFTER_DRAIN = false;
    const float* res_lat; const float* res_ctx; float* out; const float* gate; float* slab;
    __device__ __forceinline__ void operator()(const f32x4 (&acc)[2][2][4][2], const Unit& u, int wr, int wc, int fr, int fq) const {
        const int col0 = u.pn * BM + wc * 32 + 4 * fq;
        const bool lat = u.pm < (NLAT / BM);
        const int mrow = lat ? (u.pm >> 4) : 4;
        const float* resb = lat ? res_lat + (size_t)u.pm * BM * DM : res_ctx + (size_t)(u.pm - NLAT / BM) * BM * DM;
        float* outb = out + (size_t)u.pm * BM * DM;
        const float* gp = gate + (size_t)mrow * MODW + col0;
        if (u.split) {
            float* sb = slab + ((size_t)(u.split - 1) * NCTXR + (size_t)(u.pm - NLAT / BM) * BM) * DM + col0;
#pragma unroll
            for (int ai = 0; ai < 2; ++ai)
#pragma unroll
                for (int m = 0; m < 4; ++m) { float* op = sb + (size_t)(ai * HALF + wr * 64 + m * 16 + fr) * DM;
#pragma unroll
                    for (int bj = 0; bj < 2; ++bj)
#pragma unroll
                        for (int n = 0; n < 2; ++n) *(f32x4*)(op + bj * HALF + n * 16) = acc[ai][bj][m][n]; }
            return;
        }
        f32x4 gv[2][2];
#pragma unroll
        for (int bj = 0; bj < 2; ++bj)
#pragma unroll
            for (int n = 0; n < 2; ++n) gv[bj][n] = *(const f32x4*)(gp + bj * HALF + n * 16);
#pragma unroll
        for (int ai = 0; ai < 2; ++ai) {
            f32x4 bs[4][2][2];
#pragma unroll
            for (int m = 0; m < 4; ++m) { const size_t off = (size_t)(ai * HALF + wr * 64 + m * 16 + fr) * DM + col0;
#pragma unroll
                for (int bj = 0; bj < 2; ++bj)
#pragma unroll
                    for (int n = 0; n < 2; ++n) bs[m][bj][n] = *(const f32x4*)(resb + off + bj * HALF + n * 16); }
#pragma unroll
            for (int m = 0; m < 4; ++m) { const size_t off = (size_t)(ai * HALF + wr * 64 + m * 16 + fr) * DM + col0;
#pragma unroll
                for (int bj = 0; bj < 2; ++bj)
#pragma unroll
                    for (int n = 0; n < 2; ++n) *(f32x4*)(outb + off + bj * HALF + n * 16) = bs[m][bj][n] + gv[bj][n] * acc[ai][bj][m][n]; }
            asm volatile("" ::: "memory");
        }
    }
};

template <class Epi, class Sched, bool ALIGN_EPI = false, bool SP2 = false>
__device__ __forceinline__ void gemm_phase(LAS unsigned char* lds, const Gemm g, const Sched& S, const Epi& E, const int wave_s) {
    const int tid_ = tid_from_(wave_s);
    const int tid = tid_, wid = __builtin_amdgcn_readfirstlane(tid >> 6), lane = tid & 63, wr = wid >> 2, wc = wid & 3, fr = lane & 15, fq = lane >> 4;
    const int K = g.K, lda = g.lda;
    unsigned voffA[2], voffB[2];
#pragma unroll
    for (int i = 0; i < 2; ++i) { int R, C; stage_rc(tid * 16 + i * 8192, R, C); const int Rb = Epi::PERM ? ((R & ~31) + perm32(R & 31)) : R;
        voffA[i] = (unsigned)(R * lda + C) * 2u; voffB[i] = (unsigned)(Rb * K + C) * 2u; }
    const size_t kstep = (size_t)(BK * 2);
    const size_t hstepA = (size_t)HALF * lda * 2, hstepB = (size_t)HALF * K * 2;
    const size_t tstepA = 2 * hstepA, tstepB = 2 * hstepB;
    const unsigned ldsw = (unsigned)wid * 1024u;
    const int aoff = lds_byte(wr * 64 + fr, fq * 8), boff = lds_byte(wc * 32 + fr, fq * 8);
#define PG8_SA(b, h) (((b) * 2 + (h)) * HTB)
#define PG8_SB(b, h) ((4 + (b) * 2 + (h)) * HTB)
#define PG8_STAGE(bufoff, gbase, voff) do { _Pragma("unroll") for (int _i = 0; _i < 2; ++_i) \
        __builtin_amdgcn_global_load_lds((const unsigned*)((const char*)(gbase) + (voff)[_i]), (LAS unsigned*)(lds + (bufoff) + ldsw + _i * 8192), 16, 0, 0); } while (0)
#define PG8_LDA(dst, b, h) do { _Pragma("unroll") for (int m = 0; m < 4; ++m) _Pragma("unroll") for (int k = 0; k < 2; ++k) dst[m][k] = *(const LAS bf16x8*)(lds + PG8_SA(b, h) + aoff + m * 2048 + k * 1024); } while (0)
#define PG8_LDB(dst, b, h) do { _Pragma("unroll") for (int n = 0; n < 2; ++n) _Pragma("unroll") for (int k = 0; k < 2; ++k) dst[n][k] = *(const LAS bf16x8*)(lds + PG8_SB(b, h) + boff + n * 2048 + k * 1024); } while (0)
#define PG8_MMA(ai, bj, At, Bt) do { __builtin_amdgcn_s_setprio(1); _Pragma("unroll") for (int m = 0; m < 4; ++m) _Pragma("unroll") for (int n = 0; n < 2; ++n) _Pragma("unroll") for (int k = 0; k < 2; ++k) \
        acc[ai][bj][m][n] = __builtin_amdgcn_mfma_f32_16x16x32_bf16(Bt[n][k], At[m][k], acc[ai][bj][m][n], 0, 0, 0); __builtin_amdgcn_s_setprio(0); } while (0)
#define PG8_WAIT_V(n) asm volatile("s_waitcnt vmcnt(" #n ")" ::: "memory")
#define PG8_WAIT_L(n) asm volatile("s_waitcnt lgkmcnt(" #n ")" ::: "memory")
#define PG8_BAR __builtin_amdgcn_s_barrier()
#define PG8_SCHED __builtin_amdgcn_sched_barrier(0)
    Unit cur, nxt; int ui = 0;
    if (!S.next(0, cur)) return;
    f32x4 acc[2][2][4][2];
#pragma unroll
    for (int a = 0; a < 2; ++a)
#pragma unroll
        for (int b = 0; b < 2; ++b)
#pragma unroll
            for (int m = 0; m < 4; ++m)
#pragma unroll
                for (int n = 0; n < 2; ++n) acc[a][b][m][n] = (f32x4){0.f, 0.f, 0.f, 0.f};
    bf16x8 At[4][2], B0[2][2], B1[2][2];
    const char* cA = (const char*)g.A + (size_t)cur.pm * tstepA + (size_t)cur.k0 * 2; const char* cB = (const char*)g.Bt + (size_t)cur.pn * tstepB + (size_t)cur.k0 * 2;
    S.a_ready(cur);
    if constexpr (SP2) {
        PG8_STAGE(PG8_SB(0, 0), cB, voffB); PG8_STAGE(PG8_SB(0, 1), cB + hstepB, voffB); PG8_STAGE(PG8_SA(0, 0), cA, voffA); PG8_STAGE(PG8_SA(0, 1), cA + hstepA, voffA);
        if (wr == 1) PG8_BAR;
        PG8_WAIT_V(2); PG8_BAR;
        PG8_STAGE(PG8_SB(1, 0), cB + kstep, voffB); PG8_STAGE(PG8_SA(1, 0), cA + kstep, voffA); PG8_STAGE(PG8_SB(1, 1), cB + hstepB + kstep, voffB);
        PG8_WAIT_V(6); PG8_BAR;
    } else {
        PG8_STAGE(PG8_SB(0, 0), cB, voffB); PG8_STAGE(PG8_SA(0, 0), cA, voffA); PG8_STAGE(PG8_SB(0, 1), cB + hstepB, voffB); PG8_STAGE(PG8_SA(0, 1), cA + hstepA, voffA);
        if (wr == 1) PG8_BAR;
        PG8_WAIT_V(4); PG8_BAR;
        PG8_STAGE(PG8_SB(1, 0), cB + kstep, voffB); PG8_STAGE(PG8_SA(1, 0), cA + kstep, voffA); PG8_STAGE(PG8_SB(1, 1), cB + hstepB + kstep, voffB);
        PG8_WAIT_V(6); PG8_BAR;
    }
    for (;;) {
        const bool has_next = S.next(ui + 1, nxt);
        const char* nA = has_next ? (const char*)g.A + (size_t)nxt.pm * tstepA + (size_t)nxt.k0 * 2 : cA; const char* nB = has_next ? (const char*)g.Bt + (size_t)nxt.pn * tstepB + (size_t)nxt.k0 * 2 : cB;
        const int nt = cur.nt;
        for (int t = 0; t < nt; t += 2) {
            const bool last = (t == nt - 2);
            const char* a1 = cA + (size_t)(t + 1) * kstep;
            const char* a2 = last ? nA : cA + (size_t)(t + 2) * kstep; const char* b2 = last ? nB : cB + (size_t)(t + 2) * kstep;
            const char* a3 = a2 + kstep; const char* b3 = b2 + kstep;
            if (last && has_next) S.a_ready(nxt);
            if constexpr (SP2) {
            PG8_LDB(B0, 0, 0); PG8_LDB(B1, 0, 1); PG8_SCHED; PG8_LDA(At, 0, 0); PG8_STAGE(PG8_SA(1, 1), a1 + hstepA, voffA);
            PG8_WAIT_V(8); PG8_WAIT_L(0); PG8_BAR; PG8_MMA(0, 0, At, B0); PG8_MMA(0, 1, At, B1); PG8_BAR; PG8_SCHED;
            PG8_LDA(At, 0, 1); PG8_STAGE(PG8_SB(0, 0), b2, voffB); PG8_STAGE(PG8_SB(0, 1), b2 + hstepB, voffB); PG8_STAGE(PG8_SA(0, 0), a2, voffA);
            PG8_WAIT_V(8); PG8_WAIT_L(0); PG8_BAR; PG8_MMA(1, 0, At, B0); PG8_MMA(1, 1, At, B1); PG8_BAR; PG8_SCHED;
            PG8_LDB(B0, 1, 0); PG8_LDB(B1, 1, 1); PG8_SCHED; PG8_LDA(At, 1, 0); PG8_STAGE(PG8_SA(0, 1), a2 + hstepA, voffA);
            PG8_WAIT_V(8); PG8_WAIT_L(0); PG8_BAR; PG8_MMA(0, 0, At, B0); PG8_MMA(0, 1, At, B1); PG8_BAR; PG8_SCHED;
            PG8_LDA(At, 1, 1); PG8_STAGE(PG8_SB(1, 0), b3, voffB); PG8_STAGE(PG8_SB(1, 1), b3 + hstepB, voffB); PG8_STAGE(PG8_SA(1, 0), a3, voffA);
            PG8_WAIT_V(8); PG8_WAIT_L(0); PG8_BAR; PG8_MMA(1, 0, At, B0); PG8_MMA(1, 1, At, B1); PG8_BAR; PG8_SCHED;
            } else {
            PG8_LDB(B0, 0, 0); PG8_SCHED; PG8_LDA(At, 0, 0); PG8_STAGE(PG8_SA(1, 1), a1 + hstepA, voffA);
            PG8_WAIT_L(8); PG8_BAR; PG8_WAIT_L(0); PG8_MMA(0, 0, At, B0); PG8_BAR; PG8_SCHED;
            PG8_LDB(B1, 0, 1); PG8_STAGE(PG8_SB(0, 0), b2, voffB);
            PG8_BAR; PG8_WAIT_L(0); PG8_MMA(0, 1, At, B1); PG8_BAR;
            PG8_LDA(At, 0, 1); PG8_STAGE(PG8_SA(0, 0), a2, voffA);
            PG8_BAR; PG8_WAIT_L(0); PG8_MMA(1, 0, At, B0); PG8_BAR; PG8_SCHED;
            PG8_STAGE(PG8_SB(0, 1), b2 + hstepB, voffB);
            PG8_WAIT_V(6); PG8_BAR; PG8_MMA(1, 1, At, B1); PG8_BAR;
            PG8_LDB(B0, 1, 0); PG8_SCHED; PG8_LDA(At, 1, 0); PG8_STAGE(PG8_SA(0, 1), a2 + hstepA, voffA);
            PG8_WAIT_L(8); PG8_BAR; PG8_WAIT_L(0); PG8_MMA(0, 0, At, B0); PG8_BAR; PG8_SCHED;
            PG8_LDB(B1, 1, 1); PG8_STAGE(PG8_SB(1, 0), b3, voffB);
            PG8_BAR; PG8_WAIT_L(0); PG8_MMA(0, 1, At, B1); PG8_BAR;
            PG8_LDA(At, 1, 1); PG8_STAGE(PG8_SA(1, 0), a3, voffA);
            PG8_BAR; PG8_WAIT_L(0); PG8_MMA(1, 0, At, B0); PG8_BAR; PG8_SCHED;
            PG8_STAGE(PG8_SB(1, 1), b3 + hstepB, voffB);
            PG8_WAIT_V(6); PG8_BAR; PG8_MMA(1, 1, At, B1); PG8_BAR;
            }
        }
        if constexpr (ALIGN_EPI) { if (wr == 0) PG8_BAR; }
        if constexpr (!Epi::AFTER_DRAIN) { E(acc, cur, wr, wc, fr, fq); S.done(cur); }
        if (!has_next) break;
#pragma unroll
        for (int a = 0; a < 2; ++a)
#pragma unroll
            for (int b = 0; b < 2; ++b)
#pragma unroll
                for (int m = 0; m < 4; ++m)
#pragma unroll
                    for (int n = 0; n < 2; ++n) acc[a][b][m][n] = (f32x4){0.f, 0.f, 0.f, 0.f};
        cur = nxt; cA = nA; cB = nB; ++ui;
        if constexpr (ALIGN_EPI) { if (wr == 1) PG8_BAR; }
    }
    PG8_WAIT_V(0);
    if constexpr (!ALIGN_EPI) { if (wr == 0) PG8_BAR; }
    PG8_BAR;
#undef PG8_SA
#undef PG8_SB
#undef PG8_STAGE
#undef PG8_LDA
#undef PG8_LDB
#undef PG8_MMA
#undef PG8_WAIT_V
#undef PG8_WAIT_L
#undef PG8_BAR
#undef PG8_SCHED
}
}

namespace att {
constexpr int NW = 8, QBLK = 32, KVBLK = 64;
constexpr float THR = 8.f;
#define SBAR() __builtin_amdgcn_sched_barrier(0)
__device__ __forceinline__ int crow(int r, int hi) { return (r & 3) + 8 * (r >> 2) + 4 * hi; }
__device__ __forceinline__ unsigned cvtpk(float lo, float hi) { unsigned r; asm volatile("v_cvt_pk_bf16_f32 %0, %1, %2" : "=v"(r) : "v"(lo), "v"(hi)); return r; }

struct UnitP {
    const bf16_t* Q; int ldq;
    const bf16_t* Kn; int ldkn;
    const bf16_t* Kp; int ldkp;
    const bf16_t* V; int ldv;
    bf16_t* O; int ldo;
    int base0, n0, base1, NT;
    int masked;
    int kpos1, qpos0;
    int rope;
    int has_sink; float sink;
};

__device__ __forceinline__ void partialSM(f32x16& p0, f32x16& p1, float& m_reg, float& mn, float& alpha, const float C, const float THRS) {
  float pmax = p0[0];
#pragma unroll
  for (int r = 1; r < 16; ++r) pmax = fmaxf(pmax, p0[r]);
#pragma unroll
  for (int r = 0; r < 16; ++r) pmax = fmaxf(pmax, p1[r]);
  { auto rr = __builtin_amdgcn_permlane32_swap(__float_as_uint(pmax), __float_as_uint(pmax), false, false);
    pmax = fmaxf(__uint_as_float(rr[0]), __uint_as_float(rr[1])); }
  if (__builtin_expect(__all(pmax - m_reg <= THRS), 1)) { mn = m_reg; alpha = 1.f; }
  else { mn = fmaxf(m_reg, pmax); alpha = __builtin_amdgcn_exp2f((m_reg - mn) * C); m_reg = mn; }
  float mnC = -mn * C;
#pragma unroll
  for (int r = 0; r < 16; ++r) p0[r] = fmaf(p0[r], C, mnC);
#pragma unroll
  for (int r = 0; r < 16; ++r) p1[r] = fmaf(p1[r], C, mnC);
#pragma unroll
  for (int r = 0; r < 16; ++r) p0[r] = __builtin_amdgcn_exp2f(p0[r]);
}
__device__ __forceinline__ void finishSM(f32x16& p0, f32x16& p1, float alpha, float& l_reg, bf16x8& pa0, bf16x8& pa1, bf16x8& pa2, bf16x8& pa3) {
#pragma unroll
  for (int r = 0; r < 16; ++r) p1[r] = __builtin_amdgcn_exp2f(p1[r]);
  float ps = 0;
#pragma unroll
  for (int r = 0; r < 16; ++r) ps += p0[r];
#pragma unroll
  for (int r = 0; r < 16; ++r) ps += p1[r];
  { auto rr = __builtin_amdgcn_permlane32_swap(__float_as_uint(ps), __float_as_uint(ps), false, false);
    ps = __uint_as_float(rr[0]) + __uint_as_float(rr[1]); }
  l_reg = l_reg * alpha + ps;
#define PK4(P, BASE, OUT) do { unsigned a0 = cvtpk(P[BASE + 0], P[BASE + 1]), a1 = cvtpk(P[BASE + 2], P[BASE + 3]);   \
    unsigned b0 = cvtpk(P[BASE + 4], P[BASE + 5]), b1 = cvtpk(P[BASE + 6], P[BASE + 7]);                              \
    auto r0 = __builtin_amdgcn_permlane32_swap(a0, b0, false, false); auto r1 = __builtin_amdgcn_permlane32_swap(a1, b1, false, false); \
    u32x4 w = {r0[0], r1[0], r0[1], r1[1]}; OUT = *reinterpret_cast<bf16x8*>(&w); } while (0)
  PK4(p0, 0, pa0); PK4(p0, 8, pa1); PK4(p1, 0, pa2); PK4(p1, 8, pa3);
#undef PK4
}
template <int NQK, int NKN>
__device__ __forceinline__ void qkt(f32x16& p0, f32x16& p1, const char* Kn, const char* Kp, const bf16x8* qr, int r32, int hi) {
  p0 = f32x16{}; p1 = f32x16{};
  const int swz = (r32 & 7) << 4;
#define KFRAG(d0, B0, B1) do { if ((d0) < 8 * NKN) { const int cb = ((d0) * 16 + hi * 8) * 2; \
      B0 = *reinterpret_cast<const bf16x8*>(Kn + r32 * 256 + (cb ^ swz)); B1 = *reinterpret_cast<const bf16x8*>(Kn + (32 + r32) * 256 + (cb ^ swz)); } \
    else { const int cb = (((d0) - 8 * NKN) * 16 + hi * 8) * 2; \
      B0 = *reinterpret_cast<const bf16x8*>(Kp + r32 * 128 + (cb ^ swz)); B1 = *reinterpret_cast<const bf16x8*>(Kp + (32 + r32) * 128 + (cb ^ swz)); } } while (0)
  bf16x8 a0, a1, n0, n1;
  KFRAG(0, a0, a1);
#pragma unroll
  for (int d0 = 0; d0 < NQK; ++d0) {
    if (d0 + 1 < NQK) { KFRAG(d0 + 1, n0, n1); }
    __builtin_amdgcn_sched_barrier(0);
    p0 = __builtin_amdgcn_mfma_f32_32x32x16_bf16(a0, qr[d0], p0, 0, 0, 0);
    p1 = __builtin_amdgcn_mfma_f32_32x32x16_bf16(a1, qr[d0], p1, 0, 0, 0);
    __builtin_amdgcn_sched_barrier(0);
    a0 = n0; a1 = n1;
  }
#undef KFRAG
}
__device__ __forceinline__ void glds16(const void* gsrc, unsigned lds_dst) { unsigned keep;
  asm volatile("s_mov_b32 %0, m0\n\ts_mov_b32 m0, %2\n\ts_nop 0\n\tglobal_load_lds_dwordx4 %1, off\n\ts_mov_b32 m0, %0" : "=&s"(keep) : "v"(gsrc), "s"(lds_dst) : "memory"); }
template <int NDV> __device__ __forceinline__ int v_st(int k, int c) { const int kk = (k & ~0xC) | ((k & 4) << 1) | ((k & 8) >> 1); return ((kk >> 3) * NDV + (c >> 5)) * 512 + ((kk & 7) * 32 + (c & 31)) * 2; }
__device__ __forceinline__ int v_rd_base(int lane) { return ((lane & 3) << 3) | (((lane >> 2) & 3) << 6) | (((lane >> 4) & 1) << 5) | (((lane >> 5) & 1) << 8); }
template <int NDV> constexpr int v_rd_off(int d0, int ks, int half) { return d0 * 512 + ks * (NDV * 1024) + half * (NDV * 512); }
template <int OFF> __device__ __forceinline__ s16x4 tr_read(int vb) {
  s16x4 r; asm volatile("ds_read_b64_tr_b16 %0, %1 offset:%2" : "=&v"(r) : "v"(vb), "i"(OFF) : "memory"); return r;
}
template <int NDV, int D0> __device__ __forceinline__ void pv_one(f32x16& od, int vb, bf16x8 pa0, bf16x8 pa1, bf16x8 pa2, bf16x8 pa3) {
  const s16x4 l0 = tr_read<v_rd_off<NDV>(D0, 0, 0)>(vb), h0 = tr_read<v_rd_off<NDV>(D0, 0, 1)>(vb), l1 = tr_read<v_rd_off<NDV>(D0, 1, 0)>(vb), h1 = tr_read<v_rd_off<NDV>(D0, 1, 1)>(vb);
  const s16x4 l2 = tr_read<v_rd_off<NDV>(D0, 2, 0)>(vb), h2 = tr_read<v_rd_off<NDV>(D0, 2, 1)>(vb), l3 = tr_read<v_rd_off<NDV>(D0, 3, 0)>(vb), h3 = tr_read<v_rd_off<NDV>(D0, 3, 1)>(vb);
  asm volatile("s_waitcnt lgkmcnt(0)" ::: "memory"); SBAR();
#define PK(L, H) (bf16x8){L[0], L[1], L[2], L[3], H[0], H[1], H[2], H[3]}
  od = __builtin_amdgcn_mfma_f32_32x32x16_bf16(pa0, PK(l0, h0), od, 0, 0, 0);
  od = __builtin_amdgcn_mfma_f32_32x32x16_bf16(pa1, PK(l1, h1), od, 0, 0, 0);
  od = __builtin_amdgcn_mfma_f32_32x32x16_bf16(pa2, PK(l2, h2), od, 0, 0, 0);
  od = __builtin_amdgcn_mfma_f32_32x32x16_bf16(pa3, PK(l3, h3), od, 0, 0, 0);
#undef PK
}
template <int NDV> __device__ __forceinline__ void pv_all(f32x16* o, int vb, bf16x8 pa0, bf16x8 pa1, bf16x8 pa2, bf16x8 pa3) {
  pv_one<NDV, 0>(o[0], vb, pa0, pa1, pa2, pa3); pv_one<NDV, 1>(o[1], vb, pa0, pa1, pa2, pa3);
  if constexpr (NDV == 4) { pv_one<NDV, 2>(o[2], vb, pa0, pa1, pa2, pa3); pv_one<NDV, 3>(o[3], vb, pa0, pa1, pa2, pa3); }
}
__device__ __forceinline__ void wmask(f32x16& p0, f32x16& p1, int kd  , int hi) {
#pragma unroll
  for (int r = 0; r < 16; ++r) { const int d = kd + crow(r, hi); if (d < -128 || d > 128) p0[r] = -1e30f; if (d + 32 < -128 || d + 32 > 128) p1[r] = -1e30f; }
}

template <int NQK, int NDV, int NKN>
__device__ __forceinline__ void attn_unit(const UnitP& P, char* lds, const float C, const float THRS, const int wave_s) {
  constexpr int KN_B = NKN * 64 * 256, KP_B = 64 * 128, SHM_K = KN_B + KP_B, SHM_V = 64 * NDV * 64, NVC = NDV / 2  ;
  const int tid_ = tid_from_(wave_s);
  const int tid = tid_, lane = tid & 63, r32 = lane & 31, hi = lane >> 5; const int wid = __builtin_amdgcn_readfirstlane(tid >> 6);
  char* V_lds = lds; char* K_lds = lds + 2 * SHM_V;
  float* ws = (float*)(lds + 2 * SHM_V + 2 * SHM_K) + wid * 64; float* li_l = ws; float* al_l = ws + 32;
  const unsigned lds0 = (unsigned)(uintptr_t)lds;
  float m_reg = -1e30f, l_reg = 0; f32x16 o[NDV]; bf16x8 qr[NQK];
#pragma unroll
  for (int d = 0; d < NDV; ++d) o[d] = f32x16{};
  const int qrow = wid * QBLK + r32;
  unsigned offKn[2], offKp, offV[2];
#pragma unroll
  for (int i = 0; i < 2; ++i) { const int q = i * 512 + tid, row = q >> 4, cp = q & 15, c = (cp & 8) | ((cp & 7) ^ (row & 7)); offKn[i] = (unsigned)(row * P.ldkn + c * 8); }
  { const int row = tid >> 3, cp = tid & 7, c = cp ^ (row & 7); offKp = (unsigned)(row * P.ldkp + c * 8); }
#pragma unroll
  for (int i = 0; i < NVC; ++i) { const int q = i * 512 + tid, sub = q >> 5, rem = q & 31, kk = (sub / NDV) * 8 + (rem >> 2), c = (sub % NDV) * 32 + (rem & 3) * 8;
    const int k = (kk & ~0xC) | ((kk & 4) << 1) | ((kk & 8) >> 1); offV[i] = (unsigned)(k * P.ldv + c); }
#define TROW(j) ((j) < P.n0 ? P.base0 + 64 * (j) : P.base1 + 64 * ((j) - P.n0))
#define DMA_K(j, b) do { const int row0_ = TROW(j); const unsigned kd_ = lds0 + 2 * SHM_V + (b) * SHM_K + wid * 1024; \
    if constexpr (NKN == 1) { const bf16_t* s_ = P.Kn + (size_t)row0_ * P.ldkn; glds16(s_ + offKn[0], kd_); glds16(s_ + offKn[1], kd_ + 8192); } \
    glds16(P.Kp + (size_t)row0_ * P.ldkp + offKp, kd_ + KN_B); } while (0)
#define DMA_V(j, b) do { const int row0_ = TROW(j); const unsigned vd_ = lds0 + (b) * SHM_V + wid * 1024; const bf16_t* s_ = P.V + (size_t)row0_ * P.ldv; \
    glds16(s_ + offV[0], vd_); if constexpr (NVC == 2) glds16(s_ + offV[1], vd_ + 8192); } while (0)
#define WAIT_BAR(N) asm volatile("s_waitcnt vmcnt(" #N ") lgkmcnt(0)\n\ts_barrier" ::: "memory")
#define LBAR() asm volatile("s_waitcnt lgkmcnt(0)\n\ts_barrier" ::: "memory")
#define WAIT_BAR_V() do { if constexpr (NVC == 2) WAIT_BAR(2); else WAIT_BAR(1); } while (0)
  DMA_K(0, 0); DMA_V(0, 0); DMA_K(1, 1);
  const bf16_t* Qw = P.Q + (size_t)qrow * P.ldq + hi * 8;
#pragma unroll
  for (int d0 = 0; d0 < NQK; ++d0) qr[d0] = *reinterpret_cast<const bf16x8*>(Qw + d0 * 16);
  if (P.rope) {
    const int t = P.qpos0 + qrow; const int pr = t >> 6, pc = t & 63;
#pragma unroll
    for (int a = 0; a < 2; ++a) {
      const float* tb = ROPE_TAB + ((a ? pc : pr) * 16 + hi * 8) * 2;
      bf16x8 x1 = qr[NQK - 4 + 2 * a], x2 = qr[NQK - 3 + 2 * a];
#pragma unroll
      for (int j = 0; j < 8; ++j) { const float c = tb[2 * j], s = tb[2 * j + 1]; const float f1 = bf2f((unsigned short)x1[j]), f2 = bf2f((unsigned short)x2[j]);
        x1[j] = (short)f2bf(f1 * c - f2 * s); x2[j] = (short)f2bf(f2 * c + f1 * s); }
      qr[NQK - 4 + 2 * a] = x1; qr[NQK - 3 + 2 * a] = x2;
    }
  }
  const int vb0 = (int)lds0 + v_rd_base(lane);
#define RESC(a) do { if (__any((a) < 1.f)) { if (hi == 0) al_l[r32] = (a); asm volatile("s_waitcnt lgkmcnt(0)" ::: "memory"); \
    _Pragma("unroll") for (int d = 0; d < NDV; ++d) _Pragma("unroll") for (int r = 0; r < 16; ++r) o[d][r] *= al_l[crow(r, hi)]; } } while (0)
#define MASK(P0, P1, j) do { if (P.masked && (j) >= P.n0) { const int kd0_ = P.kpos1 + 64 * ((j) - P.n0) - (P.qpos0 + wid * QBLK); \
    if (kd0_ + 63 > 128 || kd0_ - 31 < -128) wmask(P0, P1, P.kpos1 + 64 * ((j) - P.n0) - (P.qpos0 + qrow), hi); } } while (0)
#define QKT(P0, P1, b) qkt<NQK, NKN>(P0, P1, K_lds + (b) * SHM_K, K_lds + (b) * SHM_K + KN_B, qr, r32, hi)
  f32x16 pA0, pA1, pB0, pB1; float mnA, mnB, alA, alB; bf16x8 pa0, pa1, pa2, pa3; const int NT = P.NT;
  WAIT_BAR(0);
  QKT(pA0, pA1, 0); MASK(pA0, pA1, 0); partialSM(pA0, pA1, m_reg, mnA, alA, C, THRS);
  DMA_V(1, 1);
  for (int j = 1; j + 1 < NT; j += 2) {
    DMA_K(j + 1, 0);
    SBAR(); finishSM(pA0, pA1, alA, l_reg, pa0, pa1, pa2, pa3); SBAR();
    QKT(pB0, pB1, 1); MASK(pB0, pB1, j); SBAR();
    pv_all<NDV>(o, vb0, pa0, pa1, pa2, pa3); partialSM(pB0, pB1, m_reg, mnB, alB, C, THRS);
    LBAR();
    DMA_V(j + 1, 0);
    RESC(alB);
    WAIT_BAR_V();
    DMA_K(j + 2, 1);
    SBAR(); finishSM(pB0, pB1, alB, l_reg, pa0, pa1, pa2, pa3); SBAR();
    QKT(pA0, pA1, 0); MASK(pA0, pA1, j + 1); SBAR();
    pv_all<NDV>(o, vb0 + SHM_V, pa0, pa1, pa2, pa3); partialSM(pA0, pA1, m_reg, mnA, alA, C, THRS);
    LBAR();
    DMA_V(j + 2, 1);
    RESC(alA);
    WAIT_BAR_V();
  }
  SBAR(); finishSM(pA0, pA1, alA, l_reg, pa0, pa1, pa2, pa3); SBAR();
  QKT(pB0, pB1, 1); MASK(pB0, pB1, NT - 1); SBAR();
  pv_all<NDV>(o, vb0, pa0, pa1, pa2, pa3); partialSM(pB0, pB1, m_reg, mnB, alB, C, THRS);
  WAIT_BAR(0); RESC(alB);
  finishSM(pB0, pB1, alB, l_reg, pa0, pa1, pa2, pa3); SBAR();
  pv_all<NDV>(o, vb0 + SHM_V, pa0, pa1, pa2, pa3);
  if (P.has_sink) l_reg += __builtin_amdgcn_exp2f(P.sink * 1.4426950408889634f - m_reg * C);
  if (hi == 0) li_l[r32] = l_reg; asm volatile("s_waitcnt lgkmcnt(0)" ::: "memory");
  float rli[16];
#pragma unroll
  for (int r = 0; r < 16; ++r) rli[r] = __builtin_amdgcn_rcpf(li_l[crow(r, hi)]);
  bf16_t* Ow = P.O + (size_t)(wid * QBLK) * P.ldo;
#pragma unroll
  for (int r = 0; r < 16; ++r) { const int orow = crow(r, hi);
#pragma unroll
    for (int d0 = 0; d0 < NDV; ++d0) Ow[(size_t)orow * P.ldo + d0 * 32 + r32] = f2bf(o[d0][r] * rli[r]); }
  LBAR();
#undef TROW
#undef DMA_K
#undef DMA_V
#undef WAIT_BAR
#undef WAIT_BAR_V
#undef LBAR
#undef RESC
#undef MASK
#undef QKT
}
#undef SBAR
}

struct Ctx {
    unsigned char* lds; LAS unsigned char* lds3;
    int tid, lane, wave, G, bx, vcu;
};

#define LDS_BAR() asm volatile("s_waitcnt lgkmcnt(0)\n\ts_barrier" ::: "memory")
__device__ __forceinline__ Ctx make_ctx(unsigned char* lds, const int wave_s) {
    Ctx T; const int tid_ = tid_from_(wave_s);
    T.lds = lds; T.lds3 = (LAS unsigned char*)lds; T.tid = tid_; T.lane = tid_ & 63; T.wave = __builtin_amdgcn_readfirstlane(tid_ >> 6);
    T.G = gridDim.x; T.bx = blockIdx.x; T.vcu = (T.G % 8 == 0) ? (T.bx % 8) * (T.G / 8) + T.bx / 8 : T.bx;
    return T;
}
__device__ __forceinline__ void transpose_item(const float* W, int K, int N, bf16_t* WT, LAS float* scr, int item, int lane) {
    const int nblk = N / 32, kb = item / nblk, nb = item % nblk, k0 = 64 * kb, n0 = 32 * nb;
    float wv[32];
#pragma unroll
    for (int i = 0; i < 32; ++i) wv[i] = W[(size_t)(k0 + 2 * i + (lane >> 5)) * N + n0 + (lane & 31)];
#pragma unroll
    for (int i = 0; i < 32; ++i) scr[(2 * i + (lane >> 5)) * 33 + (lane & 31)] = wv[i];
    asm volatile("s_waitcnt lgkmcnt(0)" ::: "memory");
    const int c = lane & 7;
#pragma unroll
    for (int j = 0; j < 4; ++j) { const int n = (lane >> 3) + 8 * j; const LAS float* s = scr + (8 * c) * 33 + n;
        u32x4 o; o.x = cvt_pk_bf16(s[0 * 33], s[1 * 33]); o.y = cvt_pk_bf16(s[2 * 33], s[3 * 33]); o.z = cvt_pk_bf16(s[4 * 33], s[5 * 33]); o.w = cvt_pk_bf16(s[6 * 33], s[7 * 33]);
        *(u32x4*)(WT + (size_t)(n0 + n) * K + k0 + 8 * c) = o; }
    asm volatile("s_waitcnt lgkmcnt(0)" ::: "memory");
}

struct Params { const float* in[23]; float* out; unsigned char* ws; int ph_lo, ph_hi; };
enum { I_X = 0, I_C, I_CTX, I_CCTX, I_ADAW, I_ADAB, I_NMIX, I_NMLP, I_WIN, I_QN, I_WUQ, I_KVN, I_WUKV, I_SINK, I_CONVW, I_CONVB, I_LNG, I_LNB, I_ONORM, I_WOUT, I_W1, I_W2, I_FNORM };

__device__ __forceinline__ void prologue_phase(const Ctx& T, const Params& p) {
    float* mod = (float*)(p.ws + WS_MOD);
    {
        float* sil = (float*)T.lds;
        float* red = sil + 5 * DM;
        for (int i = T.tid; i < 5 * DM; i += 512) { const int r = i >> 11, k = i & (DM - 1); const float v = r < 4 ? p.in[I_C][r * DM + k] : p.in[I_CCTX][k]; sil[i] = v * sigmoidf_(v); }
        __syncthreads();
        for (int item = T.bx; item < 2 * 96; item += T.G) {
            const int l = item / 96, cb = item % 96, col = cb * 128 + 2 * T.lane;
            const float* W = p.in[I_ADAW] + (size_t)l * DM * MODW + col;
            float a0[5], a1[5];
#pragma unroll
            for (int r = 0; r < 5; ++r) { a0[r] = 0.f; a1[r] = 0.f; }
            const int k0 = T.wave * 256;
            for (int k = k0; k < k0 + 256; k += 16) {
                f32x2 w[16];
#pragma unroll
                for (int i = 0; i < 16; ++i) w[i] = *(const f32x2*)(W + (size_t)(k + i) * MODW);
#pragma unroll
                for (int i = 0; i < 16; ++i)
#pragma unroll
                    for (int r = 0; r < 5; ++r) { const float s = sil[r * DM + k + i]; a0[r] += s * w[i].x; a1[r] += s * w[i].y; }
            }
#pragma unroll
            for (int r = 0; r < 5; ++r) { red[(T.wave * 5 + r) * 128 + 2 * T.lane] = a0[r]; red[(T.wave * 5 + r) * 128 + 2 * T.lane + 1] = a1[r]; }
            __syncthreads();
            for (int i = T.tid; i < 5 * 128; i += 512) { const int r = i >> 7, cc = i & 127; float s = 0.f;
#pragma unroll
                for (int w = 0; w < 8; ++w) s += red[(w * 5 + r) * 128 + cc];
                mod[(size_t)(l * 5 + r) * MODW + cb * 128 + cc] = s + p.in[I_ADAB][l * MODW + cb * 128 + cc]; }
            __syncthreads();
        }
    }
    {
        LAS float* scr = (LAS float*)(T.lds3 + T.wave * 16384);
        const int gw = T.bx * 8 + T.wave, NGW = T.G * 8;
        constexpr int I_IN = (DM / 64) * (INW / 32), I_UQ = (512 / 64) * (QW / 32), I_UKV = (512 / 64) * (KVW / 32), I_OUT = (DM / 64) * (DM / 32), I_1 = (DM / 64) * (FF / 32), I_2 = (FF / 64) * (DM / 32);
        constexpr int PER_L = I_IN + I_UQ + I_UKV + I_OUT + I_1 + I_2;
        for (int it = gw; it < 2 * PER_L; it += NGW) {
            const int l = it / PER_L; int r = it % PER_L;
            unsigned char* wl = p.ws + WS_WL + (size_t)l * WL_SIZE;
            if (r < I_IN) { transpose_item(p.in[I_WIN] + (size_t)l * DM * INW, DM, INW, (bf16_t*)(wl + WL_IN), scr, r, T.lane); continue; } r -= I_IN;
            if (r < I_UQ) { transpose_item(p.in[I_WUQ] + (size_t)l * 512 * QW, 512, QW, (bf16_t*)(wl + WL_UQ), scr, r, T.lane); continue; } r -= I_UQ;
            if (r < I_UKV) { transpose_item(p.in[I_WUKV] + (size_t)l * 512 * KVW, 512, KVW, (bf16_t*)(wl + WL_UKV), scr, r, T.lane); continue; } r -= I_UKV;
            if (r < I_OUT) { transpose_item(p.in[I_WOUT] + (size_t)l * DM * DM, DM, DM, (bf16_t*)(wl + WL_OUT), scr, r, T.lane); continue; } r -= I_OUT;
            if (r < I_1) { transpose_item(p.in[I_W1] + (size_t)l * DM * FF, DM, FF, (bf16_t*)(wl + WL_W1), scr, r, T.lane); continue; } r -= I_1;
            transpose_item(p.in[I_W2] + (size_t)l * FF * DM, FF, DM, (bf16_t*)(wl + WL_W2), scr, r, T.lane);
        }
        const int gt = T.bx * 512 + T.tid, NGT = T.G * 512;
        constexpr int PADV = (INWP - INW) * DM * 2 / 16;
        for (int i = gt; i < 2 * PADV; i += NGT) { const int l = i / PADV, j = i % PADV;
            *(u32x4*)(p.ws + WS_WL + (size_t)l * WL_SIZE + WL_IN + (size_t)INW * DM * 2 + (size_t)j * 16) = (u32x4){0u, 0u, 0u, 0u}; }
    }
}

template <int TR, bool SLABS>
__device__ __forceinline__ void norm_tile(const Ctx& T, float* red, const float* xb  , const f32x4 gs, const f32x4 sh4, bf16_t* ob  ,
                                          const float* sb  , const f32x4 gt, float* xo  ) {
    f32x4 v[TR];
#pragma unroll
    for (int i = 0; i < TR; ++i) v[i] = *(const f32x4*)(xb + (size_t)i * DM);
    if constexpr (SLABS) {
        f32x4 sv[TR][8];
#pragma unroll
        for (int i = 0; i < TR; ++i)
#pragma unroll
            for (int sl = 0; sl < 8; ++sl) sv[i][sl] = *(const f32x4*)(sb + ((size_t)sl * NCTXR + i) * DM);
#pragma unroll
        for (int i = 0; i < TR; ++i) { const f32x4 a = ((sv[i][0] + sv[i][1]) + (sv[i][2] + sv[i][3])) + ((sv[i][4] + sv[i][5]) + (sv[i][6] + sv[i][7]));
            v[i] += gt * a; *(f32x4*)(xo + (size_t)i * DM) = v[i]; }
    }
    { float ss[TR];
#pragma unroll
      for (int i = 0; i < TR; ++i) ss[i] = (v[i].x * v[i].x + v[i].y * v[i].y) + (v[i].z * v[i].z + v[i].w * v[i].w);
      wave_sum_n<TR>(ss, T.lane);
#pragma unroll
      for (int i = 0; i < TR; ++i) if (T.lane == i) red[i * 8 + T.wave] = ss[i]; }
    LDS_BAR();
#pragma unroll
    for (int i = 0; i < TR; ++i) { const f32x4 a = *(const f32x4*)(red + i * 8), b = *(const f32x4*)(red + i * 8 + 4);
        const float rstd = 1.0f / sqrtf((((a.x + a.y) + (a.z + a.w)) + ((b.x + b.y) + (b.z + b.w))) * (1.0f / DM) + EPS);
        const f32x4 y = v[i] * rstd * gs + sh4;
        u32x2 w; w.x = cvt_pk_bf16(y.x, y.y); w.y = cvt_pk_bf16(y.z, y.w); *(u32x2*)(ob + (size_t)i * DM) = w; }
    LDS_BAR();
}
__device__ __forceinline__ void modnorm_phase(const Ctx& T, const float* src_lat, const float* src_ctx, int nrows, const float* gw, const float* modl, int sh_off, int sc_off, bf16_t* out, const float* slab, const float* gate, float* xout) {
    float* red = (float*)T.lds;
    const int col = 4 * T.tid;
    const f32x4 g4 = *(const f32x4*)(gw + col);
    for (int t = T.bx; t < NLAT / 16; t += T.G) {
        const int r0 = t * 16; const float* mr = modl + (size_t)(r0 >> 12) * MODW + col;
        const f32x4 gs = g4 * (*(const f32x4*)(mr + sc_off) + 1.0f), sh4 = *(const f32x4*)(mr + sh_off);
        norm_tile<16, false>(T, red, src_lat + (size_t)r0 * DM + col, gs, sh4, out + (size_t)r0 * DM + col, nullptr, gs, nullptr);
    }
    if (nrows > NLAT) {
        const float* mr = modl + (size_t)4 * MODW + col;
        const f32x4 gs = g4 * (*(const f32x4*)(mr + sc_off) + 1.0f), sh4 = *(const f32x4*)(mr + sh_off);
        for (int t = T.bx; t < NCTXR / 4; t += T.G) {
            const int rc = t * 4;
            if (slab) { const f32x4 gt = *(const f32x4*)(gate + (size_t)4 * MODW + col);
                norm_tile<4, true>(T, red, src_ctx + (size_t)rc * DM + col, gs, sh4, out + (size_t)(NLAT + rc) * DM + col, slab + (size_t)rc * DM + col, gt, xout + (size_t)(NLAT + rc) * DM + col); }
            else norm_tile<4, false>(T, red, src_ctx + (size_t)rc * DM + col, gs, sh4, out + (size_t)(NLAT + rc) * DM + col, nullptr, gs, nullptr);
        }
    }
}
__device__ __forceinline__ void finalnorm_phase(const Ctx& T, const float* x, const float* gw, float* out) {
    constexpr int TR = 16;
    float* red = (float*)T.lds;
    const int col = 4 * T.tid;
    const f32x4 g4 = *(const f32x4*)(gw + col);
    for (int t = T.bx; t < NLAT / TR; t += T.G) {
        const int r0 = t * TR;
        f32x4 v[TR];
#pragma unroll
        for (int i = 0; i < TR; ++i) v[i] = *(const f32x4*)(x + (size_t)(r0 + i) * DM + col);
        { float ss[TR];
#pragma unroll
          for (int i = 0; i < TR; ++i) ss[i] = (v[i].x * v[i].x + v[i].y * v[i].y) + (v[i].z * v[i].z + v[i].w * v[i].w);
          wave_sum_n<TR>(ss, T.lane);
#pragma unroll
          for (int i = 0; i < TR; ++i) if (T.lane == i) red[i * 8 + T.wave] = ss[i]; }
        LDS_BAR();
#pragma unroll
        for (int i = 0; i < TR; ++i) { const f32x4 a = *(const f32x4*)(red + i * 8), b = *(const f32x4*)(red + i * 8 + 4);
            const float rstd = 1.0f / sqrtf((((a.x + a.y) + (a.z + a.w)) + ((b.x + b.y) + (b.z + b.w))) * (1.0f / DM) + EPS);
            *(f32x4*)(out + (size_t)(r0 + i) * DM + col) = v[i] * rstd * g4; }
        LDS_BAR();
    }
}

__device__ __forceinline__ void unpack8(const u32x4 w, float* f) { f[0] = bflo(w.x); f[1] = bfhi(w.x); f[2] = bflo(w.y); f[3] = bfhi(w.y); f[4] = bflo(w.z); f[5] = bfhi(w.z); f[6] = bflo(w.w); f[7] = bfhi(w.w); }
__device__ __forceinline__ u32x4 pack8(const float* f) { u32x4 w; w.x = cvt_pk_bf16(f[0], f[1]); w.y = cvt_pk_bf16(f[2], f[3]); w.z = cvt_pk_bf16(f[4], f[5]); w.w = cvt_pk_bf16(f[6], f[7]); return w; }

__device__ __forceinline__ void prep_phase(const Ctx& T, bf16_t* U, const float* qn, const float* kvn) {
    constexpr int RR = 4;
    const int gwv = T.bx * 8 + T.wave, NGW = T.G * 8, lane = T.lane;
    float gq[8], gk[8];
#pragma unroll
    for (int j = 0; j < 8; ++j) { gq[j] = qn[8 * lane + j]; gk[j] = kvn[8 * lane + j]; }
    const int a = (lane >> 4) & 1, fi = lane & 15;
    for (int r0 = gwv * RR; r0 < NROW; r0 += NGW * RR) {
        u32x4 vq[RR], vk[RR], va[RR], vg[RR]; unsigned short x1a[RR], x2a[RR], x1b[RR], x2b[RR]; f32x2 rcs[RR];
        const bool lat = r0 < NLAT;
        const int ia = U_AKR + 32 * a + fi, ib = U_BK + (lane >> 5) * 64 + 32 * a + fi;
#pragma unroll
        for (int i = 0; i < RR; ++i) { const bf16_t* ur = U + (size_t)(r0 + i) * INWP;
            vq[i] = ((const u32x4*)(ur + U_AQ))[lane]; vk[i] = ((const u32x4*)(ur + U_AKV))[lane]; va[i] = ((const u32x4*)(ur + U_CA))[lane]; vg[i] = ((const u32x4*)(ur + U_CG))[lane];
            if (lat) { x1a[i] = ur[ia]; x2a[i] = ur[ia + 16]; x1b[i] = ur[ib]; x2b[i] = ur[ib + 16];
                const int t = (r0 + i) & (SEQ - 1), pos = a ? (t & 63) : (t >> 6); rcs[i] = *(const f32x2*)(ROPE_TAB + (pos * 16 + fi) * 2); } }
        float ssq[2 * RR];
#pragma unroll
        for (int i = 0; i < RR; ++i) { float f[8]; unpack8(vq[i], f); float s = 0.f;
#pragma unroll
            for (int j = 0; j < 8; ++j) s += f[j] * f[j];
            ssq[2 * i] = s; unpack8(vk[i], f); s = 0.f;
#pragma unroll
            for (int j = 0; j < 8; ++j) s += f[j] * f[j];
            ssq[2 * i + 1] = s; }
        wave_sum_n<2 * RR>(ssq, lane);
#pragma unroll
        for (int i = 0; i < RR; ++i) { bf16_t* ur = U + (size_t)(r0 + i) * INWP; float f[8];
            { unpack8(vq[i], f); const float rstd = 1.0f / sqrtf(ssq[2 * i] * (1.0f / 512.0f) + EPS);
#pragma unroll
              for (int j = 0; j < 8; ++j) f[j] = f[j] * rstd * gq[j];
              ((u32x4*)(ur + U_AQ))[lane] = pack8(f); }
            { unpack8(vk[i], f); const float rstd = 1.0f / sqrtf(ssq[2 * i + 1] * (1.0f / 512.0f) + EPS);
#pragma unroll
              for (int j = 0; j < 8; ++j) f[j] = f[j] * rstd * gk[j];
              ((u32x4*)(ur + U_AKV))[lane] = pack8(f); }
            if (lat) {
                const float c = rcs[i].x, s = rcs[i].y;
                if (lane < 32) { const float x1 = bf2f(x1a[i]), x2 = bf2f(x2a[i]); ur[ia] = f2bf(x1 * c - x2 * s); ur[ia + 16] = f2bf(x2 * c + x1 * s); }
                { const float x1 = bf2f(x1b[i]), x2 = bf2f(x2b[i]); ur[ib] = f2bf(x1 * c - x2 * s); ur[ib + 16] = f2bf(x2 * c + x1 * s); }
            }
            { float fg[8]; unpack8(va[i], f); unpack8(vg[i], fg);
#pragma unroll
              for (int j = 0; j < 8; ++j) f[j] = f[j] * sigmoidf_(fg[j]);
              ((u32x4*)(ur + U_CA))[lane] = pack8(f); }
        }
    }
}

__device__ __forceinline__ void mergenorm_phase(const Ctx& T, bf16_t* MIX, const float* on, int nrows) {
    constexpr int RR = 4;
    const int gwv = T.bx * 8 + T.wave, NGW = T.G * 8, lane = T.lane;
    float g0[8], g1[8], g2[8], g3[8];
#pragma unroll
    for (int j = 0; j < 8; ++j) { g0[j] = on[8 * lane + j]; g1[j] = on[512 + 8 * lane + j]; g2[j] = on[1024 + 8 * lane + j]; g3[j] = on[1536 + 8 * lane + j]; }
    for (int r0 = gwv * RR; r0 < nrows; r0 += NGW * RR) {
        u32x4 v0[RR], v1[RR], v2[RR], v3[RR];
#pragma unroll
        for (int i = 0; i < RR; ++i) { const u32x4* mr = (const u32x4*)(MIX + (size_t)(r0 + i) * MIXW) + lane; v0[i] = mr[0]; v1[i] = mr[64]; v2[i] = mr[128]; v3[i] = mr[192]; }
        float ssq[3 * RR];
#pragma unroll
        for (int i = 0; i < RR; ++i) { float f[8], h[8]; unpack8(v0[i], f); unpack8(v1[i], h); float s = 0.f;
#pragma unroll
            for (int j = 0; j < 8; ++j) s += f[j] * f[j] + h[j] * h[j];
            ssq[3 * i] = s; unpack8(v2[i], f); s = 0.f;
#pragma unroll
            for (int j = 0; j < 8; ++j) s += f[j] * f[j];
            ssq[3 * i + 1] = s; unpack8(v3[i], f); s = 0.f;
#pragma unroll
            for (int j = 0; j < 8; ++j) s += f[j] * f[j];
            ssq[3 * i + 2] = s; }
        wave_sum_n<3 * RR>(ssq, lane);
#pragma unroll
        for (int i = 0; i < RR; ++i) { u32x4* mr = (u32x4*)(MIX + (size_t)(r0 + i) * MIXW) + lane; float f[8], h[8];
            { unpack8(v0[i], f); unpack8(v1[i], h); const float rstd = 1.0f / sqrtf(ssq[3 * i] * (1.0f / 1024.0f) + EPS);
#pragma unroll
              for (int j = 0; j < 8; ++j) { f[j] = f[j] * rstd * g0[j]; h[j] = h[j] * rstd * g1[j]; }
              mr[0] = pack8(f); mr[64] = pack8(h); }
            { unpack8(v2[i], f); const float rstd = 1.0f / sqrtf(ssq[3 * i + 1] * (1.0f / 512.0f) + EPS);
#pragma unroll
              for (int j = 0; j < 8; ++j) f[j] = f[j] * rstd * g2[j];
              mr[128] = pack8(f); }
            { unpack8(v3[i], f); const float rstd = 1.0f / sqrtf(ssq[3 * i + 2] * (1.0f / 512.0f) + EPS);
#pragma unroll
              for (int j = 0; j < 8; ++j) f[j] = f[j] * rstd * g3[j];
              mr[192] = pack8(f); }
        }
    }
}

__device__ __forceinline__ void conv_phase(const Ctx& T, const bf16_t* U, bf16_t* MIX, const float* cw, const float* cb, const float* lng, const float* lnb, int nitems) {
    constexpr int CR = 16, NL = CR + 30;
    const int c = T.tid;
    float w[31];
#pragma unroll
    for (int k = 0; k < 31; ++k) w[k] = cw[k * 512 + c];
    const float bias = cb[c], g = lng[c], b = lnb[c];
    float* red = (float*)T.lds;
    unsigned short hv[NL], hn[NL];
#define CONV_LOAD(dst, it) do { const int r0_ = (it) * CR; int s0_, s1_; \
        if (r0_ < NLAT) { s0_ = r0_ & ~(SEQ - 1); s1_ = s0_ + SEQ; } else { s0_ = NLAT + ((r0_ - NLAT) & ~(CTXL - 1)); s1_ = s0_ + CTXL; } \
        _Pragma("unroll") for (int j = 0; j < NL; ++j) { int rr = r0_ - 15 + j; rr = rr < s0_ ? s0_ : (rr >= s1_ ? s1_ - 1 : rr); dst[j] = U[(size_t)rr * INWP + U_CA + c]; } } while (0)
    int item = T.bx; asm volatile("" : "+s"(item));
    if (item < nitems) CONV_LOAD(hv, item);
    while (item < nitems) {
        const int nxt = item + T.G;
        if (nxt < nitems) CONV_LOAD(hn, nxt);
        const int r0 = item * CR;
        int seg0, seg1;
        if (r0 < NLAT) { seg0 = r0 & ~(SEQ - 1); seg1 = seg0 + SEQ; } else { seg0 = NLAT + ((r0 - NLAT) & ~(CTXL - 1)); seg1 = seg0 + CTXL; }
        float acc[CR];
#pragma unroll
        for (int i = 0; i < CR; ++i) acc[i] = bias;
#pragma unroll
        for (int j = 0; j < NL; ++j) {
            const int rr = r0 - 15 + j;
            const float v = (rr >= seg0 && rr < seg1) ? bf2f(hv[j]) : 0.f;
#pragma unroll
            for (int i = 0; i < CR; ++i) { const int k = j - i; if (k >= 0 && k < 31) acc[i] += w[k] * v; }
        }
        float s[2 * CR];
#pragma unroll
        for (int i = 0; i < CR; ++i) { s[i] = acc[i]; s[CR + i] = acc[i] * acc[i]; }
        wave_sum_n<2 * CR>(s, T.lane);
#pragma unroll
        for (int q = 0; q < 2 * CR; ++q) if (T.lane == q) red[T.wave * 2 * CR + q] = s[q];
        LDS_BAR();
#pragma unroll
        for (int i = 0; i < CR; ++i) {
            float sm = 0.f, sq = 0.f;
#pragma unroll
            for (int wv = 0; wv < 8; ++wv) { sm += red[wv * 2 * CR + i]; sq += red[wv * 2 * CR + CR + i]; }
            const float mean = sm * (1.0f / 512.0f); const float var = fmaxf(sq * (1.0f / 512.0f) - mean * mean, 0.f);
            const float y = (acc[i] - mean) * __builtin_amdgcn_rsqf(var + EPS) * g + b;
            MIX[(size_t)(r0 + i) * MIXW + 1536 + c] = f2bf(y * sigmoidf_(y));
        }
        LDS_BAR();
#pragma unroll
        for (int j = 0; j < NL; ++j) hv[j] = hn[j];
        item = nxt;
    }
#undef CONV_LOAD
}

#define XB_TMO      128
#define XB_XCNT(j)  (256  + 64 * (j))
#define XB_XSUB(j)  (1280 + 64 * (j))
#define XB_XGEN(j)  (2304 + 64 * (j))
#define XB_TOP      3328
#define XB_TOPGEN   3392
#define XCD_BAR_WORDS 3456
#define XB_SPIN_CAP (1u << 20)
__device__ __forceinline__ unsigned xb_ld(unsigned* p)              { return __hip_atomic_load(p, __ATOMIC_RELAXED, __HIP_MEMORY_SCOPE_AGENT); }
__device__ __forceinline__ unsigned xb_add(unsigned* p, unsigned v) { return __hip_atomic_fetch_add(p, v, __ATOMIC_RELAXED, __HIP_MEMORY_SCOPE_AGENT); }
__device__ __forceinline__ unsigned xb_xcc_id() { return (unsigned)__builtin_amdgcn_s_getreg((3 << 11) | 20) & 0xFu; }
#define XB_SPIN(cond, bar) do { unsigned _sp = 0; while (cond) { __builtin_amdgcn_s_sleep(1); \
    if ((++_sp & 255u) == 0u) { if (xb_ld(&(bar)[XB_TMO])) break; if (_sp > XB_SPIN_CAP) { atomicAdd(&(bar)[XB_TMO], 1u); break; } } } } while (0)
struct XcdBarrier { unsigned* bar; unsigned x; volatile LAS unsigned* st; };
__device__ __forceinline__ XcdBarrier xcd_barrier_post(unsigned* bar, volatile LAS unsigned* st, const int tid) {
    XcdBarrier b; b.bar = bar; b.x = xb_xcc_id(); b.st = st;
    if (tid == 0) (void)xb_add(&bar[XB_XCNT(b.x)], 1u);
    return b;
}
__device__ __forceinline__ void xcd_barrier_complete(unsigned* bar, unsigned x, unsigned& nloc, unsigned& nx) {
    const unsigned G = gridDim.x * gridDim.y * gridDim.z;
    unsigned sum, cnt, mine, sp = 0u;
    for (;;) {
        sum = 0u; cnt = 0u; mine = 0u;
#pragma unroll
        for (unsigned j = 0; j < 16; ++j) { const unsigned c = xb_ld(&bar[XB_XCNT(j)]); sum += c; cnt += (c > 0u) ? 1u : 0u; mine = (j == x) ? c : mine; }
        if (sum == G) break;
        __builtin_amdgcn_s_sleep(1);
        if ((++sp & 255u) == 0u) { if (xb_ld(&bar[XB_TMO])) break; if (sp > XB_SPIN_CAP) { atomicAdd(&bar[XB_TMO], 1u); break; } }
    }
    nloc = mine > 0u ? mine : 1u; nx = cnt > 0u ? cnt : 1u;
}
__device__ __forceinline__ void xcd_barrier(const XcdBarrier& b, const int tid) {
    asm volatile("s_waitcnt vmcnt(0)" ::: "memory");
    __syncthreads();
    if (tid == 0) {
        unsigned* bar = b.bar;
        __builtin_amdgcn_s_waitcnt(0);
        unsigned nloc = b.st[0], nx = b.st[1];
        if (nloc == 0u) { xcd_barrier_complete(bar, b.x, nloc, nx); b.st[0] = nloc; b.st[1] = nx; }
        const unsigned old = xb_add(&bar[XB_XSUB(b.x)], 1u);
        const unsigned gen = old / nloc;
        if (old + 1u == (gen + 1u) * nloc) {
            __builtin_amdgcn_fence(__ATOMIC_RELEASE, "agent");
            asm volatile("s_waitcnt vmcnt(0)" ::: "memory");
            const unsigned og = xb_add(&bar[XB_TOP], 1u);
            const unsigned tg = og / nx;
            if (og + 1u == (tg + 1u) * nx) xb_add(&bar[XB_TOPGEN], 1u);
            else XB_SPIN(xb_ld(&bar[XB_TOPGEN]) == tg, bar);
            __builtin_amdgcn_fence(__ATOMIC_ACQUIRE, "agent");
            xb_add(&bar[XB_XGEN(b.x)], 1u);
            asm volatile("s_waitcnt vmcnt(0)" ::: "memory");
        } else {
            XB_SPIN(xb_ld(&bar[XB_XGEN(b.x)]) == gen, bar);
            __builtin_amdgcn_fence(__ATOMIC_ACQUIRE, "agent");
            asm volatile("s_waitcnt vmcnt(0)" ::: "memory");
        }
    }
    __syncthreads();
}

#ifndef PH_MASK
#define PH_MASK 0xFFFF
#endif
#ifndef DUP_MASK
#define DUP_MASK 0
#endif
#ifndef DUP_SUB
#define DUP_SUB 0
#endif
#ifndef DUP_BAR
#define DUP_BAR 0
#endif
#ifndef DUP_L
#define DUP_L 3
#endif
__global__ void __launch_bounds__(512, 2) mega_fwd(Params p) {
    extern __shared__ __attribute__((aligned(16))) unsigned char lds[];
    cg::grid_group grid = cg::this_grid();
    unsigned char* ws = p.ws;
    float* mod = (float*)(ws + WS_MOD);
    float* XB = (float*)(ws + WS_X);
    bf16_t* HN = (bf16_t*)(ws + WS_HN); bf16_t* U = (bf16_t*)(ws + WS_U); bf16_t* QB = (bf16_t*)(ws + WS_Q); bf16_t* KVB = (bf16_t*)(ws + WS_KV);
    bf16_t* MIX = (bf16_t*)(ws + WS_MIX); bf16_t* ACT = (bf16_t*)(ws + WS_ACT); float* SLAB = (float*)(ws + WS_SLAB);
    const int wave_s = __builtin_amdgcn_readfirstlane((int)threadIdx.x >> 6);
    { volatile LAS unsigned* m = (volatile LAS unsigned*)((LAS unsigned char*)lds + 131072); const int t0 = tid_from_(wave_s); if (t0 < 64) m[t0] = 0u; }
    __syncthreads();
    if (p.ph_hi - p.ph_lo > 1) (void)xcd_barrier_post((unsigned*)(ws + WS_CTL), (volatile LAS unsigned*)((LAS unsigned char*)lds + 131072) + 8, tid_from_(wave_s));
    int ph = 0; int l_ = 0;
#define RUN(k) ((k) >= p.ph_lo && (k) < p.ph_hi)
#define GBAR() do { XcdBarrier xb_; xb_.bar = (unsigned*)(p.ws + WS_CTL); xb_.x = xb_xcc_id(); xb_.st = (volatile LAS unsigned*)((LAS unsigned char*)lds + 131072) + 8; xcd_barrier(xb_, tid_from_(wave_s)); } while (0)
#define SEAM() do { if (ph >= p.ph_lo && ph + 1 < p.ph_hi) { if (p.ph_lo < 0) grid.sync();   for (int rb_ = 0; rb_ <= DUP_BAR; ++rb_) { XcdBarrier xb_; xb_.bar = (unsigned*)(p.ws + WS_CTL); xb_.x = xb_xcc_id(); xb_.st = (volatile LAS unsigned*)((LAS unsigned char*)lds + 131072) + 8; xcd_barrier(xb_, tid_from_(wave_s)); } } ++ph; } while (0)

    if (((PH_MASK >> 0) & 1) && RUN(ph)) { for (int rep_ = 0; rep_ < 1 + ((DUP_MASK >> 0) & 1) * ((DUP_L >> l_) & 1); ++rep_) { if (rep_) GBAR(); { const Ctx T = make_ctx(lds, wave_s); prologue_phase(T, p); } } }
    SEAM();

    for (int l = 0; l < DEPTH; ++l) { l_ = l;
        const unsigned char* wl = ws + WS_WL + (size_t)l * WL_SIZE;
        const float* modl = mod + (size_t)l * 5 * MODW;
        const float* res_lat = l == 0 ? p.in[I_X] : XB;
        const float* res_ctx = l == 0 ? p.in[I_CTX] : XB + (size_t)NLAT * DM;
        const int mrows = l == 0 ? NROW : NLAT;
        if (((PH_MASK >> 1) & 1) && RUN(ph)) { for (int rep_ = 0; rep_ < 1 + ((DUP_MASK >> 1) & 1) * ((DUP_L >> l_) & 1); ++rep_) { if (rep_) GBAR(); { const Ctx T = make_ctx(lds, wave_s); modnorm_phase(T, res_lat, res_ctx, NROW, p.in[I_NMIX] + l * DM, modl, 0 * DM, 1 * DM, HN, l == 1 ? SLAB : nullptr, mod + 5 * DM, XB); } } }
        SEAM();
        if (((PH_MASK >> 2) & 1) && RUN(ph)) { for (int rep_ = 0; rep_ < 1 + ((DUP_MASK >> 2) & 1) * ((DUP_L >> l_) & 1); ++rep_) { if (rep_) GBAR(); { const Ctx T = make_ctx(lds, wave_s);  pg8::Gemm g{HN, (const bf16_t*)(wl + WL_IN), NROW, INWP, DM, DM}; pg8::StaticOrder S; S.init(NROW, INWP, T.G, T.bx, DM);
            pg8::EpiBf16<0> E{U, INWP}; pg8::gemm_phase<pg8::EpiBf16<0>, pg8::StaticOrder, true, true>(T.lds3, g, S, E, wave_s); } } }
        SEAM();
        if (((PH_MASK >> 3) & 1) && RUN(ph)) { for (int rep_ = 0; rep_ < 1 + ((DUP_MASK >> 3) & 1) * ((DUP_L >> l_) & 1); ++rep_) { if (rep_) GBAR(); { const Ctx T = make_ctx(lds, wave_s); prep_phase(T, U, p.in[I_QN] + l * 512, p.in[I_KVN] + l * 512); } } }
        SEAM();
        if (((PH_MASK >> 4) & 1) && RUN(ph)) { for (int rep_ = 0; rep_ < 1 + ((DUP_MASK >> 4) & 1) * ((DUP_L >> l_) & 1); ++rep_) { if (rep_) GBAR(); { const Ctx T = make_ctx(lds, wave_s);
            for (int gi = 0; gi < 2; ++gi) {
                const int Mg = gi == 0 ? mrows : NROW, Ng = gi == 0 ? QW : KVW;
                pg8::Gemm g{U + (gi == 0 ? U_AQ : U_AKV), (const bf16_t*)(wl + (gi == 0 ? WL_UQ : WL_UKV)), Mg, Ng, 512, INWP}; pg8::StaticOrder S; S.init(Mg, Ng, T.G, T.bx, 512);
                pg8::EpiBf16<0> E{gi == 0 ? QB : KVB, Ng}; pg8::gemm_phase<pg8::EpiBf16<0>, pg8::StaticOrder, true, true>(T.lds3, g, S, E, wave_s);
            }
        } } }
        SEAM();
        if (((PH_MASK >> 5) & 1) && RUN(ph)) { for (int rep_ = 0; rep_ < 1 + ((DUP_MASK >> 5) & 1) * ((DUP_L >> l_) & 1); ++rep_) { if (rep_) GBAR(); { const Ctx T = make_ctx(lds, wave_s);
            const float CA = MLA_SCALE * 1.4426950408889634f, CB = SWA_SCALE * 1.4426950408889634f;
            const int nu = l == 0 ? 544 : 512;
            for (int rs_ = 0; rs_ < 1 + (DUP_SUB & 1); ++rs_)
            for (int u = T.vcu; u < nu; u += T.G) {
                att::UnitP P; P.ldq = QW; P.ldkn = KVW; P.Kp = U + U_AKR; P.ldkp = INWP; P.ldv = KVW; P.ldo = MIXW; P.masked = 0; P.kpos1 = 0; P.has_sink = 0; P.sink = 0.f;
                if (u < 512) { const int bh = u >> 4, qb = u & 15, b = bh >> 3, h = bh & 7; const size_t q0 = (size_t)b * SEQ + qb * 256;
                    P.Q = QB + q0 * QW + h * 192; P.Kn = KVB + h * 256; P.V = KVB + h * 256 + 128; P.O = MIX + q0 * MIXW + h * 128;
                    P.base0 = b * SEQ; P.n0 = 64; P.base1 = NLAT + b * CTXL; P.NT = 68; P.qpos0 = qb * 256; P.rope = 1; }
                else { const int bh = u - 512, b = bh >> 3, h = bh & 7; const size_t q0 = (size_t)NLAT + b * CTXL;
                    P.Q = QB + q0 * QW + h * 192; P.Kn = KVB + h * 256; P.V = KVB + h * 256 + 128; P.O = MIX + q0 * MIXW + h * 128;
                    P.base0 = NLAT + b * CTXL; P.n0 = 4; P.base1 = 0; P.NT = 4; P.qpos0 = 0; P.rope = 0; }
#ifndef NO_MLA
                att::attn_unit<12, 4, 1>(P, (char*)lds, CA, att::THR / MLA_SCALE, wave_s);
#endif
            }
            for (int rs_ = 0; rs_ < 1 + ((DUP_SUB >> 1) & 1); ++rs_)
            for (int u = T.vcu; u < nu; u += T.G) {
                att::UnitP P; P.ldq = INWP; P.Kn = nullptr; P.ldkn = 0; P.ldkp = INWP; P.ldv = INWP; P.ldo = MIXW; P.has_sink = 1;
                if (u < 512) { const int bh = u >> 4, qb = u & 15, b = bh >> 3, h = bh & 7, kvh = h >> 2; const size_t q0 = (size_t)b * SEQ + qb * 256;
                    const int kt0 = qb * 256 - 128 < 0 ? 0 : qb * 256 - 128, kt1 = qb * 256 + 384 > SEQ ? SEQ : qb * 256 + 384;
                    P.Q = U + q0 * INWP + U_BQ + h * 64; P.Kp = U + U_BK + kvh * 64; P.V = U + U_BV + kvh * 64; P.O = MIX + q0 * MIXW + 1024 + h * 64;
                    P.base0 = NLAT + b * CTXL; P.n0 = 4; P.base1 = b * SEQ + kt0; P.NT = 4 + (kt1 - kt0) / 64; P.masked = 1; P.kpos1 = kt0; P.qpos0 = qb * 256; P.rope = 1; P.sink = p.in[I_SINK][l * 8 + h]; }
                else { const int bh = u - 512, b = bh >> 3, h = bh & 7, kvh = h >> 2; const size_t q0 = (size_t)NLAT + b * CTXL;
                    P.Q = U + q0 * INWP + U_BQ + h * 64; P.Kp = U + U_BK + kvh * 64; P.V = U + U_BV + kvh * 64; P.O = MIX + q0 * MIXW + 1024 + h * 64;
                    P.base0 = NLAT + b * CTXL; P.n0 = 4; P.base1 = 0; P.NT = 4; P.masked = 0; P.kpos1 = 0; P.qpos0 = 0; P.rope = 0; P.sink = p.in[I_SINK][l * 8 + h]; }
#ifndef NO_SWA
                att::attn_unit<4, 2, 0>(P, (char*)lds, CB, att::THR / SWA_SCALE, wave_s);
#endif
            }
#ifndef NO_CONV
            for (int rs_ = 0; rs_ < 1 + ((DUP_SUB >> 2) & 1); ++rs_)
            { const Ctx T2 = make_ctx(lds, wave_s);
            conv_phase(T2, U, MIX, p.in[I_CONVW] + l * 31 * 512, p.in[I_CONVB] + l * 512, p.in[I_LNG] + l * 512, p.in[I_LNB] + l * 512, mrows / 16); }
#endif
        } } }
        SEAM();
        if (((PH_MASK >> 6) & 1) && RUN(ph)) { for (int rep_ = 0; rep_ < 1 + ((DUP_MASK >> 6) & 1) * ((DUP_L >> l_) & 1); ++rep_) { if (rep_) GBAR(); { const Ctx T = make_ctx(lds, wave_s); mergenorm_phase(T, MIX, p.in[I_ONORM] + l * MIXW, mrows); } } }
        SEAM();
        if (((PH_MASK >> 7) & 1) && RUN(ph)) { for (int rep_ = 0; rep_ < 1 + ((DUP_MASK >> 7) & 1) * ((DUP_L >> l_) & 1); ++rep_) { if (rep_) GBAR(); { const Ctx T = make_ctx(lds, wave_s);  pg8::Gemm g{MIX, (const bf16_t*)(wl + WL_OUT), mrows, DM, DM, DM}; pg8::CtxSplitOrder S; S.init(DM, T.G, T.bx, DM, l == 0);
            pg8::EpiResid E{res_lat, res_ctx, XB, modl + 2 * DM, SLAB}; pg8::gemm_phase<pg8::EpiResid, pg8::CtxSplitOrder, true, true>(T.lds3, g, S, E, wave_s); } } }
        SEAM();
        if (((PH_MASK >> 8) & 1) && RUN(ph)) { for (int rep_ = 0; rep_ < 1 + ((DUP_MASK >> 8) & 1) * ((DUP_L >> l_) & 1); ++rep_) { if (rep_) GBAR(); { const Ctx T = make_ctx(lds, wave_s); modnorm_phase(T, XB, l == 0 ? p.in[I_CTX] : XB + (size_t)NLAT * DM, mrows, p.in[I_NMLP] + l * DM, modl, 3 * DM, 4 * DM, HN, l == 0 ? SLAB : nullptr, mod + 2 * DM, XB); } } }
        SEAM();
        if (((PH_MASK >> 9) & 1) && RUN(ph)) { for (int rep_ = 0; rep_ < 1 + ((DUP_MASK >> 9) & 1) * ((DUP_L >> l_) & 1); ++rep_) { if (rep_) GBAR(); { const Ctx T = make_ctx(lds, wave_s);  pg8::Gemm g{HN, (const bf16_t*)(wl + WL_W1), mrows, FF, DM, DM}; pg8::StaticOrder S; S.init(mrows, FF, T.G, T.bx, DM);
            pg8::EpiBf16<2> E{ACT, FF}; pg8::gemm_phase<pg8::EpiBf16<2>, pg8::StaticOrder, true, true>(T.lds3, g, S, E, wave_s); } } }
        SEAM();
        if (((PH_MASK >> 10) & 1) && RUN(ph)) { for (int rep_ = 0; rep_ < 1 + ((DUP_MASK >> 10) & 1) * ((DUP_L >> l_) & 1); ++rep_) { if (rep_) GBAR(); { const Ctx T = make_ctx(lds, wave_s);  pg8::Gemm g{ACT, (const bf16_t*)(wl + WL_W2), mrows, DM, FF, FF}; pg8::CtxSplitOrder S; S.init(DM, T.G, T.bx, FF, l == 0);
            pg8::EpiResid E{XB, XB + (size_t)NLAT * DM, XB, modl + 5 * DM, SLAB}; pg8::gemm_phase<pg8::EpiResid, pg8::CtxSplitOrder, true, true>(T.lds3, g, S, E, wave_s); } } }
        SEAM();
    }
    if (((PH_MASK >> 11) & 1) && RUN(ph)) { for (int rep_ = 0; rep_ < 1 + ((DUP_MASK >> 11) & 1) * ((DUP_L >> l_) & 1); ++rep_) { if (rep_) GBAR(); { const Ctx T = make_ctx(lds, wave_s); finalnorm_phase(T, XB, p.in[I_FNORM], p.out); } } }
#undef RUN
#undef SEAM
}

constexpr int LDS_BYTES = 131072 + 1024;
constexpr int N_PHASES = 1 + 10 * DEPTH + 1;
#ifndef MK_ONE_LAUNCH
#define MK_ONE_LAUNCH 1
#endif
extern "C" void kernel_launch(void* const* d_in, const int* in_sizes, int n_in, void* d_out, int out_size, void* d_ws, size_t ws_size, hipStream_t stream) {
    static int grid = 0;
    if (grid == 0) {
        if (n_in != 23 || ws_size < WS_END || out_size != NLAT * DM) { fprintf(stderr, "kernel_launch: unexpected shapes: n_in %d ws %zu (need %zu) out %d\n", n_in, ws_size, (size_t)WS_END, out_size); grid = -1; return; }
        int dev = 0, cus = 0, per_cu = 0;
        hipGetDevice(&dev); hipDeviceGetAttribute(&cus, hipDeviceAttributeMultiprocessorCount, dev);
        if (hipFuncSetAttribute((const void*)mega_fwd, hipFuncAttributeMaxDynamicSharedMemorySize, LDS_BYTES) != hipSuccess) { fprintf(stderr, "kernel_launch: hipFuncSetAttribute failed\n"); grid = -1; return; }
        hipOccupancyMaxActiveBlocksPerMultiprocessor(&per_cu, (const void*)mega_fwd, 512, LDS_BYTES);
        (void)hipGetLastError();
        if (per_cu < 1) { fprintf(stderr, "kernel_launch: occupancy query says %d blocks per CU\n", per_cu); per_cu = 1; }
        grid = cus;
    }
    if (grid < 0) return;
    (void)hipMemsetAsync((char*)d_ws + WS_CTL, 0, 16384, stream);
    Params p{};
    for (int i = 0; i < 23; ++i) p.in[i] = (const float*)d_in[i];
    p.out = (float*)d_out; p.ws = (unsigned char*)d_ws;
#if MK_ONE_LAUNCH
    p.ph_lo = 0; p.ph_hi = N_PHASES;
    void* args[] = {&p};
    hipError_t e = hipLaunchCooperativeKernel((const void*)mega_fwd, dim3(grid), dim3(512), args, LDS_BYTES, stream);
    if (e != hipSuccess) fprintf(stderr, "kernel_launch: cooperative launch failed: %s (grid %d)\n", hipGetErrorString(e), grid);
#else
    for (int k = 0; k < N_PHASES; ++k) { p.ph_lo = k; p.ph_hi = k + 1; hipLaunchKernelGGL(mega_fwd, dim3(grid), dim3(512), LDS_BYTES, stream, p); }
#endif
}
```

```cpp
#include <hip/hip_runtime.h>
#include <hip/hip_cooperative_groups.h>
#include <cstdio>
#include <cstdint>
namespace cg = cooperative_groups;

#define LAS __attribute__((address_space(3)))
typedef unsigned short bf16_t;
typedef short bf16x8 __attribute__((ext_vector_type(8)));
typedef short s16x4 __attribute__((ext_vector_type(4)));
typedef float f32x4 __attribute__((ext_vector_type(4)));
typedef float f32x2 __attribute__((ext_vector_type(2)));
typedef float f32x16 __attribute__((ext_vector_type(16)));
typedef unsigned u32x4 __attribute__((ext_vector_type(4)));
typedef unsigned u32x2 __attribute__((ext_vector_type(2)));

constexpr int DM = 2048, NB = 4, SEQ = 4096, CTXL = 256, NLAT = NB * SEQ, NCTXR = NB * CTXL, NROW = NLAT + NCTXR, DEPTH = 2;
constexpr int INW = 2880, INWP = 3072, QW = 1536, KVW = 2048, FF = 8192, MODW = 6 * DM, MIXW = 2048;
constexpr int U_AQ = 0, U_AKV = 512, U_AKR = 1024, U_BQ = 1088, U_BK = 1600, U_BV = 1728, U_CA = 1856, U_CG = 2368;
constexpr float EPS = 1e-6f;
constexpr float MLA_SCALE = 0.07216878364870322f;
constexpr float SWA_SCALE = 0.125f;


constexpr size_t MiB = 1u << 20;
constexpr size_t WS_MOD = 0;
constexpr size_t WS_CTL = 512 * 1024;
constexpr size_t WS_WL = 1 * MiB;
constexpr size_t WL_IN = 0, WL_UQ = 12 * MiB, WL_UKV = WL_UQ + 1536 * 1024, WL_OUT = WL_UKV + 2 * MiB, WL_W1 = WL_OUT + 8 * MiB, WL_W2 = WL_W1 + 32 * MiB, WL_SIZE = WL_W2 + 32 * MiB;
constexpr size_t WS_X = WS_WL + 2 * WL_SIZE;
constexpr size_t WS_HN = WS_X + (size_t)NROW * DM * 4;
constexpr size_t WS_U = WS_HN + (size_t)NROW * DM * 2;
constexpr size_t WS_Q = WS_U + (size_t)NROW * INWP * 2;
constexpr size_t WS_KV = WS_Q + (size_t)NROW * QW * 2;
constexpr size_t WS_MIX = WS_KV + (size_t)NROW * KVW * 2;
constexpr size_t WS_ACT = WS_U;
constexpr size_t WS_SLAB = WS_MIX + (size_t)NROW * MIXW * 2;
constexpr size_t WS_END = WS_SLAB + (size_t)8 * NCTXR * DM * 4;
static_assert(WS_ACT + (size_t)NROW * FF * 2 <= WS_SLAB, "act overlay");

__device__ const float ROPE_TAB[64 * 16 * 2] = {
1.00000000e+00f, 0.00000000e+00f, 1.00000000e+00f, 0.00000000e+00f, 1.00000000e+00f, 0.00000000e+00f, 1.00000000e+00f, 0.00000000e+00f,
1.00000000e+00f, 0.00000000e+00f, 1.00000000e+00f, 0.00000000e+00f, 1.00000000e+00f, 0.00000000e+00f, 1.00000000e+00f, 0.00000000e+00f,
1.00000000e+00f, 0.00000000e+00f, 1.00000000e+00f, 0.00000000e+00f, 1.00000000e+00f, 0.00000000e+00f, 1.00000000e+00f, 0.00000000e+00f,
1.00000000e+00f, 0.00000000e+00f, 1.00000000e+00f, 0.00000000e+00f, 1.00000000e+00f, 0.00000000e+00f, 1.00000000e+00f, 0.00000000e+00f,
5.40302306e-01f, 8.41470985e-01f, 8.46009106e-01f, 5.33168446e-01f, 9.50415281e-01f, 3.10983591e-01f, 9.84230235e-01f, 1.76892185e-01f,
9.95004165e-01f, 9.98334181e-02f, 9.98419278e-01f, 5.62044992e-02f, 9.99500042e-01f, 3.16175047e-02f, 9.99841890e-01f, 1.77818571e-02f,
9.99950000e-01f, 9.99983311e-03f, 9.99984189e-01f, 5.62338361e-03f, 9.99995000e-01f, 3.16227236e-03f, 9.99998419e-01f, 1.77827849e-03f,
9.99999500e-01f, 9.99999881e-04f, 9.99999842e-01f, 5.62341272e-04f, 9.99999950e-01f, 3.16227752e-04f, 9.99999984e-01f, 1.77827939e-04f,
-4.16146837e-01f, 9.09297427e-01f, 4.31462816e-01f, 9.02130721e-01f, 8.06578412e-01f, 5.91127114e-01f, 9.37418310e-01f, 3.48205273e-01f,
9.80066577e-01f, 1.98669334e-01f, 9.93682109e-01f, 1.12231311e-01f, 9.98000667e-01f, 6.32033945e-02f, 9.99367611e-01f, 3.55580912e-02f,
9.99800007e-01f, 1.99986662e-02f, 9.99936755e-01f, 1.12465894e-02f, 9.99980000e-01f, 6.32451310e-03f, 9.99993675e-01f, 3.55655136e-03f,
9.99998000e-01f, 1.99999876e-03f, 9.99999368e-01f, 1.12468237e-03f, 9.99999800e-01f, 6.32455472e-04f, 9.99999937e-01f, 3.55655873e-04f,
-9.89992497e-01f, 1.41120008e-01f, -1.15966163e-01f, 9.93253165e-01f, 5.82753640e-01f, 8.12648876e-01f, 8.61040659e-01f, 5.08536117e-01f,
9.55336486e-01f, 2.95520218e-01f, 9.85803469e-01f, 1.67903306e-01f, 9.95503374e-01f, 9.47260862e-02f, 9.98577312e-01f, 5.33230830e-02f,
9.99550034e-01f, 2.99954995e-02f, 9.99857701e-01f, 1.68694395e-02f, 9.99955000e-01f, 9.48669035e-03f, 9.99985770e-01f, 5.33481299e-03f,
9.99995500e-01f, 2.99999553e-03f, 9.99998577e-01f, 1.68702310e-03f, 9.99999550e-01f, 9.48683100e-04f, 9.99999858e-01f, 5.33483781e-04f,
-6.53643621e-01f, -7.56802495e-01f, -6.27679676e-01f, 7.78471723e-01f, 3.01137471e-01f, 9.53580738e-01f, 7.57506176e-01f, 6.52827997e-01f,
9.21060992e-01f, 3.89418348e-01f, 9.74808266e-01f, 2.23044491e-01f, 9.92010662e-01f, 1.26154060e-01f, 9.97471244e-01f, 7.10712093e-02f,
9.99200107e-01f, 3.99893333e-02f, 9.99747028e-01f, 2.24917562e-02f, 9.99920001e-01f, 1.26487732e-02f, 9.99974702e-01f, 7.11305774e-03f,
9.99992000e-01f, 3.99998952e-03f, 9.99997470e-01f, 2.24936331e-03f, 9.99999200e-01f, 1.26491069e-03f, 9.99999747e-01f, 7.11311701e-04f,
2.83662185e-01f, -9.58924275e-01f, -9.46079242e-01f, 3.23935282e-01f, -1.03423381e-02f, 9.99946517e-01f, 6.30080299e-01f, 7.76529984e-01f,
8.77582562e-01f, 4.79425539e-01f, 9.60731260e-01f, 2.77480534e-01f, 9.87526022e-01f, 1.57455882e-01f, 9.96049756e-01f, 8.87968616e-02f,
9.98750261e-01f, 4.99791663e-02f, 9.99604741e-01f, 2.81133616e-02f, 9.99875003e-01f, 1.58107286e-02f, 9.99960472e-01f, 8.89128000e-03f,
9.99987500e-01f, 4.99997952e-03f, 9.99996047e-01f, 2.81170292e-03f, 9.99998750e-01f, 1.58113816e-03f, 9.99999605e-01f, 8.89139598e-04f,
9.60170287e-01f, -2.79415498e-01f, -9.73103698e-01f, -2.30367517e-01f, -3.20796390e-01f, 9.47148181e-01f, 4.82782035e-01f, 8.75740548e-01f,
8.25335601e-01f, 5.64642493e-01f, 9.43616960e-01f, 3.31039323e-01f, 9.82053937e-01f, 1.88600277e-01f, 9.94313298e-01f, 1.06494442e-01f,
9.98200540e-01f, 5.99640051e-02f, 9.99430844e-01f, 3.37340781e-02f, 9.99820005e-01f, 1.89725269e-02f, 9.99943080e-01f, 1.06694741e-02f,
9.99982000e-01f, 5.99996405e-03f, 9.99994308e-01f, 3.37404141e-03f, 9.99998200e-01f, 1.89736535e-03f, 9.99999431e-01f, 1.06696741e-03f,
7.53902254e-01f, 6.56986599e-01f, -7.00429814e-01f, -7.13721287e-01f, -5.99437453e-01f, 8.00421602e-01f, 3.20257002e-01f, 9.47330699e-01f,
7.64842195e-01f, 6.44217678e-01f, 9.23519457e-01f, 3.83551578e-01f, 9.75599879e-01f, 2.19556087e-01f, 9.92262418e-01f, 1.24158339e-01f,
9.97551000e-01f, 6.99428476e-02f, 9.99225342e-01f, 3.93537258e-02f, 9.99755010e-01f, 2.21341355e-02f, 9.99922525e-01f, 1.24476345e-02f,
9.99975500e-01f, 6.99994305e-03f, 9.99992252e-01f, 3.93637883e-03f, 9.99997550e-01f, 2.21359246e-03f, 9.99999225e-01f, 1.24479530e-03f,
-1.45500034e-01f, 9.89358247e-01f, -2.12036448e-01f, -9.77261759e-01f, -8.18632447e-01f, 5.74317783e-01f, 1.47631213e-01f, 9.89042479e-01f,
6.96706701e-01f, 7.17356099e-01f, 9.00502310e-01f, 4.34851228e-01f, 9.68170306e-01f, 2.50292345e-01f, 9.89897766e-01f, 1.41782975e-01f,
9.96801706e-01f, 7.99146922e-02f, 9.98988242e-01f, 4.49721329e-02f, 9.99680017e-01f, 2.52955226e-02f, 9.99898809e-01f, 1.42257556e-02f,
9.99968000e-01f, 7.99991505e-03f, 9.99989881e-01f, 4.49871524e-03f, 9.99996800e-01f, 2.52981936e-03f, 9.99998988e-01f, 1.42262304e-03f,
-9.11130262e-01f, 4.12118485e-01f, 3.41660255e-01f, -9.39823531e-01f, -9.56644168e-01f, 2.91259224e-01f, -2.96507962e-02f, 9.99560318e-01f,
6.21609940e-01f, 7.83326932e-01f, 8.74638261e-01f, 4.84776146e-01f, 9.59772644e-01f, 2.80778331e-01f, 9.87220090e-01f, 1.59362777e-01f,
9.95952733e-01f, 8.98785453e-02f, 9.98719551e-01f, 5.05891178e-02f, 9.99595027e-01f, 2.84566569e-02f, 9.99871931e-01f, 1.60038307e-02f,
9.99959500e-01f, 8.99987904e-03f, 9.99987193e-01f, 5.06105023e-03f, 9.99995950e-01f, 2.84604600e-03f, 9.99998719e-01f, 1.60045073e-03f,
-8.39071529e-01f, -5.44021111e-01f, 7.90131866e-01f, -6.12936893e-01f, -9.99786072e-01f, -2.06835699e-02f, -2.05997633e-01f, 9.78552490e-01f,
5.40302306e-01f, 8.41470985e-01f, 8.46009106e-01f, 5.33168446e-01f, 9.50415290e-01f, 3.10983563e-01f, 9.84230235e-01f, 1.76892185e-01f,
9.95004166e-01f, 9.98334107e-02f, 9.98419278e-01f, 5.62044992e-02f, 9.99500042e-01f, 3.16175047e-02f, 9.99841890e-01f, 1.77818571e-02f,
9.99950000e-01f, 9.99983404e-03f, 9.99984189e-01f, 5.62338361e-03f, 9.99995000e-01f, 3.16227236e-03f, 9.99998419e-01f, 1.77827849e-03f,
4.42569799e-03f, -9.99990207e-01f, 9.95257399e-01f, -9.72764577e-02f, -9.43779739e-01f, -3.30574959e-01f, -3.75847400e-01f, 9.26681570e-01f,
4.53596100e-01f, 8.91207371e-01f, 8.14705342e-01f, 5.79875164e-01f, 9.40107590e-01f, 3.40877865e-01f, 9.80929147e-01f, 1.94365656e-01f,
9.93956098e-01f, 1.09778300e-01f, 9.98087432e-01f, 6.18181033e-02f, 9.99395061e-01f, 3.47780401e-02f, 9.99808688e-01f, 1.95598272e-02f,
9.99939501e-01f, 1.09997790e-02f, 9.99980868e-01f, 6.18571475e-03f, 9.99993950e-01f, 3.47849840e-03f, 9.99998087e-01f, 1.95610608e-03f,
8.43853959e-01f, -5.36572918e-01f, 8.93861614e-01f, 4.48342965e-01f, -7.94179352e-01f, -6.07683434e-01f, -5.33843014e-01f, 8.45583607e-01f,
3.62357710e-01f, 9.32039103e-01f, 7.80825933e-01f, 6.24748639e-01f, 9.28859871e-01f, 3.70431289e-01f, 9.77317868e-01f, 2.11777679e-01f,
9.92808636e-01f, 1.19712205e-01f, 9.97724024e-01f, 6.74297562e-02f, 9.99280086e-01f, 3.79382239e-02f, 9.99772325e-01f, 2.13377337e-02f,
9.99928001e-01f, 1.19997121e-02f, 9.99977232e-01f, 6.74804441e-03f, 9.99992800e-01f, 3.79472386e-03f, 9.99997723e-01f, 2.13393360e-03f,
9.07446781e-01f, 4.20167037e-01f, 5.17172845e-01f, 8.55880978e-01f, -5.65820493e-01f, -8.24528453e-01f, -6.75001666e-01f, 7.37816204e-01f,
2.67498760e-01f, 9.63558205e-01f, 7.44477987e-01f, 6.67647007e-01f, 9.16683370e-01f, 3.99614314e-01f, 9.73397544e-01f, 2.29122720e-01f,
9.91561894e-01f, 1.29634138e-01f, 9.97329065e-01f, 7.30392768e-02f, 9.99155119e-01f, 4.10980321e-02f, 9.99732799e-01f, 2.31155726e-02f,
9.99915501e-01f, 1.29996341e-02f, 9.99973279e-01f, 7.31037192e-03f, 9.99991550e-01f, 4.11094918e-03f, 9.99997328e-01f, 2.31176106e-03f,
1.36737218e-01f, 9.90607356e-01f, -1.87961516e-02f, 9.99823337e-01f, -2.81349481e-01f, -9.59605372e-01f, -7.94870905e-01f, 6.06778580e-01f,
1.69967166e-01f, 9.85449726e-01f, 7.05776374e-01f, 7.08434690e-01f, 9.03590249e-01f, 4.28397784e-01f, 9.69169414e-01f, 2.46395308e-01f,
9.90215996e-01f, 1.39543115e-01f, 9.96902569e-01f, 7.86464803e-02f, 9.99020160e-01f, 4.42574256e-02f, 9.99690113e-01f, 2.48933403e-02f,
9.99902002e-01f, 1.39995431e-02f, 9.99969010e-01f, 7.87269666e-03f, 9.99990200e-01f, 4.42717408e-03f, 9.99996901e-01f, 2.48958868e-03f,
-7.59687913e-01f, 6.50287840e-01f, -5.48975472e-01f, 8.35838460e-01f, 3.10223509e-02f, -9.99518691e-01f, -8.89670427e-01f, 4.56603254e-01f,
7.07372017e-02f, 9.97494987e-01f, 6.64843529e-01f, 7.46982651e-01f, 8.89593626e-01f, 4.56752865e-01f, 9.64634817e-01f, 2.63589966e-01f,
9.88771079e-01f, 1.49438124e-01f, 9.96444547e-01f, 8.42512043e-02f, 9.98875211e-01f, 4.74163803e-02f, 9.99644265e-01f, 2.66710293e-02f,
9.99887502e-01f, 1.49994381e-02f, 9.99964425e-01f, 8.43501985e-03f, 9.99988750e-01f, 4.74339854e-03f, 9.99996442e-01f, 2.66741598e-03f,
-9.57659480e-01f, -2.87903317e-01f, -9.10081090e-01f, 4.14430224e-01f, 3.40318168e-01f, -9.40310345e-01f, -9.56410050e-01f, 2.92027082e-01f,
-2.91995461e-02f, 9.99573602e-01f, 6.21808819e-01f, 7.83169070e-01f, 8.74707484e-01f, 4.84651232e-01f, 9.59795176e-01f, 2.80701301e-01f,
9.87227284e-01f, 1.59318203e-01f, 9.95955015e-01f, 8.98532639e-02f, 9.98720273e-01f, 5.05748570e-02f, 9.99595256e-01f, 2.84486321e-02f,
9.99872003e-01f, 1.59993181e-02f, 9.99959523e-01f, 8.99733943e-03f, 9.99987200e-01f, 5.05962253e-03f, 9.99995952e-01f, 2.84524320e-03f,
-2.75163338e-01f, -9.61397492e-01f, -9.90897960e-01f, -1.34615131e-01f, 6.15864792e-01f, -7.87851863e-01f, -9.92984984e-01f, 1.18240524e-01f,
-1.28844542e-01f, 9.91664804e-01f, 5.76808296e-01f, 8.16879544e-01f, 8.58946708e-01f, 5.12064988e-01f, 9.54652029e-01f, 2.97723872e-01f,
9.85584767e-01f, 1.69182351e-01f, 9.95433988e-01f, 9.54524822e-02f, 9.98555348e-01f, 5.37328280e-02f, 9.99543086e-01f, 3.02261450e-02f,
9.99855503e-01f, 1.69991821e-02f, 9.99954305e-01f, 9.55965617e-03f, 9.99985550e-01f, 5.37584601e-03f, 9.99995431e-01f, 3.02307034e-03f,
6.60316708e-01f, -7.50987247e-01f, -7.66536540e-01f, -6.42200695e-01f, 8.30336128e-01f, -5.57262877e-01f, -9.98241661e-01f, -5.92755186e-02f,
-2.27202164e-01f, 9.73847615e-01f, 5.29984176e-01f, 8.48007532e-01f, 8.42327058e-01f, 5.38966722e-01f, 9.49207011e-01f, 3.14652269e-01f,
9.83843694e-01f, 1.79029566e-01f, 9.94881482e-01f, 1.01048682e-01f, 9.98380437e-01f, 5.68902654e-02f, 9.99487755e-01f, 3.20035622e-02f,
9.99838004e-01f, 1.79990291e-02f, 9.99948772e-01f, 1.01219708e-02f, 9.99983800e-01f, 5.69206895e-03f, 9.99994877e-01f, 3.20089737e-03f,
9.88704618e-01f, 1.49877210e-01f, -3.06095406e-01f, -9.52000842e-01f, 9.62463796e-01f, -2.71410100e-01f, -9.72014272e-01f, -2.34921804e-01f,
-3.23289544e-01f, 9.46300095e-01f, 4.81484589e-01f, 8.76454557e-01f, 8.24865151e-01f, 5.65329535e-01f, 9.43461826e-01f, 3.31481196e-01f,
9.82004236e-01f, 1.88858893e-01f, 9.94297517e-01f, 1.06641679e-01f, 9.98195543e-01f, 6.00471302e-02f, 9.99429263e-01f, 3.37808820e-02f,
9.99819505e-01f, 1.89988581e-02f, 9.99942921e-01f, 1.06842813e-02f, 9.99981950e-01f, 6.00829132e-03f, 9.99994292e-01f, 3.37872454e-03f,
4.08082062e-01f, 9.12945251e-01f, 2.48616731e-01f, -9.68601941e-01f, 9.99144380e-01f, 4.13582902e-02f, -9.15129950e-01f, -4.03158994e-01f,
-4.16146837e-01f, 9.09297427e-01f, 4.31462816e-01f, 9.02130721e-01f, 8.06578448e-01f, 5.91127066e-01f, 9.37418310e-01f, 3.48205273e-01f,
9.80066580e-01f, 1.98669319e-01f, 9.93682109e-01f, 1.12231311e-01f, 9.98000667e-01f, 6.32033945e-02f, 9.99367611e-01f, 3.55580912e-02f,
9.99800007e-01f, 1.99986681e-02f, 9.99936755e-01f, 1.12465894e-02f, 9.99980000e-01f, 6.32451310e-03f, 9.99993675e-01f, 3.55655136e-03f,
-5.47729260e-01f, 8.36655639e-01f, 7.26760256e-01f, -6.86891207e-01f, 9.36740452e-01f, 3.50024751e-01f, -8.29382949e-01f, -5.58680521e-01f,
-5.04846228e-01f, 8.63209294e-01f, 3.80076998e-01f, 9.24954850e-01f, 7.87485197e-01f, 6.16333566e-01f, 9.31078354e-01f, 3.64819269e-01f,
9.78030916e-01f, 2.08459893e-01f, 9.93035277e-01f, 1.17817394e-01f, 9.97795810e-01f, 6.63590305e-02f, 9.99302799e-01f, 3.73351880e-02f,
9.99779508e-01f, 2.09984581e-02f, 9.99930273e-01f, 1.18088930e-02f, 9.99977950e-01f, 6.64073424e-03f, 9.99993027e-01f, 3.73437808e-03f,
-9.99960826e-01f, -8.85130929e-03f, 9.81074582e-01f, -1.93630229e-01f, 7.81440393e-01f, 6.23979898e-01f, -7.17477463e-01f, -6.96581718e-01f,
-5.88501156e-01f, 8.08496376e-01f, 3.27489589e-01f, 9.44854787e-01f, 7.67604563e-01f, 6.40923736e-01f, 9.24443984e-01f, 3.81317874e-01f,
9.75897450e-01f, 2.18229622e-01f, 9.92357044e-01f, 1.23399744e-01f, 9.97580976e-01f, 6.95140029e-02f, 9.99234826e-01f, 3.91121704e-02f,
9.99758010e-01f, 2.19982271e-02f, 9.99923474e-01f, 1.23711928e-02f, 9.99975800e-01f, 6.95695471e-03f, 9.99992347e-01f, 3.91220468e-03f,
-5.32833020e-01f, -8.46220404e-01f, 9.33235772e-01f, 3.59264517e-01f, 5.48645256e-01f, 8.36055251e-01f, -5.82943235e-01f, -8.12512883e-01f,
-6.66275986e-01f, 7.45705244e-01f, 2.73866839e-01f, 9.61767620e-01f, 7.46956388e-01f, 6.64873036e-01f, 9.17517275e-01f, 3.97695927e-01f,
9.73666397e-01f, 2.27977513e-01f, 9.91647429e-01f, 1.28978199e-01f, 9.97356166e-01f, 7.26682802e-02f, 9.99163694e-01f, 4.08890255e-02f,
9.99735512e-01f, 2.29979741e-02f, 9.99916359e-01f, 1.29334897e-02f, 9.99973550e-01f, 7.27317449e-03f, 9.99991636e-01f, 4.09003138e-03f,
4.24179007e-01f, -9.05578362e-01f, 5.97977171e-01f, 8.01513133e-01f, 2.61441688e-01f, 9.65219272e-01f, -4.30023272e-01f, -9.02817803e-01f,
-7.37393780e-01f, 6.75463110e-01f, 2.19378275e-01f, 9.75639878e-01f, 7.25561320e-01f, 6.88157519e-01f, 9.10300429e-01f, 4.13948220e-01f,
9.71337976e-01f, 2.37702621e-01f, 9.90906456e-01f, 1.34552575e-01f, 9.97121382e-01f, 7.58218234e-02f, 9.99089402e-01f, 4.26657512e-02f,
9.99712014e-01f, 2.39976963e-02f, 9.99908928e-01f, 1.34957815e-02f, 9.99971200e-01f, 7.58939308e-03f, 9.99990893e-01f, 4.26785749e-03f,
9.91202812e-01f, -1.32351750e-01f, 7.85522636e-02f, 9.96909997e-01f, -5.16893290e-02f, 9.98663213e-01f, -2.63540593e-01f, -9.64648307e-01f,
-8.01143616e-01f, 5.98472144e-01f, 1.64196159e-01f, 9.86427707e-01f, 7.03440751e-01f, 7.10753902e-01f, 9.02795741e-01f, 4.30069588e-01f,
9.68912422e-01f, 2.47403959e-01f, 9.90134147e-01f, 1.40122697e-01f, 9.96876627e-01f, 7.89746157e-02f, 9.99011951e-01f, 4.44423420e-02f,
9.99687516e-01f, 2.49973963e-02f, 9.99901180e-01f, 1.40580691e-02f, 9.99968750e-01f, 7.90561137e-03f, 9.99990118e-01f, 4.44568393e-03f,
6.46919322e-01f, 7.62558450e-01f, -4.65064496e-01f, 8.85276801e-01f, -3.59694339e-01f, 9.33070191e-01f, -8.87455026e-02f, -9.96054334e-01f,
-8.56888827e-01f, 5.15501249e-01f, 1.08494947e-01f, 9.94097001e-01f, 6.80616801e-01f, 7.32639591e-01f, 8.95005558e-01f, 4.46054986e-01f,
9.66389981e-01f, 2.57080543e-01f, 9.89330528e-01f, 1.45688387e-01f, 9.96621904e-01f, 8.21266183e-02f, 9.98931341e-01f, 4.62187923e-02f,
9.99662019e-01f, 2.59970713e-02f, 9.99893117e-01f, 1.46203532e-02f, 9.99966200e-01f, 8.22182888e-03f, 9.99989312e-01f, 4.62350977e-03f,
-2.92138809e-01f, 9.56375928e-01f, -8.65450634e-01f, 5.00994211e-01f, -6.32028631e-01f, 7.74945037e-01f, 8.88481164e-02f, -9.96045186e-01f,
-9.04072162e-01f, 4.27379837e-01f, 5.24506144e-02f, 9.98623519e-01f, 6.57112291e-01f, 7.53792702e-01f, 8.86932371e-01f, 4.61899307e-01f,
9.63770901e-01f, 2.66731418e-01f, 9.88495623e-01f, 1.51249471e-01f, 9.96357214e-01f, 8.52777923e-02f, 9.98847571e-01f, 4.79951001e-02f,
9.99635522e-01f, 2.69967203e-02f, 9.99884737e-01f, 1.51826317e-02f, 9.99963550e-01f, 8.53804556e-03f, 9.99988474e-01f, 4.80133592e-03f,
-9.62605866e-01f, 2.70905788e-01f, -9.99293409e-01f, -3.75856620e-02f, -8.41684939e-01f, 5.39968946e-01f, 2.63639511e-01f, -9.64621277e-01f,
-9.42222325e-01f, 3.34988195e-01f, -3.75941901e-03f, 9.99992933e-01f, 6.32950677e-01f, 7.74192121e-01f, 8.78578705e-01f, 4.77597592e-01f,
9.61055438e-01f, 2.76355650e-01f, 9.87629462e-01f, 1.56805757e-01f, 9.96082561e-01f, 8.84281209e-02f, 9.98760643e-01f, 4.97712524e-02f,
9.99608026e-01f, 2.79963423e-02f, 9.99876041e-01f, 1.57449054e-02f, 9.99960800e-01f, 8.85426139e-03f, 9.99987604e-01f, 4.97916193e-03f,
-7.48057530e-01f, -6.63633884e-01f, -8.25371633e-01f, -5.64589822e-01f, -9.67871508e-01f, 2.51445312e-01f, 4.30115848e-01f, -9.02773702e-01f,
-9.70958188e-01f, 2.39249237e-01f, -5.99575673e-02f, 9.98200927e-01f, 6.08156211e-01f, 7.93817374e-01f, 8.69947214e-01f, 4.93144851e-01f,
9.58243878e-01f, 2.85952217e-01f, 9.86732067e-01f, 1.62357098e-01f, 9.95797946e-01f, 9.15775651e-02f, 9.98670557e-01f, 5.15472474e-02f,
9.99579529e-01f, 2.89959364e-02f, 9.99867029e-01f, 1.63071750e-02f, 9.99957950e-01f, 9.17047633e-03f, 9.99986703e-01f, 5.15698731e-03f,
1.54251450e-01f, -9.88031624e-01f, -3.97251862e-01f, -9.17709626e-01f, -9.98075227e-01f, -6.20148391e-02f, 5.83026938e-01f, -8.12452823e-01f,
-9.89992497e-01f, 1.41120008e-01f, -1.15966163e-01f, 9.93253165e-01f, 5.82753640e-01f, 8.12648876e-01f, 8.61040659e-01f, 5.08536117e-01f,
9.55336494e-01f, 2.95520190e-01f, 9.85803469e-01f, 1.67903306e-01f, 9.95503374e-01f, 9.47260937e-02f, 9.98577312e-01f, 5.33230830e-02f,
9.99550034e-01f, 2.99955014e-02f, 9.99857701e-01f, 1.68694395e-02f, 9.99955000e-01f, 9.48669035e-03f, 9.99985770e-01f, 5.33481299e-03f,
9.14742358e-01f, -4.04037645e-01f, 1.53215476e-01f, -9.88192804e-01f, -9.29300295e-01f, -3.69325007e-01f, 7.17549222e-01f, -6.96507799e-01f,
-9.99135156e-01f, 4.15805195e-02f, -1.71608138e-01f, 9.85165289e-01f, 5.56768364e-01f, 8.30667797e-01f, 8.51861797e-01f, 5.23766626e-01f,
9.52333569e-01f, 3.05058639e-01f, 9.84843697e-01f, 1.73444204e-01f, 9.95198847e-01f, 9.78736675e-02f, 9.98480910e-01f, 5.50987464e-02f,
9.99519538e-01f, 3.09950364e-02f, 9.99848056e-01f, 1.74316968e-02f, 9.99951950e-01f, 9.80290343e-03f, 9.99984805e-01f, 5.51263804e-03f,
8.34223361e-01f, 5.51426681e-01f, 6.56495179e-01f, -7.54330219e-01f, -7.68367089e-01f, -6.40009388e-01f, 8.29440367e-01f, -5.58595272e-01f,
-9.98294773e-01f, -5.83741910e-02f, -2.26707585e-01f, 9.73962869e-01f, 5.30226367e-01f, 8.47856120e-01f, 8.42413559e-01f, 5.38831509e-01f,
9.49235420e-01f, 3.14566554e-01f, 9.83852782e-01f, 1.78979618e-01f, 9.94884368e-01f, 1.01020270e-01f, 9.98381351e-01f, 5.68742354e-02f,
9.99488044e-01f, 3.19945405e-02f, 9.99838096e-01f, 1.79939505e-02f, 9.99948800e-01f, 1.01191155e-02f, 9.99983809e-01f, 5.69046338e-03f,
-1.32767472e-02f, 9.99911860e-01f, 9.57586074e-01f, -2.88147378e-01f, -5.31235279e-01f, -8.47224338e-01f, 9.15171383e-01f, -4.03064932e-01f,
-9.87479777e-01f, -1.57745647e-01f, -2.81090307e-01f, 9.59681322e-01f, 5.03154187e-01f, 8.64196658e-01f, 8.32698933e-01f, 5.53726003e-01f,
9.46042349e-01f, 3.24043013e-01f, 9.82830754e-01f, 1.84509371e-01f, 9.94559939e-01f, 1.04165862e-01f, 9.98278634e-01f, 5.86495447e-02f,
9.99455549e-01f, 3.29940106e-02f, 9.99827819e-01f, 1.85561985e-02f, 9.99945550e-01f, 1.04353266e-02f, 9.99982781e-01f, 5.86828853e-03f,
-8.48570275e-01f, 5.29082686e-01f, 9.63757533e-01f, 2.66779718e-01f, -2.41421115e-01f, -9.70420448e-01f, 9.72038357e-01f, -2.34822129e-01f,
-9.66798168e-01f, -2.55541194e-01f, -3.34584379e-01f, 9.42365796e-01f, 4.75578896e-01f, 8.79673072e-01f, 8.22720991e-01f, 5.68445398e-01f,
9.42754664e-01f, 3.33487096e-01f, 9.81777647e-01f, 1.90033290e-01f, 9.94225566e-01f, 1.07310406e-01f, 9.98172760e-01f, 6.04246684e-02f,
9.99422056e-01f, 3.39934516e-02f, 9.99817226e-01f, 1.91184387e-02f, 9.99942201e-01f, 1.07515367e-02f, 9.99981722e-01f, 6.04611304e-03f,
-9.03692205e-01f, -4.28182669e-01f, 6.73110268e-01f, 7.39542134e-01f, 7.23346672e-02f, -9.97380417e-01f, 9.98247762e-01f, -5.91726788e-02f,
-9.36456687e-01f, -3.50783228e-01f, -3.87020682e-01f, 9.22071034e-01f, 4.47528065e-01f, 8.94269887e-01f, 8.12482924e-01f, 5.82984990e-01f,
9.39372715e-01f, 3.42897802e-01f, 9.80693494e-01f, 1.95551199e-01f, 9.93881250e-01f, 1.10453883e-01f, 9.98063730e-01f, 6.21996048e-02f,
9.99387563e-01f, 3.49928548e-02f, 9.99806317e-01f, 1.96806747e-02f, 9.99938751e-01f, 1.10677456e-02f, 9.99980631e-01f, 6.22393783e-03f,
-1.27963690e-01f, -9.91778853e-01f, 1.75156534e-01f, 9.84540598e-01f, 3.78916172e-01f, -9.25430999e-01f, 9.92972826e-01f, 1.18342584e-01f,
-8.96758353e-01f, -4.42520572e-01f, -4.38233547e-01f, 8.98861145e-01f, 4.19029744e-01f, 9.07972507e-01f, 8.01987899e-01f, 5.97340280e-01f,
9.35896829e-01f, 3.52274219e-01f, 9.79578328e-01f, 2.01062925e-01f, 9.93526995e-01f, 1.13596256e-01f, 9.97951544e-01f, 6.39743371e-02f,
9.99352070e-01f, 3.59922267e-02f, 9.99795091e-01f, 2.02429046e-02f, 9.99935201e-01f, 1.13839535e-02f, 9.99979509e-01f, 6.40176195e-03f,
7.65414052e-01f, -6.43538133e-01f, -3.76742289e-01f, 9.26318114e-01f, 6.47921689e-01f, -7.61706955e-01f, 9.56380030e-01f, 2.92125382e-01f,
-8.48100006e-01f, -5.29836181e-01f, -4.88060852e-01f, 8.72809604e-01f, 3.90112429e-01f, 9.20767231e-01f, 7.91239269e-01f, 6.11506680e-01f,
9.32327344e-01f, 3.61615436e-01f, 9.78432188e-01f, 2.06568278e-01f, 9.93162805e-01f, 1.16737493e-01f, 9.97836202e-01f, 6.57488745e-02f,
9.99315578e-01f, 3.69915589e-02f, 9.99783550e-01f, 2.08051261e-02f, 9.99931551e-01f, 1.17001602e-02f, 9.99978354e-01f, 6.57958633e-03f,
9.55073644e-01f, 2.96368579e-01f, -8.12611205e-01f, 5.82806168e-01f, 8.52673116e-01f, -5.22444789e-01f, 8.89623492e-01f, 4.56694694e-01f,
-7.90967741e-01f, -6.11857853e-01f, -5.36345181e-01f, 8.43998724e-01f, 3.60805033e-01f, 9.32641264e-01f, 7.80240434e-01f, 6.25479708e-01f,
9.28664637e-01f, 3.70920465e-01f, 9.77255105e-01f, 2.12067113e-01f, 9.92788684e-01f, 1.19877556e-01f, 9.97717704e-01f, 6.75232040e-02f,
9.99278087e-01f, 3.79908578e-02f, 9.99771692e-01f, 2.13673430e-02f, 9.99927801e-01f, 1.20163657e-02f, 9.99977168e-01f, 6.75741050e-03f,
2.66642932e-01f, 9.63795386e-01f, -9.98210360e-01f, 5.98003149e-02f, 9.72865350e-01f, -2.31372019e-01f, 7.94808390e-01f, 6.06860464e-01f,
-7.25932239e-01f, -6.87766228e-01f, -5.82933885e-01f, 8.12519591e-01f, 3.31136863e-01f, 9.43582735e-01f, 7.68994909e-01f, 6.39254902e-01f,
9.24909065e-01f, 3.80188402e-01f, 9.76047118e-01f, 2.17559242e-01f, 9.92404635e-01f, 1.23016426e-01f, 9.97596052e-01f, 6.92973125e-02f,
9.99239596e-01f, 3.89901151e-02f, 9.99759518e-01f, 2.19295531e-02f, 9.99923951e-01f, 1.23325701e-02f, 9.99975951e-01f, 6.93523400e-03f,
-6.66938062e-01f, 7.45113160e-01f, -8.76379442e-01f, -4.81621297e-01f, 9.96578984e-01f, 8.26458063e-02f, 6.74925652e-01f, 7.37885740e-01f,
-6.53643621e-01f, -7.56802495e-01f, -6.27679676e-01f, 7.78471723e-01f, 3.01137584e-01f, 9.53580702e-01f, 7.57506176e-01f, 6.52827997e-01f,
9.21061003e-01f, 3.89418320e-01f, 9.74808266e-01f, 2.23044491e-01f, 9.92010662e-01f, 1.26154060e-01f, 9.97471244e-01f, 7.10712093e-02f,
9.99200107e-01f, 3.99893370e-02f, 9.99747028e-01f, 2.24917562e-02f, 9.99920001e-01f, 1.26487732e-02f, 9.99974702e-01f, 7.11305774e-03f,
-9.87339278e-01f, -1.58622669e-01f, -4.84639397e-01f, -8.74714042e-01f, 9.21462347e-01f, 3.88467685e-01f, 5.33756100e-01f, 8.45638472e-01f,
-5.74824025e-01f, -8.18277056e-01f, -6.70441094e-01f, 7.41962761e-01f, 2.70837078e-01f, 9.62625201e-01f, 7.45777904e-01f, 6.66194655e-01f,
9.17120824e-01f, 3.98609325e-01f, 9.73538587e-01f, 2.28522688e-01f, 9.91606768e-01f, 1.29290439e-01f, 9.97343283e-01f, 7.28448814e-02f,
9.99159618e-01f, 4.09885153e-02f, 9.99734222e-01f, 2.30539504e-02f, 9.99915951e-01f, 1.29649751e-02f, 9.99973421e-01f, 7.29088079e-03f,
-3.99985315e-01f, -9.16521548e-01f, 5.63609403e-02f, -9.98410459e-01f, 7.54965347e-01f, 6.55764687e-01f, 3.75752152e-01f, 9.26720195e-01f,
-4.90260572e-01f, -8.71575913e-01f, -7.11082951e-01f, 7.03108126e-01f, 2.40265871e-01f, 9.70707119e-01f, 7.33813802e-01f, 6.79350649e-01f,
9.13088946e-01f, 4.07760441e-01f, 9.72238123e-01f, 2.33993657e-01f, 9.91192958e-01f, 1.32425525e-01f, 9.97212167e-01f, 7.46183157e-02f,
9.99118130e-01f, 4.19876562e-02f, 9.99721100e-01f, 2.36161391e-02f, 9.99911801e-01f, 1.32811756e-02f, 9.99972109e-01f, 7.46870408e-03f,
5.55113302e-01f, -8.31774743e-01f, 5.80003113e-01f, -8.14614258e-01f, 5.13598418e-01f, 8.58030690e-01f, 2.05897171e-01f, 9.78573633e-01f,
-4.00798997e-01f, -9.16166013e-01f, -7.49476759e-01f, 6.62030655e-01f, 2.09454419e-01f, 9.77818412e-01f, 7.21617654e-01f, 6.92291818e-01f,
9.08965759e-01f, 4.16870782e-01f, 9.70906914e-01f, 2.39457227e-01f, 9.90769236e-01f, 1.35559287e-01f, 9.97077898e-01f, 7.63915215e-02f,
9.99075642e-01f, 4.29867515e-02f, 9.99707662e-01f, 2.41783204e-02f, 9.99907551e-01f, 1.35973748e-02f, 9.99970765e-01f, 7.64652713e-03f,
9.99843309e-01f, 1.77019251e-02f, 9.25014669e-01f, -3.79931391e-01f, 2.21298174e-01f, 9.75206193e-01f, 2.95478207e-02f, 9.99563368e-01f,
-3.07332779e-01f, -9.51602103e-01f, -7.85501139e-01f, 6.18860211e-01f, 1.78433530e-01f, 9.83951968e-01f, 7.09193358e-01f, 7.05014029e-01f,
9.04751664e-01f, 4.25939463e-01f, 9.69545006e-01f, 2.44913210e-01f, 9.90335607e-01f, 1.38691694e-01f, 9.96940476e-01f, 7.81644856e-02f,
9.99032156e-01f, 4.39858075e-02f, 9.99693907e-01f, 2.47404922e-02f, 9.99903202e-01f, 1.39135727e-02f, 9.99969389e-01f, 7.82434947e-03f,
5.25321989e-01f, 8.50903525e-01f, 9.85138202e-01f, 1.71763569e-01f, -9.29481055e-02f, 9.95670955e-01f, -1.47732986e-01f, 9.89027282e-01f,
-2.10795799e-01f, -9.77530118e-01f, -8.19042201e-01f, 5.73733276e-01f, 1.47234222e-01f, 9.89101655e-01f, 6.96544759e-01f, 7.17513344e-01f,
9.00447108e-01f, 4.34965523e-01f, 9.68152431e-01f, 2.50361478e-01f, 9.89892074e-01f, 1.41822713e-01f, 9.96799902e-01f, 7.99371952e-02f,
9.98987671e-01f, 4.49848158e-02f, 9.99679836e-01f, 2.53026580e-02f, 9.99898752e-01f, 1.42297692e-02f, 9.99967982e-01f, 8.00217157e-03f,
-4.32177945e-01f, 9.01788348e-01f, 7.41858013e-01f, 6.70556998e-01f, -3.97976765e-01f, 9.17395495e-01f, -3.20354369e-01f, 9.47297777e-01f,
-1.12152622e-01f, -9.93690993e-01f, -8.49993909e-01f, 5.26792516e-01f, 1.15887692e-01f, 9.93262323e-01f, 6.83675900e-01f, 7.29785766e-01f,
8.96052507e-01f, 4.43948088e-01f, 9.66729248e-01f, 2.55801799e-01f, 9.89438642e-01f, 1.44952315e-01f, 9.96656175e-01f, 8.17096594e-02f,
9.98942186e-01f, 4.59837829e-02f, 9.99665450e-01f, 2.58648158e-02f, 9.99894202e-01f, 1.45459642e-02f, 9.99966543e-01f, 8.17999434e-03f,
-9.92335469e-01f, 1.23573123e-01f, 2.70098458e-01f, 9.62832708e-01f, -6.63538256e-01f, 7.48142355e-01f, -4.82871938e-01f, 8.75690979e-01f,
-1.23883774e-02f, -9.99923261e-01f, -8.78258409e-01f, 4.78186331e-01f, 8.44252840e-02f, 9.96429813e-01f, 6.70590848e-01f, 7.41827416e-01f,
8.91568289e-01f, 4.52886284e-01f, 9.65275487e-01f, 2.61234060e-01f, 9.88975318e-01f, 1.48080452e-01f, 9.96509297e-01f, 8.34818579e-02f,
9.98895703e-01f, 4.69827002e-02f, 9.99650747e-01f, 2.64269636e-02f, 9.99889552e-01f, 1.48621578e-02f, 9.99965073e-01f, 8.35781593e-03f,
-6.40144339e-01f, -7.68254661e-01f, -2.84846606e-01f, 9.58573112e-01f, -8.63296488e-01f, 5.04697111e-01f, -6.30159971e-01f, 7.76465332e-01f,
8.74991734e-02f, -9.96164592e-01f, -9.03746345e-01f, 4.28068388e-01f, 5.28784581e-02f, 9.98600956e-01f, 6.57293742e-01f, 7.53634485e-01f,
8.86994928e-01f, 4.61779166e-01f, 9.63791209e-01f, 2.66658031e-01f, 9.88502102e-01f, 1.51207123e-01f, 9.96359267e-01f, 8.52537997e-02f,
9.98848221e-01f, 4.79815705e-02f, 9.99635728e-01f, 2.69891049e-02f, 9.99884802e-01f, 1.51783490e-02f, 9.99963571e-01f, 8.53563725e-03f,
3.00592544e-01f, -9.53752653e-01f, -7.52063995e-01f, 6.59090090e-01f, -9.77442725e-01f, 2.11200659e-01f, -7.57573076e-01f, 6.52750361e-01f,
1.86512463e-01f, -9.82452595e-01f, -9.26377138e-01f, 3.76597130e-01f, 2.12787581e-02f, 9.99773582e-01f, 6.43788833e-01f, 7.65203201e-01f,
8.82332868e-01f, 4.70625870e-01f, 9.62276453e-01f, 2.72073570e-01f, 9.88019001e-01f, 1.54332282e-01f, 9.96206087e-01f, 8.70254719e-02f,
9.98799740e-01f, 4.89803966e-02f, 9.99620393e-01f, 2.75512376e-02f, 9.99879952e-01f, 1.54945396e-02f, 9.99962037e-01f, 8.71345923e-03f,
9.64966028e-01f, -2.62374854e-01f, -9.87659084e-01f, 1.56619074e-01f, -9.94656427e-01f, -1.03240463e-01f, -8.61092711e-01f, 5.08447974e-01f,
2.83662185e-01f, -9.58924275e-01f, -9.46079242e-01f, 3.23935282e-01f, -1.03422189e-02f, 9.99946518e-01f, 6.30080299e-01f, 7.76529984e-01f,
8.77582562e-01f, 4.79425539e-01f, 9.60731260e-01f, 2.77480534e-01f, 9.87526020e-01f, 1.57455897e-01f, 9.96049756e-01f, 8.87968616e-02f,
9.98750260e-01f, 4.99791700e-02f, 9.99604741e-01f, 2.81133598e-02f, 9.99875003e-01f, 1.58107286e-02f, 9.99960472e-01f, 8.89128000e-03f,
7.42154197e-01f, 6.70229176e-01f, -9.19073538e-01f, -3.94086072e-01f, -9.13230128e-01f, -4.07444148e-01f, -9.37454250e-01f, 3.48108502e-01f,
3.77977654e-01f, -9.25814718e-01f, -9.62790371e-01f, 2.70249331e-01f, -4.19528545e-02f, 9.99119591e-01f, 6.16172522e-01f, 7.87611213e-01f,
8.72744512e-01f, 4.88177239e-01f, 9.59155693e-01f, 2.82878695e-01f, 9.87023164e-01f, 1.60577938e-01f, 9.95890276e-01f, 9.05679778e-02f,
9.98699782e-01f, 5.09778971e-02f, 9.99588774e-01f, 2.86754749e-02f, 9.99869953e-01f, 1.61269170e-02f, 9.99958875e-01f, 9.06910049e-03f,
-1.62990781e-01f, 9.86627592e-01f, -5.67430029e-01f, -8.23421619e-01f, -7.41239965e-01f, -6.71240132e-01f, -9.84248472e-01f, 1.76790685e-01f,
4.68516924e-01f, -8.83454522e-01f, -9.76457693e-01f, 2.15709002e-01f, -7.35215408e-02f, 9.97293629e-01f, 6.02069899e-01f, 7.98443384e-01f,
8.67819189e-01f, 4.96880121e-01f, 9.57549788e-01f, 2.88267938e-01f, 9.86510437e-01f, 1.63698373e-01f, 9.95727646e-01f, 9.23388002e-02f,
9.98648305e-01f, 5.19765696e-02f, 9.99572491e-01f, 2.92375810e-02f, 9.99864803e-01f, 1.64431020e-02f, 9.99957246e-01f, 9.24692070e-03f,
-9.18282786e-01f, 3.95925150e-01f, -4.10281900e-02f, -9.99157989e-01f, -4.95741821e-01f, -8.68469946e-01f, -9.99999995e-01f, -1.03020676e-04f,
5.54374495e-01f, -8.32267336e-01f, -9.87037999e-01f, 1.60486722e-01f, -1.05016712e-01f, 9.94470457e-01f, 5.87776937e-01f, 8.09023036e-01f,
8.62807085e-01f, 5.05533317e-01f, 9.55913610e-01f, 2.93648038e-01f, 9.85987845e-01f, 1.66817172e-01f, 9.95561868e-01f, 9.41093381e-02f,
9.98595829e-01f, 5.29751937e-02f, 9.99555891e-01f, 2.97996760e-02f, 9.99859553e-01f, 1.67592871e-02f, 9.99955586e-01f, 9.42474155e-03f,
-8.29309833e-01f, -5.58789049e-01f, 4.98009600e-01f, -8.67171516e-01f, -2.01079620e-01f, -9.79574901e-01f, -9.84212024e-01f, -1.76993477e-01f,
6.34692950e-01f, -7.72764427e-01f, -9.94497866e-01f, 1.04756834e-01f, -1.36406875e-01f, 9.90652898e-01f, 5.73298061e-01f, 8.19346894e-01f,
8.57708701e-01f, 5.14135959e-01f, 9.54247195e-01f, 2.99018880e-01f, 9.85455396e-01f, 1.69934287e-01f, 9.95392941e-01f, 9.58795783e-02f,
9.98542354e-01f, 5.39737612e-02f, 9.99538975e-01f, 3.03617634e-02f, 9.99854204e-01f, 1.70754687e-02f, 9.99953894e-01f, 9.60256116e-03f,
2.21267563e-02f, -9.99755173e-01f, 8.83669314e-01f, -4.68111679e-01f, 1.13521777e-01f, -9.93535508e-01f, -9.37382505e-01f, -3.48301649e-01f,
7.08669774e-01f, -7.05540326e-01f, -9.98813646e-01f, 4.86959996e-02f, -1.67660642e-01f, 9.85844769e-01f, 5.58637897e-01f, 8.29411659e-01f,
8.52524516e-01f, 5.22687239e-01f, 9.52550613e-01f, 3.04380238e-01f, 9.84913090e-01f, 1.73049718e-01f, 9.95220867e-01f, 9.76495079e-02f,
9.98487881e-01f, 5.49722784e-02f, 9.99521744e-01f, 3.09238412e-02f, 9.99848754e-01f, 1.73916505e-02f, 9.99952171e-01f, 9.78038047e-03f,
8.53220108e-01f, -5.21551002e-01f, 9.97174636e-01f, 7.51182087e-02f, 4.16867074e-01f, -9.08967459e-01f, -8.60988417e-01f, -5.08624563e-01f,
7.75565818e-01f, -6.31266712e-01f, -9.99971734e-01f, -7.51878489e-03f, -1.98746880e-01f, 9.80050855e-01f, 5.43801080e-01f, 8.39214147e-01f,
8.47255110e-01f, 5.31186200e-01f, 9.50823909e-01f, 3.09731970e-01f, 9.84360935e-01f, 1.76163418e-01f, 9.95045645e-01f, 9.94191362e-02f,
9.98432410e-01f, 5.59707370e-02f, 9.99504196e-01f, 3.14859073e-02f, 9.99843204e-01f, 1.77078286e-02f, 9.99950416e-01f, 9.95820041e-03f,
8.99866827e-01f, 4.36164755e-01f, 8.03569087e-01f, 5.95211494e-01f, 6.78870211e-01f, -7.34258290e-01f, -7.57439190e-01f, -6.52905716e-01f,
8.34712942e-01f, -5.50685304e-01f, -9.97968467e-01f, -6.37097991e-02f, -2.29634270e-01f, 9.73276991e-01f, 5.28792303e-01f, 8.48751259e-01f,
8.41900979e-01f, 5.39632043e-01f, 9.49067129e-01f, 3.15073936e-01f, 9.83798936e-01f, 1.79275357e-01f, 9.94867276e-01f, 1.01188450e-01f,
9.98375940e-01f, 5.69691433e-02f, 9.99486332e-01f, 3.20479672e-02f, 9.99837554e-01f, 1.80240068e-02f, 9.99948629e-01f, 1.01360191e-02f,
1.19180135e-01f, 9.92872648e-01f, 3.62476666e-01f, 9.31992847e-01f, 8.73550510e-01f, -4.86733506e-01f, -6.30000714e-01f, -7.76594554e-01f,
8.85519606e-01f, -4.64602011e-01f, -9.92810180e-01f, -1.19699398e-01f, -2.60292045e-01f, 9.65529933e-01f, 5.13616311e-01f, 8.58019979e-01f,
8.36462659e-01f, 5.48023923e-01f, 9.47280345e-01f, 3.20405911e-01f, 9.83227099e-01f, 1.82385503e-01f, 9.94685763e-01f, 1.02957436e-01f,
9.98318471e-01f, 5.79674889e-02f, 9.99468152e-01f, 3.26100133e-02f, 9.99831805e-01f, 1.83401814e-02f, 9.99946811e-01f, 1.03138375e-02f,
-7.71080223e-01f, 6.36738007e-01f, -1.90249096e-01f, 9.81735851e-01f, 9.81602098e-01f, -1.90938005e-01f, -4.82692335e-01f, -8.75789992e-01f,
9.27478466e-01f, -3.73876576e-01f, -9.84513180e-01f, -1.75310575e-01f, -2.90689550e-01f, 9.56817425e-01f, 4.98277903e-01f, 8.67017376e-01f,
8.30940694e-01f, 5.56361001e-01f, 9.45463597e-01f, 3.25727781e-01f, 9.82645430e-01f, 1.85493825e-01f, 9.94501103e-01f, 1.04726105e-01f,
9.98260005e-01f, 5.89657802e-02f, 9.99449656e-01f, 3.31720491e-02f, 9.99825955e-01f, 1.86563560e-02f, 9.99944961e-01f, 1.04916564e-02f,
-9.52412980e-01f, -3.04810621e-01f, -6.84381916e-01f, 7.29123716e-01f, 9.92308319e-01f, 1.23790949e-01f, -3.20159180e-01f, -9.47363763e-01f,
9.60170287e-01f, -2.79415498e-01f, -9.73103698e-01f, -2.30367517e-01f, -3.20796390e-01f, 9.47148181e-01f, 4.82782035e-01f, 8.75740548e-01f,
8.25335635e-01f, 5.64642444e-01f, 9.43616960e-01f, 3.31039323e-01f, 9.82053934e-01f, 1.88600292e-01f, 9.94313298e-01f, 1.06494442e-01f,
9.98200540e-01f, 5.99640089e-02f, 9.99430844e-01f, 3.37340781e-02f, 9.99820005e-01f, 1.89725269e-02f, 9.99943080e-01f, 1.06694741e-02f,
-2.58101636e-01f, -9.66117770e-01f, -9.67739662e-01f, 2.51952269e-01f, 9.04607566e-01f, 4.26245412e-01f, -1.47529203e-01f, -9.89057700e-01f,
9.83268421e-01f, -1.82162598e-01f, -9.58617804e-01f, -2.84696165e-01f, -3.50582460e-01f, 9.36531867e-01f, 4.67133397e-01f, 8.84186852e-01f,
8.19648010e-01f, 5.72867472e-01f, 9.41740473e-01f, 3.36340425e-01f, 9.81452621e-01f, 1.91704858e-01f, 9.94122349e-01f, 1.08262435e-01f,
9.98140077e-01f, 6.09621813e-02f, 9.99411716e-01f, 3.42960927e-02f, 9.99813956e-01f, 1.92886978e-02f, 9.99941166e-01f, 1.08472915e-02f,
6.73507162e-01f, -7.39180697e-01f, -9.53050036e-01f, -3.02812861e-01f, 7.27198078e-01f, 6.86427677e-01f, 2.97537714e-02f, -9.99557259e-01f,
9.96542121e-01f, -8.30891177e-02f, -9.41101294e-01f, -3.38124763e-01f, -3.80017977e-01f, 9.24979101e-01f, 4.51337043e-01f, 8.92353559e-01f,
8.13878454e-01f, 5.81035164e-01f, 9.39834216e-01f, 3.41630863e-01f, 9.80841490e-01f, 1.94807522e-01f, 9.93928256e-01f, 1.10030093e-01f,
9.98078615e-01f, 6.19602890e-02f, 9.99392272e-01f, 3.48580964e-02f, 9.99807806e-01f, 1.96048648e-02f, 9.99939222e-01f, 1.10251085e-02f,
9.85896582e-01f, 1.67355700e-01f, -6.44837016e-01f, -7.64320105e-01f, 4.77671453e-01f, 8.78538550e-01f, 2.06098327e-01f, -9.78531287e-01f,
9.99858633e-01f, 1.68140912e-02f, -9.20609545e-01f, -3.90484398e-01f, -4.09073509e-01f, 9.12501433e-01f, 4.35397967e-01f, 9.00238085e-01f,
8.08027511e-01f, 5.89144754e-01f, 9.37898229e-01f, 3.46910525e-01f, 9.80220551e-01f, 1.97908238e-01f, 9.93731021e-01f, 1.11797395e-01f,
9.98016156e-01f, 6.29583348e-02f, 9.99372512e-01f, 3.54200929e-02f, 9.99801557e-01f, 1.99210318e-02f, 9.99937245e-01f, 1.12029262e-02f,
};

__device__ __forceinline__ unsigned cvt_pk_bf16(float lo, float hi) { unsigned r; asm volatile("v_cvt_pk_bf16_f32 %0, %1, %2" : "=v"(r) : "v"(lo), "v"(hi)); return r; }
__device__ __forceinline__ float bf2f(unsigned short b) { return __uint_as_float((unsigned)b << 16); }
__device__ __forceinline__ float bflo(unsigned w) { return __uint_as_float(w << 16); }
__device__ __forceinline__ float bfhi(unsigned w) { return __uint_as_float(w & 0xffff0000u); }
__device__ __forceinline__ unsigned short f2bf(float f) { unsigned u = __float_as_uint(f); return (unsigned short)((u + 0x7fffu + ((u >> 16) & 1u)) >> 16); }
__device__ __forceinline__ float wave_sum(float v, const int lane) {
#pragma unroll
    for (int o = 1; o < 64; o <<= 1) v += __int_as_float(__builtin_amdgcn_ds_bpermute((lane ^ o) << 2, __float_as_int(v)));
    return v;
}
template <int N> __device__ __forceinline__ void wave_sum_n(float (&s)[N], const int lane) {
#pragma unroll
    for (int o = 1; o < 64; o <<= 1) { float t[N]; const int idx = (lane ^ o) << 2;
#pragma unroll
        for (int q = 0; q < N; ++q) t[q] = __int_as_float(__builtin_amdgcn_ds_bpermute(idx, __float_as_int(s[q])));
#pragma unroll
        for (int q = 0; q < N; ++q) s[q] += t[q]; }
}
__device__ __forceinline__ int lane_id_() { return (int)__builtin_amdgcn_mbcnt_hi(~0u, __builtin_amdgcn_mbcnt_lo(~0u, 0u)); }
__device__ __forceinline__ int tid_from_(int wave_s) { int l; int w = wave_s; asm volatile("v_mbcnt_lo_u32_b32 %0, -1, 0\n\tv_mbcnt_hi_u32_b32 %0, -1, %0" : "=v"(l), "+s"(w)); return w * 64 + l; }
__device__ __forceinline__ float sigmoidf_(float x) { return __builtin_amdgcn_rcpf(1.0f + __expf(-x)); }

namespace pg8 {
constexpr int BM = 256, BK = 64, HALF = 128, HTB = HALF * BK * 2, STAGE_BYTES = 8 * HTB, NXCD = 8, WGM = 8;
__host__ __device__ __forceinline__ int lds_byte(int r, int c) { const int st = (r >> 4) * 2 + (c >> 5), rr = r & 15, cc = c & 31, ob = rr * 64 + cc * 2; return st * 1024 + (ob ^ (((ob >> 9) & 1) << 5)); }
__host__ __device__ __forceinline__ void stage_rc(int b, int& R, int& C) { const int st = b / 1024, sb = b % 1024, swz = sb ^ (((sb >> 9) & 1) << 5); R = (st >> 1) * 16 + swz / 64; C = (st & 1) * 32 + (swz % 64) / 2; }
__host__ __device__ __forceinline__ int perm32(int rho) { const int n = rho >> 4, i = rho & 15; return 8 * (i >> 2) + 4 * n + (i & 3); }

struct Unit { int pm, pn, k0, nt, split; };
struct Gemm { const bf16_t* A; const bf16_t* Bt; int M, N, K, lda; };

struct StaticOrder {
    int nM, nN, nwg, G, c, ntk;
    __host__ __device__ __forceinline__ void init(int M, int N, int G_, int c_, int K) { nM = M / BM; nN = N / BM; nwg = nM * nN; G = G_; c = c_; ntk = K / BK; }
    __host__ __device__ __forceinline__ bool next(int i, Unit& u) const {
        const int L = i * G + c; const bool ok = L < nwg;
        int wgid = ok ? L : 0; { const int q = nwg / NXCD, r = nwg % NXCD, xcd = wgid % NXCD, off = wgid / NXCD; wgid = (xcd < r ? xcd * (q + 1) : r * (q + 1) + (xcd - r) * q) + off; }
        const int nig = WGM * nN, gid = wgid / nig, fm = gid * WGM, gsz = (nM - fm) < WGM ? (nM - fm) : WGM;
        u.pm = fm + ((wgid % nig) % gsz); u.pn = (wgid % nig) / gsz; u.k0 = 0; u.nt = ntk; u.split = 0; return ok;
    }
    __device__ __forceinline__ void a_ready(const Unit&) const {}
    __device__ __forceinline__ void done(const Unit&) const {}
};

struct CtxSplitOrder {
    StaticOrder lat; int with_ctx, nl;
    __host__ __device__ __forceinline__ void init(int N, int G_, int c_, int K, int with_ctx_) { lat.init(NLAT, N, G_, c_, K); with_ctx = with_ctx_; nl = (lat.nwg - c_ + G_ - 1) / G_; if (nl < 0) nl = 0; }
    __host__ __device__ __forceinline__ bool next(int i, Unit& u) const {
        Unit a; const bool va = lat.next(i, a);
        const int nctx = (NCTXR / BM) * lat.nN; constexpr int S = 8;
        const bool use_lat = i < nl;
        const int sub = (use_lat ? 0 : (i - nl) * lat.G) + lat.c;
        const bool vc = with_ctx && !use_lat && sub < nctx * S;
        const int uu = sub / S, sl = sub % S, cnt = lat.ntk / S;
        u.pm = use_lat ? a.pm : NLAT / BM + (uu / lat.nN) % (NCTXR / BM); u.pn = use_lat ? a.pn : uu % lat.nN; u.nt = use_lat ? a.nt : cnt; u.k0 = use_lat ? 0 : sl * cnt * BK; u.split = use_lat ? 0 : 1 + sl;
        return use_lat ? va : vc;
    }
    __device__ __forceinline__ void a_ready(const Unit&) const {}
    __device__ __forceinline__ void done(const Unit&) const {}
};

template <int ACT  > struct EpiBf16 {
    static constexpr bool PERM = true, AFTER_DRAIN = false;
    bf16_t* O; int ldc;
    __device__ __forceinline__ void operator()(const f32x4 (&acc)[2][2][4][2], const Unit& u, int wr, int wc, int fr, int fq) const {
        const int row0 = u.pm * BM + wr * 64 + fr; const int col0 = u.pn * BM + wc * 32 + 8 * fq;
#pragma unroll
        for (int ai = 0; ai < 2; ++ai)
#pragma unroll
            for (int m = 0; m < 4; ++m) { bf16_t* rowp = O + (size_t)(row0 + ai * HALF + m * 16) * ldc + col0;
#pragma unroll
                for (int bj = 0; bj < 2; ++bj) { f32x4 v0 = acc[ai][bj][m][0], v1 = acc[ai][bj][m][1];
                    if (ACT == 2) {
#pragma unroll
                        for (int e = 0; e < 4; ++e) { float a = v0[e] > 0.f ? v0[e] : 0.f; v0[e] = a * a; float b = v1[e] > 0.f ? v1[e] : 0.f; v1[e] = b * b; } }
                    u32x4 w; w.x = cvt_pk_bf16(v0[0], v0[1]); w.y = cvt_pk_bf16(v0[2], v0[3]); w.z = cvt_pk_bf16(v1[0], v1[1]); w.w = cvt_pk_bf16(v1[2], v1[3]);
                    *(u32x4*)(rowp + bj * HALF) = w; } }
    }
};
struct EpiResid {
    static constexpr bool PERM = false, AFTER_DRAIN = false;
    const float* res_lat; const float* res_ctx; float* out; const float* gate; float* slab;
    __device__ __forceinline__ void operator()(const f32x4 (&acc)[2][2][4][2], const Unit& u, int wr, int wc, int fr, int fq) const {
        const int col0 = u.pn * BM + wc * 32 + 4 * fq;
        const bool lat = u.pm < (NLAT / BM);
        const int mrow = lat ? (u.pm >> 4) : 4;
        const float* resb = lat ? res_lat + (size_t)u.pm * BM * DM : res_ctx + (size_t)(u.pm - NLAT / BM) * BM * DM;
        float* outb = out + (size_t)u.pm * BM * DM;
        const float* gp = gate + (size_t)mrow * MODW + col0;
        if (u.split) {
            float* sb = slab + ((size_t)(u.split - 1) * NCTXR + (size_t)(u.pm - NLAT / BM) * BM) * DM + col0;
#pragma unroll
            for (int ai = 0; ai < 2; ++ai)
#pragma unroll
                for (int m = 0; m < 4; ++m) { float* op = sb + (size_t)(ai * HALF + wr * 64 + m * 16 + fr) * DM;
#pragma unroll
                    for (int bj = 0; bj < 2; ++bj)
#pragma unroll
                        for (int n = 0; n < 2; ++n) *(f32x4*)(op + bj * HALF + n * 16) = acc[ai][bj][m][n]; }
            return;
        }
        f32x4 gv[2][2];
#pragma unroll
        for (int bj = 0; bj < 2; ++bj)
#pragma unroll
            for (int n = 0; n < 2; ++n) gv[bj][n] = *(const f32x4*)(gp + bj * HALF + n * 16);
#pragma unroll
        for (int ai = 0; ai < 2; ++ai) {
            f32x4 bs[4][2][2];
#pragma unroll
            for (int m = 0; m < 4; ++m) { const size_t off = (size_t)(ai * HALF + wr * 64 + m * 16 + fr) * DM + col0;
#pragma unroll
                for (int bj = 0; bj < 2; ++bj)
#pragma unroll
                    for (int n = 0; n < 2; ++n) bs[m][bj][n] = *(const f32x4*)(resb + off + bj * HALF + n * 16); }
#pragma unroll
            for (int m = 0; m < 4; ++m) { const size_t off = (size_t)(ai * HALF + wr * 64 + m * 16 + fr) * DM + col0;
#pragma unroll
                for (int bj = 0; bj < 2; ++bj)
#pragma unroll
                    for (int n = 0; n < 2; ++n) *(f32x4*)(outb + off + bj * HALF + n * 16) = bs[m][bj][n] + gv[bj][n] * acc[ai][bj][m][n]; }
            asm volatile("" ::: "memory");
        }
    }
};

template <class Epi, class Sched, bool ALIGN_EPI = false, bool SP2 = false>
__device__ __forceinline__ void gemm_phase(LAS unsigned char* lds, const Gemm g, const Sched& S, const Epi& E, const int wave_s) {
    const int tid_ = tid_from_(wave_s);
    const int tid = tid_, wid = __builtin_amdgcn_readfirstlane(tid >> 6), lane = tid & 63, wr = wid >> 2, wc = wid & 3, fr = lane & 15, fq = lane >> 4;
    const int K = g.K, lda = g.lda;
    unsigned voffA[2], voffB[2];
#pragma unroll
    for (int i = 0; i < 2; ++i) { int R, C; stage_rc(tid * 16 + i * 8192, R, C); const int Rb = Epi::PERM ? ((R & ~31) + perm32(R & 31)) : R;
        voffA[i] = (unsigned)(R * lda + C) * 2u; voffB[i] = (unsigned)(Rb * K + C) * 2u; }
    const size_t kstep = (size_t)(BK * 2);
    const size_t hstepA = (size_t)HALF * lda * 2, hstepB = (size_t)HALF * K * 2;
    const size_t tstepA = 2 * hstepA, tstepB = 2 * hstepB;
    const unsigned ldsw = (unsigned)wid * 1024u;
    const int aoff = lds_byte(wr * 64 + fr, fq * 8), boff = lds_byte(wc * 32 + fr, fq * 8);
#define PG8_SA(b, h) (((b) * 2 + (h)) * HTB)
#define PG8_SB(b, h) ((4 + (b) * 2 + (h)) * HTB)
#define PG8_STAGE(bufoff, gbase, voff) do { _Pragma("unroll") for (int _i = 0; _i < 2; ++_i) \
        __builtin_amdgcn_global_load_lds((const unsigned*)((const char*)(gbase) + (voff)[_i]), (LAS unsigned*)(lds + (bufoff) + ldsw + _i * 8192), 16, 0, 0); } while (0)
#define PG8_LDA(dst, b, h) do { _Pragma("unroll") for (int m = 0; m < 4; ++m) _Pragma("unroll") for (int k = 0; k < 2; ++k) dst[m][k] = *(const LAS bf16x8*)(lds + PG8_SA(b, h) + aoff + m * 2048 + k * 1024); } while (0)
#define PG8_LDB(dst, b, h) do { _Pragma("unroll") for (int n = 0; n < 2; ++n) _Pragma("unroll") for (int k = 0; k < 2; ++k) dst[n][k] = *(const LAS bf16x8*)(lds + PG8_SB(b, h) + boff + n * 2048 + k * 1024); } while (0)
#define PG8_MMA(ai, bj, At, Bt) do { __builtin_amdgcn_s_setprio(1); _Pragma("unroll") for (int m = 0; m < 4; ++m) _Pragma("unroll") for (int n = 0; n < 2; ++n) _Pragma("unroll") for (int k = 0; k < 2; ++k) \
        acc[ai][bj][m][n] = __builtin_amdgcn_mfma_f32_16x16x32_bf16(Bt[n][k], At[m][k], acc[ai][bj][m][n], 0, 0, 0); __builtin_amdgcn_s_setprio(0); } while (0)
#define PG8_WAIT_V(n) asm volatile("s_waitcnt vmcnt(" #n ")" ::: "memory")
#define PG8_WAIT_L(n) asm volatile("s_waitcnt lgkmcnt(" #n ")" ::: "memory")
#define PG8_BAR __builtin_amdgcn_s_barrier()
#define PG8_SCHED __builtin_amdgcn_sched_barrier(0)
    Unit cur, nxt; int ui = 0;
    if (!S.next(0, cur)) return;
    f32x4 acc[2][2][4][2];
#pragma unroll
    for (int a = 0; a < 2; ++a)
#pragma unroll
        for (int b = 0; b < 2; ++b)
#pragma unroll
            for (int m = 0; m < 4; ++m)
#pragma unroll
                for (int n = 0; n < 2; ++n) acc[a][b][m][n] = (f32x4){0.f, 0.f, 0.f, 0.f};
    bf16x8 At[4][2], B0[2][2], B1[2][2];
    const char* cA = (const char*)g.A + (size_t)cur.pm * tstepA + (size_t)cur.k0 * 2; const char* cB = (const char*)g.Bt + (size_t)cur.pn * tstepB + (size_t)cur.k0 * 2;
    S.a_ready(cur);
    if constexpr (SP2) {
        PG8_STAGE(PG8_SB(0, 0), cB, voffB); PG8_STAGE(PG8_SB(0, 1), cB + hstepB, voffB); PG8_STAGE(PG8_SA(0, 0), cA, voffA); PG8_STAGE(PG8_SA(0, 1), cA + hstepA, voffA);
        if (wr == 1) PG8_BAR;
        PG8_WAIT_V(2); PG8_BAR;
        PG8_STAGE(PG8_SB(1, 0), cB + kstep, voffB); PG8_STAGE(PG8_SA(1, 0), cA + kstep, voffA); PG8_STAGE(PG8_SB(1, 1), cB + hstepB + kstep, voffB);
        PG8_WAIT_V(6); PG8_BAR;
    } else {
        PG8_STAGE(PG8_SB(0, 0), cB, voffB); PG8_STAGE(PG8_SA(0, 0), cA, voffA); PG8_STAGE(PG8_SB(0, 1), cB + hstepB, voffB); PG8_STAGE(PG8_SA(0, 1), cA + hstepA, voffA);
        if (wr == 1) PG8_BAR;
        PG8_WAIT_V(4); PG8_BAR;
        PG8_STAGE(PG8_SB(1, 0), cB + kstep, voffB); PG8_STAGE(PG8_SA(1, 0), cA + kstep, voffA); PG8_STAGE(PG8_SB(1, 1), cB + hstepB + kstep, voffB);
        PG8_WAIT_V(6); PG8_BAR;
    }
    for (;;) {
        const bool has_next = S.next(ui + 1, nxt);
        const char* nA = has_next ? (const char*)g.A + (size_t)nxt.pm * tstepA + (size_t)nxt.k0 * 2 : cA; const char* nB = has_next ? (const char*)g.Bt + (size_t)nxt.pn * tstepB + (size_t)nxt.k0 * 2 : cB;
        const int nt = cur.nt;
        for (int t = 0; t < nt; t += 2) {
            const bool last = (t == nt - 2);
            const char* a1 = cA + (size_t)(t + 1) * kstep;
            const char* a2 = last ? nA : cA + (size_t)(t + 2) * kstep; const char* b2 = last ? nB : cB + (size_t)(t + 2) * kstep;
            const char* a3 = a2 + kstep; const char* b3 = b2 + kstep;
            if (last && has_next) S.a_ready(nxt);
            if constexpr (SP2) {
            PG8_LDB(B0, 0, 0); PG8_LDB(B1, 0, 1); PG8_SCHED; PG8_LDA(At, 0, 0); PG8_STAGE(PG8_SA(1, 1), a1 + hstepA, voffA);
            PG8_WAIT_V(8); PG8_WAIT_L(0); PG8_BAR; PG8_MMA(0, 0, At, B0); PG8_MMA(0, 1, At, B1); PG8_BAR; PG8_SCHED;
            PG8_LDA(At, 0, 1); PG8_STAGE(PG8_SB(0, 0), b2, voffB); PG8_STAGE(PG8_SB(0, 1), b2 + hstepB, voffB); PG8_STAGE(PG8_SA(0, 0), a2, voffA);
            PG8_WAIT_V(8); PG8_WAIT_L(0); PG8_BAR; PG8_MMA(1, 0, At, B0); PG8_MMA(1, 1, At, B1); PG8_BAR; PG8_SCHED;
            PG8_LDB(B0, 1, 0); PG8_LDB(B1, 1, 1); PG8_SCHED; PG8_LDA(At, 1, 0); PG8_STAGE(PG8_SA(0, 1), a2 + hstepA, voffA);
            PG8_WAIT_V(8); PG8_WAIT_L(0); PG8_BAR; PG8_MMA(0, 0, At, B0); PG8_MMA(0, 1, At, B1); PG8_BAR; PG8_SCHED;
            PG8_LDA(At, 1, 1); PG8_STAGE(PG8_SB(1, 0), b3, voffB); PG8_STAGE(PG8_SB(1, 1), b3 + hstepB, voffB); PG8_STAGE(PG8_SA(1, 0), a3, voffA);
            PG8_WAIT_V(8); PG8_WAIT_L(0); PG8_BAR; PG8_MMA(1, 0, At, B0); PG8_MMA(1, 1, At, B1); PG8_BAR; PG8_SCHED;
            } else {
            PG8_LDB(B0, 0, 0); PG8_SCHED; PG8_LDA(At, 0, 0); PG8_STAGE(PG8_SA(1, 1), a1 + hstepA, voffA);
            PG8_WAIT_L(8); PG8_BAR; PG8_WAIT_L(0); PG8_MMA(0, 0, At, B0); PG8_BAR; PG8_SCHED;
            PG8_LDB(B1, 0, 1); PG8_STAGE(PG8_SB(0, 0), b2, voffB);
            PG8_BAR; PG8_WAIT_L(0); PG8_MMA(0, 1, At, B1); PG8_BAR;
            PG8_LDA(At, 0, 1); PG8_STAGE(PG8_SA(0, 0), a2, voffA);
            PG8_BAR; PG8_WAIT_L(0); PG8_MMA(1, 0, At, B0); PG8_BAR; PG8_SCHED;
            PG8_STAGE(PG8_SB(0, 1), b2 + hstepB, voffB);
            PG8_WAIT_V(6); PG8_BAR; PG8_MMA(1, 1, At, B1); PG8_BAR;
            PG8_LDB(B0, 1, 0); PG8_SCHED; PG8_LDA(At, 1, 0); PG8_STAGE(PG8_SA(0, 1), a2 + hstepA, voffA);
            PG8_WAIT_L(8); PG8_BAR; PG8_WAIT_L(0); PG8_MMA(0, 0, At, B0); PG8_BAR; PG8_SCHED;
            PG8_LDB(B1, 1, 1); PG8_STAGE(PG8_SB(1, 0), b3, voffB);
            PG8_BAR; PG8_WAIT_L(0); PG8_MMA(0, 1, At, B1); PG8_BAR;
            PG8_LDA(At, 1, 1); PG8_STAGE(PG8_SA(1, 0), a3, voffA);
            PG8_BAR; PG8_WAIT_L(0); PG8_MMA(1, 0, At, B0); PG8_BAR; PG8_SCHED;
            PG8_STAGE(PG8_SB(1, 1), b3 + hstepB, voffB);
            PG8_WAIT_V(6); PG8_BAR; PG8_MMA(1, 1, At, B1); PG8_BAR;
            }
        }
        if constexpr (ALIGN_EPI) { if (wr == 0) PG8_BAR; }
        if constexpr (!Epi::AFTER_DRAIN) { E(acc, cur, wr, wc, fr, fq); S.done(cur); }
        if (!has_next) break;
#pragma unroll
        for (int a = 0; a < 2; ++a)
#pragma unroll
            for (int b = 0; b < 2; ++b)
#pragma unroll
                for (int m = 0; m < 4; ++m)
#pragma unroll
                    for (int n = 0; n < 2; ++n) acc[a][b][m][n] = (f32x4){0.f, 0.f, 0.f, 0.f};
        cur = nxt; cA = nA; cB = nB; ++ui;
        if constexpr (ALIGN_EPI) { if (wr == 1) PG8_BAR; }
    }
    PG8_WAIT_V(0);
    if constexpr (!ALIGN_EPI) { if (wr == 0) PG8_BAR; }
    PG8_BAR;
#undef PG8_SA
#undef PG8_SB
#undef PG8_STAGE
#undef PG8_LDA
#undef PG8_LDB
#undef PG8_MMA
#undef PG8_WAIT_V
#undef PG8_WAIT_L
#undef PG8_BAR
#undef PG8_SCHED
}
}

namespace att {
constexpr int NW = 8, QBLK = 32, KVBLK = 64;
constexpr float THR = 8.f;
#define SBAR() __builtin_amdgcn_sched_barrier(0)
__device__ __forceinline__ int crow(int r, int hi) { return (r & 3) + 8 * (r >> 2) + 4 * hi; }
__device__ __forceinline__ unsigned cvtpk(float lo, float hi) { unsigned r; asm volatile("v_cvt_pk_bf16_f32 %0, %1, %2" : "=v"(r) : "v"(lo), "v"(hi)); return r; }

struct UnitP {
    const bf16_t* Q; int ldq;
    const bf16_t* Kn; int ldkn;
    const bf16_t* Kp; int ldkp;
    const bf16_t* V; int ldv;
    bf16_t* O; int ldo;
    int base0, n0, base1, NT;
    int masked;
    int kpos1, qpos0;
    int rope;
    int has_sink; float sink;
};

__device__ __forceinline__ void partialSM(f32x16& p0, f32x16& p1, float& m_reg, float& mn, float& alpha, const float C, const float THRS) {
  float pmax = p0[0];
#pragma unroll
  for (int r = 1; r < 16; ++r) pmax = fmaxf(pmax, p0[r]);
#pragma unroll
  for (int r = 0; r < 16; ++r) pmax = fmaxf(pmax, p1[r]);
  { auto rr = __builtin_amdgcn_permlane32_swap(__float_as_uint(pmax), __float_as_uint(pmax), false, false);
    pmax = fmaxf(__uint_as_float(rr[0]), __uint_as_float(rr[1])); }
  if (__builtin_expect(__all(pmax - m_reg <= THRS), 1)) { mn = m_reg; alpha = 1.f; }
  else { mn = fmaxf(m_reg, pmax); alpha = __builtin_amdgcn_exp2f((m_reg - mn) * C); m_reg = mn; }
  float mnC = -mn * C;
#pragma unroll
  for (int r = 0; r < 16; ++r) p0[r] = fmaf(p0[r], C, mnC);
#pragma unroll
  for (int r = 0; r < 16; ++r) p1[r] = fmaf(p1[r], C, mnC);
#pragma unroll
  for (int r = 0; r < 16; ++r) p0[r] = __builtin_amdgcn_exp2f(p0[r]);
}
__device__ __forceinline__ void finishSM(f32x16& p0, f32x16& p1, float alpha, float& l_reg, bf16x8& pa0, bf16x8& pa1, bf16x8& pa2, bf16x8& pa3) {
#pragma unroll
  for (int r = 0; r < 16; ++r) p1[r] = __builtin_amdgcn_exp2f(p1[r]);
  float ps = 0;
#pragma unroll
  for (int r = 0; r < 16; ++r) ps += p0[r];
#pragma unroll
  for (int r = 0; r < 16; ++r) ps += p1[r];
  { auto rr = __builtin_amdgcn_permlane32_swap(__float_as_uint(ps), __float_as_uint(ps), false, false);
    ps = __uint_as_float(rr[0]) + __uint_as_float(rr[1]); }
  l_reg = l_reg * alpha + ps;
#define PK4(P, BASE, OUT) do { unsigned a0 = cvtpk(P[BASE + 0], P[BASE + 1]), a1 = cvtpk(P[BASE + 2], P[BASE + 3]);   \
    unsigned b0 = cvtpk(P[BASE + 4], P[BASE + 5]), b1 = cvtpk(P[BASE + 6], P[BASE + 7]);                              \
    auto r0 = __builtin_amdgcn_permlane32_swap(a0, b0, false, false); auto r1 = __builtin_amdgcn_permlane32_swap(a1, b1, false, false); \
    u32x4 w = {r0[0], r1[0], r0[1], r1[1]}; OUT = *reinterpret_cast<bf16x8*>(&w); } while (0)
  PK4(p0, 0, pa0); PK4(p0, 8, pa1); PK4(p1, 0, pa2); PK4(p1, 8, pa3);
#undef PK4
}
template <int NQK, int NKN>
__device__ __forceinline__ void qkt(f32x16& p0, f32x16& p1, const char* Kn, const char* Kp, const bf16x8* qr, int r32, int hi) {
  p0 = f32x16{}; p1 = f32x16{};
  const int swz = (r32 & 7) << 4;
#define KFRAG(d0, B0, B1) do { if ((d0) < 8 * NKN) { const int cb = ((d0) * 16 + hi * 8) * 2; \
      B0 = *reinterpret_cast<const bf16x8*>(Kn + r32 * 256 + (cb ^ swz)); B1 = *reinterpret_cast<const bf16x8*>(Kn + (32 + r32) * 256 + (cb ^ swz)); } \
    else { const int cb = (((d0) - 8 * NKN) * 16 + hi * 8) * 2; \
      B0 = *reinterpret_cast<const bf16x8*>(Kp + r32 * 128 + (cb ^ swz)); B1 = *reinterpret_cast<const bf16x8*>(Kp + (32 + r32) * 128 + (cb ^ swz)); } } while (0)
  bf16x8 a0, a1, n0, n1;
  KFRAG(0, a0, a1);
#pragma unroll
  for (int d0 = 0; d0 < NQK; ++d0) {
    if (d0 + 1 < NQK) { KFRAG(d0 + 1, n0, n1); }
    __builtin_amdgcn_sched_barrier(0);
    p0 = __builtin_amdgcn_mfma_f32_32x32x16_bf16(a0, qr[d0], p0, 0, 0, 0);
    p1 = __builtin_amdgcn_mfma_f32_32x32x16_bf16(a1, qr[d0], p1, 0, 0, 0);
    __builtin_amdgcn_sched_barrier(0);
    a0 = n0; a1 = n1;
  }
#undef KFRAG
}
__device__ __forceinline__ void glds16(const void* gsrc, unsigned lds_dst) { unsigned keep;
  asm volatile("s_mov_b32 %0, m0\n\ts_mov_b32 m0, %2\n\ts_nop 0\n\tglobal_load_lds_dwordx4 %1, off\n\ts_mov_b32 m0, %0" : "=&s"(keep) : "v"(gsrc), "s"(lds_dst) : "memory"); }
template <int NDV> __device__ __forceinline__ int v_st(int k, int c) { const int kk = (k & ~0xC) | ((k & 4) << 1) | ((k & 8) >> 1); return ((kk >> 3) * NDV + (c >> 5)) * 512 + ((kk & 7) * 32 + (c & 31)) * 2; }
__device__ __forceinline__ int v_rd_base(int lane) { return ((lane & 3) << 3) | (((lane >> 2) & 3) << 6) | (((lane >> 4) & 1) << 5) | (((lane >> 5) & 1) << 8); }
template <int NDV> constexpr int v_rd_off(int d0, int ks, int half) { return d0 * 512 + ks * (NDV * 1024) + half * (NDV * 512); }
template <int OFF> __device__ __forceinline__ s16x4 tr_read(int vb) {
  s16x4 r; asm volatile("ds_read_b64_tr_b16 %0, %1 offset:%2" : "=&v"(r) : "v"(vb), "i"(OFF) : "memory"); return r;
}
template <int NDV, int D0> __device__ __forceinline__ void pv_one(f32x16& od, int vb, bf16x8 pa0, bf16x8 pa1, bf16x8 pa2, bf16x8 pa3) {
  const s16x4 l0 = tr_read<v_rd_off<NDV>(D0, 0, 0)>(vb), h0 = tr_read<v_rd_off<NDV>(D0, 0, 1)>(vb), l1 = tr_read<v_rd_off<NDV>(D0, 1, 0)>(vb), h1 = tr_read<v_rd_off<NDV>(D0, 1, 1)>(vb);
  const s16x4 l2 = tr_read<v_rd_off<NDV>(D0, 2, 0)>(vb), h2 = tr_read<v_rd_off<NDV>(D0, 2, 1)>(vb), l3 = tr_read<v_rd_off<NDV>(D0, 3, 0)>(vb), h3 = tr_read<v_rd_off<NDV>(D0, 3, 1)>(vb);
  asm volatile("s_waitcnt lgkmcnt(0)" ::: "memory"); SBAR();
#define PK(L, H) (bf16x8){L[0], L[1], L[2], L[3], H[0], H[1], H[2], H[3]}
  od = __builtin_amdgcn_mfma_f32_32x32x16_bf16(pa0, PK(l0, h0), od, 0, 0, 0);
  od = __builtin_amdgcn_mfma_f32_32x32x16_bf16(pa1, PK(l1, h1), od, 0, 0, 0);
  od = __builtin_amdgcn_mfma_f32_32x32x16_bf16(pa2, PK(l2, h2), od, 0, 0, 0);
  od = __builtin_amdgcn_mfma_f32_32x32x16_bf16(pa3, PK(l3, h3), od, 0, 0, 0);
#undef PK
}
template <int NDV> __device__ __forceinline__ void pv_all(f32x16* o, int vb, bf16x8 pa0, bf16x8 pa1, bf16x8 pa2, bf16x8 pa3) {
  pv_one<NDV, 0>(o[0], vb, pa0, pa1, pa2, pa3); pv_one<NDV, 1>(o[1], vb, pa0, pa1, pa2, pa3);
  if constexpr (NDV == 4) { pv_one<NDV, 2>(o[2], vb, pa0, pa1, pa2, pa3); pv_one<NDV, 3>(o[3], vb, pa0, pa1, pa2, pa3); }
}
__device__ __forceinline__ void wmask(f32x16& p0, f32x16& p1, int kd  , int hi) {
#pragma unroll
  for (int r = 0; r < 16; ++r) { const int d = kd + crow(r, hi); if (d < -128 || d > 128) p0[r] = -1e30f; if (d + 32 < -128 || d + 32 > 128) p1[r] = -1e30f; }
}

template <int NQK, int NDV, int NKN>
__device__ __forceinline__ void attn_unit(const UnitP& P, char* lds, const float C, const float THRS, const int wave_s) {
  constexpr int KN_B = NKN * 64 * 256, KP_B = 64 * 128, SHM_K = KN_B + KP_B, SHM_V = 64 * NDV * 64, NVC = NDV / 2  ;
  const int tid_ = tid_from_(wave_s);
  const int tid = tid_, lane = tid & 63, r32 = lane & 31, hi = lane >> 5; const int wid = __builtin_amdgcn_readfirstlane(tid >> 6);
  char* V_lds = lds; char* K_lds = lds + 2 * SHM_V;
  float* ws = (float*)(lds + 2 * SHM_V + 2 * SHM_K) + wid * 64; float* li_l = ws; float* al_l = ws + 32;
  const unsigned lds0 = (unsigned)(uintptr_t)lds;
  float m_reg = -1e30f, l_reg = 0; f32x16 o[NDV]; bf16x8 qr[NQK];
#pragma unroll
  for (int d = 0; d < NDV; ++d) o[d] = f32x16{};
  const int qrow = wid * QBLK + r32;
  unsigned offKn[2], offKp, offV[2];
#pragma unroll
  for (int i = 0; i < 2; ++i) { const int q = i * 512 + tid, row = q >> 4, cp = q & 15, c = (cp & 8) | ((cp & 7) ^ (row & 7)); offKn[i] = (unsigned)(row * P.ldkn + c * 8); }
  { const int row = tid >> 3, cp = tid & 7, c = cp ^ (row & 7); offKp = (unsigned)(row * P.ldkp + c * 8); }
#pragma unroll
  for (int i = 0; i < NVC; ++i) { const int q = i * 512 + tid, sub = q >> 5, rem = q & 31, kk = (sub / NDV) * 8 + (rem >> 2), c = (sub % NDV) * 32 + (rem & 3) * 8;
    const int k = (kk & ~0xC) | ((kk & 4) << 1) | ((kk & 8) >> 1); offV[i] = (unsigned)(k * P.ldv + c); }
#define TROW(j) ((j) < P.n0 ? P.base0 + 64 * (j) : P.base1 + 64 * ((j) - P.n0))
#define DMA_K(j, b) do { const int row0_ = TROW(j); const unsigned kd_ = lds0 + 2 * SHM_V + (b) * SHM_K + wid * 1024; \
    if constexpr (NKN == 1) { const bf16_t* s_ = P.Kn + (size_t)row0_ * P.ldkn; glds16(s_ + offKn[0], kd_); glds16(s_ + offKn[1], kd_ + 8192); } \
    glds16(P.Kp + (size_t)row0_ * P.ldkp + offKp, kd_ + KN_B); } while (0)
#define DMA_V(j, b) do { const int row0_ = TROW(j); const unsigned vd_ = lds0 + (b) * SHM_V + wid * 1024; const bf16_t* s_ = P.V + (size_t)row0_ * P.ldv; \
    glds16(s_ + offV[0], vd_); if constexpr (NVC == 2) glds16(s_ + offV[1], vd_ + 8192); } while (0)
#define WAIT_BAR(N) asm volatile("s_waitcnt vmcnt(" #N ") lgkmcnt(0)\n\ts_barrier" ::: "memory")
#define LBAR() asm volatile("s_waitcnt lgkmcnt(0)\n\ts_barrier" ::: "memory")
#define WAIT_BAR_V() do { if constexpr (NVC == 2) WAIT_BAR(2); else WAIT_BAR(1); } while (0)
  DMA_K(0, 0); DMA_V(0, 0); DMA_K(1, 1);
  const bf16_t* Qw = P.Q + (size_t)qrow * P.ldq + hi * 8;
#pragma unroll
  for (int d0 = 0; d0 < NQK; ++d0) qr[d0] = *reinterpret_cast<const bf16x8*>(Qw + d0 * 16);
  if (P.rope) {
    const int t = P.qpos0 + qrow; const int pr = t >> 6, pc = t & 63;
#pragma unroll
    for (int a = 0; a < 2; ++a) {
      const float* tb = ROPE_TAB + ((a ? pc : pr) * 16 + hi * 8) * 2;
      bf16x8 x1 = qr[NQK - 4 + 2 * a], x2 = qr[NQK - 3 + 2 * a];
#pragma unroll
      for (int j = 0; j < 8; ++j) { const float c = tb[2 * j], s = tb[2 * j + 1]; const float f1 = bf2f((unsigned short)x1[j]), f2 = bf2f((unsigned short)x2[j]);
        x1[j] = (short)f2bf(f1 * c - f2 * s); x2[j] = (short)f2bf(f2 * c + f1 * s); }
      qr[NQK - 4 + 2 * a] = x1; qr[NQK - 3 + 2 * a] = x2;
    }
  }
  const int vb0 = (int)lds0 + v_rd_base(lane);
#define RESC(a) do { if (__any((a) < 1.f)) { if (hi == 0) al_l[r32] = (a); asm volatile("s_waitcnt lgkmcnt(0)" ::: "memory"); \
    _Pragma("unroll") for (int d = 0; d < NDV; ++d) _Pragma("unroll") for (int r = 0; r < 16; ++r) o[d][r] *= al_l[crow(r, hi)]; } } while (0)
#define MASK(P0, P1, j) do { if (P.masked && (j) >= P.n0) { const int kd0_ = P.kpos1 + 64 * ((j) - P.n0) - (P.qpos0 + wid * QBLK); \
    if (kd0_ + 63 > 128 || kd0_ - 31 < -128) wmask(P0, P1, P.kpos1 + 64 * ((j) - P.n0) - (P.qpos0 + qrow), hi); } } while (0)
#define QKT(P0, P1, b) qkt<NQK, NKN>(P0, P1, K_lds + (b) * SHM_K, K_lds + (b) * SHM_K + KN_B, qr, r32, hi)
  f32x16 pA0, pA1, pB0, pB1; float mnA, mnB, alA, alB; bf16x8 pa0, pa1, pa2, pa3; const int NT = P.NT;
  WAIT_BAR(0);
  QKT(pA0, pA1, 0); MASK(pA0, pA1, 0); partialSM(pA0, pA1, m_reg, mnA, alA, C, THRS);
  DMA_V(1, 1);
  for (int j = 1; j + 1 < NT; j += 2) {
    DMA_K(j + 1, 0);
    SBAR(); finishSM(pA0, pA1, alA, l_reg, pa0, pa1, pa2, pa3); SBAR();
    QKT(pB0, pB1, 1); MASK(pB0, pB1, j); SBAR();
    pv_all<NDV>(o, vb0, pa0, pa1, pa2, pa3); partialSM(pB0, pB1, m_reg, mnB, alB, C, THRS);
    LBAR();
    DMA_V(j + 1, 0);
    RESC(alB);
    WAIT_BAR_V();
    DMA_K(j + 2, 1);
    SBAR(); finishSM(pB0, pB1, alB, l_reg, pa0, pa1, pa2, pa3); SBAR();
    QKT(pA0, pA1, 0); MASK(pA0, pA1, j + 1); SBAR();
    pv_all<NDV>(o, vb0 + SHM_V, pa0, pa1, pa2, pa3); partialSM(pA0, pA1, m_reg, mnA, alA, C, THRS);
    LBAR();
    DMA_V(j + 2, 1);
    RESC(alA);
    WAIT_BAR_V();
  }
  SBAR(); finishSM(pA0, pA1, alA, l_reg, pa0, pa1, pa2, pa3); SBAR();
  QKT(pB0, pB1, 1); MASK(pB0, pB1, NT - 1); SBAR();
  pv_all<NDV>(o, vb0, pa0, pa1, pa2, pa3); partialSM(pB0, pB1, m_reg, mnB, alB, C, THRS);
  WAIT_BAR(0); RESC(alB);
  finishSM(pB0, pB1, alB, l_reg, pa0, pa1, pa2, pa3); SBAR();
  pv_all<NDV>(o, vb0 + SHM_V, pa0, pa1, pa2, pa3);
  if (P.has_sink) l_reg += __builtin_amdgcn_exp2f(P.sink * 1.4426950408889634f - m_reg * C);
  if (hi == 0) li_l[r32] = l_reg; asm volatile("s_waitcnt lgkmcnt(0)" ::: "memory");
  float rli[16];
#pragma unroll
  for (int r = 0; r < 16; ++r) rli[r] = __builtin_amdgcn_rcpf(li_l[crow(r, hi)]);
  bf16_t* Ow = P.O + (size_t)(wid * QBLK) * P.ldo;
#pragma unroll
  for (int r = 0; r < 16; ++r) { const int orow = crow(r, hi);
#pragma unroll
    for (int d0 = 0; d0 < NDV; ++d0) Ow[(size_t)orow * P.ldo + d0 * 32 + r32] = f2bf(o[d0][r] * rli[r]); }
  LBAR();
#undef TROW
#undef DMA_K
#undef DMA_V
#undef WAIT_BAR
#undef WAIT_BAR_V
#undef LBAR
#undef RESC
#undef MASK
#undef QKT
}
#undef SBAR
}

struct Ctx {
    unsigned char* lds; LAS unsigned char* lds3;
    int tid, lane, wave, G, bx, vcu;
};

#define LDS_BAR() asm volatile("s_waitcnt lgkmcnt(0)\n\ts_barrier" ::: "memory")
__device__ __forceinline__ Ctx make_ctx(unsigned char* lds, const int wave_s) {
    Ctx T; const int tid_ = tid_from_(wave_s);
    T.lds = lds; T.lds3 = (LAS unsigned char*)lds; T.tid = tid_; T.lane = tid_ & 63; T.wave = __builtin_amdgcn_readfirstlane(tid_ >> 6);
    T.G = gridDim.x; T.bx = blockIdx.x; T.vcu = (T.G % 8 == 0) ? (T.bx % 8) * (T.G / 8) + T.bx / 8 : T.bx;
    return T;
}
__device__ __forceinline__ void transpose_item(const float* W, int K, int N, bf16_t* WT, LAS float* scr, int item, int lane) {
    const int nblk = N / 32, kb = item / nblk, nb = item % nblk, k0 = 64 * kb, n0 = 32 * nb;
    float wv[32];
#pragma unroll
    for (int i = 0; i < 32; ++i) wv[i] = W[(size_t)(k0 + 2 * i + (lane >> 5)) * N + n0 + (lane & 31)];
#pragma unroll
    for (int i = 0; i < 32; ++i) scr[(2 * i + (lane >> 5)) * 33 + (lane & 31)] = wv[i];
    asm volatile("s_waitcnt lgkmcnt(0)" ::: "memory");
    const int c = lane & 7;
#pragma unroll
    for (int j = 0; j < 4; ++j) { const int n = (lane >> 3) + 8 * j; const LAS float* s = scr + (8 * c) * 33 + n;
        u32x4 o; o.x = cvt_pk_bf16(s[0 * 33], s[1 * 33]); o.y = cvt_pk_bf16(s[2 * 33], s[3 * 33]); o.z = cvt_pk_bf16(s[4 * 33], s[5 * 33]); o.w = cvt_pk_bf16(s[6 * 33], s[7 * 33]);
        *(u32x4*)(WT + (size_t)(n0 + n) * K + k0 + 8 * c) = o; }
    asm volatile("s_waitcnt lgkmcnt(0)" ::: "memory");
}

struct Params { const float* in[23]; float* out; unsigned char* ws; int ph_lo, ph_hi; };
enum { I_X = 0, I_C, I_CTX, I_CCTX, I_ADAW, I_ADAB, I_NMIX, I_NMLP, I_WIN, I_QN, I_WUQ, I_KVN, I_WUKV, I_SINK, I_CONVW, I_CONVB, I_LNG, I_LNB, I_ONORM, I_WOUT, I_W1, I_W2, I_FNORM };

__device__ __forceinline__ void prologue_phase(const Ctx& T, const Params& p) {
    float* mod = (float*)(p.ws + WS_MOD);
    {
        float* sil = (float*)T.lds;
        float* red = sil + 5 * DM;
        for (int i = T.tid; i < 5 * DM; i += 512) { const int r = i >> 11, k = i & (DM - 1); const float v = r < 4 ? p.in[I_C][r * DM + k] : p.in[I_CCTX][k]; sil[i] = v * sigmoidf_(v); }
        __syncthreads();
        for (int item = T.bx; item < 2 * 96; item += T.G) {
            const int l = item / 96, cb = item % 96, col = cb * 128 + 2 * T.lane;
            const float* W = p.in[I_ADAW] + (size_t)l * DM * MODW + col;
            float a0[5], a1[5];
#pragma unroll
            for (int r = 0; r < 5; ++r) { a0[r] = 0.f; a1[r] = 0.f; }
            const int k0 = T.wave * 256;
            for (int k = k0; k < k0 + 256; k += 16) {
                f32x2 w[16];
#pragma unroll
                for (int i = 0; i < 16; ++i) w[i] = *(const f32x2*)(W + (size_t)(k + i) * MODW);
#pragma unroll
                for (int i = 0; i < 16; ++i)
#pragma unroll
                    for (int r = 0; r < 5; ++r) { const float s = sil[r * DM + k + i]; a0[r] += s * w[i].x; a1[r] += s * w[i].y; }
            }
#pragma unroll
            for (int r = 0; r < 5; ++r) { red[(T.wave * 5 + r) * 128 + 2 * T.lane] = a0[r]; red[(T.wave * 5 + r) * 128 + 2 * T.lane + 1] = a1[r]; }
            __syncthreads();
            for (int i = T.tid; i < 5 * 128; i += 512) { const int r = i >> 7, cc = i & 127; float s = 0.f;
#pragma unroll
                for (int w = 0; w < 8; ++w) s += red[(w * 5 + r) * 128 + cc];
                mod[(size_t)(l * 5 + r) * MODW + cb * 128 + cc] = s + p.in[I_ADAB][l * MODW + cb * 128 + cc]; }
            __syncthreads();
        }
    }
    {
        LAS float* scr = (LAS float*)(T.lds3 + T.wave * 16384);
        const int gw = T.bx * 8 + T.wave, NGW = T.G * 8;
        constexpr int I_IN = (DM / 64) * (INW / 32), I_UQ = (512 / 64) * (QW / 32), I_UKV = (512 / 64) * (KVW / 32), I_OUT = (DM / 64) * (DM / 32), I_1 = (DM / 64) * (FF / 32), I_2 = (FF / 64) * (DM / 32);
        constexpr int PER_L = I_IN + I_UQ + I_UKV + I_OUT + I_1 + I_2;
        for (int it = gw; it < 2 * PER_L; it += NGW) {
            const int l = it / PER_L; int r = it % PER_L;
            unsigned char* wl = p.ws + WS_WL + (size_t)l * WL_SIZE;
            if (r < I_IN) { transpose_item(p.in[I_WIN] + (size_t)l * DM * INW, DM, INW, (bf16_t*)(wl + WL_IN), scr, r, T.lane); continue; } r -= I_IN;
            if (r < I_UQ) { transpose_item(p.in[I_WUQ] + (size_t)l * 512 * QW, 512, QW, (bf16_t*)(wl + WL_UQ), scr, r, T.lane); continue; } r -= I_UQ;
            if (r < I_UKV) { transpose_item(p.in[I_WUKV] + (size_t)l * 512 * KVW, 512, KVW, (bf16_t*)(wl + WL_UKV), scr, r, T.lane); continue; } r -= I_UKV;
            if (r < I_OUT) { transpose_item(p.in[I_WOUT] + (size_t)l * DM * DM, DM, DM, (bf16_t*)(wl + WL_OUT), scr, r, T.lane); continue; } r -= I_OUT;
            if (r < I_1) { transpose_item(p.in[I_W1] + (size_t)l * DM * FF, DM, FF, (bf16_t*)(wl + WL_W1), scr, r, T.lane); continue; } r -= I_1;
            transpose_item(p.in[I_W2] + (size_t)l * FF * DM, FF, DM, (bf16_t*)(wl + WL_W2), scr, r, T.lane);
        }
        const int gt = T.bx * 512 + T.tid, NGT = T.G * 512;
        constexpr int PADV = (INWP - INW) * DM * 2 / 16;
        for (int i = gt; i < 2 * PADV; i += NGT) { const int l = i / PADV, j = i % PADV;
            *(u32x4*)(p.ws + WS_WL + (size_t)l * WL_SIZE + WL_IN + (size_t)INW * DM * 2 + (size_t)j * 16) = (u32x4){0u, 0u, 0u, 0u}; }
    }
}

template <int TR, bool SLABS>
__device__ __forceinline__ void norm_tile(const Ctx& T, float* red, const float* xb  , const f32x4 gs, const f32x4 sh4, bf16_t* ob  ,
                                          const float* sb  , const f32x4 gt, float* xo  ) {
    f32x4 v[TR];
#pragma unroll
    for (int i = 0; i < TR; ++i) v[i] = *(const f32x4*)(xb + (size_t)i * DM);
    if constexpr (SLABS) {
        f32x4 sv[TR][8];
#pragma unroll
        for (int i = 0; i < TR; ++i)
#pragma unroll
            for (int sl = 0; sl < 8; ++sl) sv[i][sl] = *(const f32x4*)(sb + ((size_t)sl * NCTXR + i) * DM);
#pragma unroll
        for (int i = 0; i < TR; ++i) { const f32x4 a = ((sv[i][0] + sv[i][1]) + (sv[i][2] + sv[i][3])) + ((sv[i][4] + sv[i][5]) + (sv[i][6] + sv[i][7]));
            v[i] += gt * a; *(f32x4*)(xo + (size_t)i * DM) = v[i]; }
    }
    { float ss[TR];
#pragma unroll
      for (int i = 0; i < TR; ++i) ss[i] = (v[i].x * v[i].x + v[i].y * v[i].y) + (v[i].z * v[i].z + v[i].w * v[i].w);
      wave_sum_n<TR>(ss, T.lane);
#pragma unroll
      for (int i = 0; i < TR; ++i) if (T.lane == i) red[i * 8 + T.wave] = ss[i]; }
    LDS_BAR();
#pragma unroll
    for (int i = 0; i < TR; ++i) { const f32x4 a = *(const f32x4*)(red + i * 8), b = *(const f32x4*)(red + i * 8 + 4);
        const float rstd = 1.0f / sqrtf((((a.x + a.y) + (a.z + a.w)) + ((b.x + b.y) + (b.z + b.w))) * (1.0f / DM) + EPS);
        const f32x4 y = v[i] * rstd * gs + sh4;
        u32x2 w; w.x = cvt_pk_bf16(y.x, y.y); w.y = cvt_pk_bf16(y.z, y.w); *(u32x2*)(ob + (size_t)i * DM) = w; }
    LDS_BAR();
}
__device__ __forceinline__ void modnorm_phase(const Ctx& T, const float* src_lat, const float* src_ctx, int nrows, const float* gw, const float* modl, int sh_off, int sc_off, bf16_t* out, const float* slab, const float* gate, float* xout) {
    float* red = (float*)T.lds;
    const int col = 4 * T.tid;
    const f32x4 g4 = *(const f32x4*)(gw + col);
    for (int t = T.bx; t < NLAT / 16; t += T.G) {
        const int r0 = t * 16; const float* mr = modl + (size_t)(r0 >> 12) * MODW + col;
        const f32x4 gs = g4 * (*(const f32x4*)(mr + sc_off) + 1.0f), sh4 = *(const f32x4*)(mr + sh_off);
        norm_tile<16, false>(T, red, src_lat + (size_t)r0 * DM + col, gs, sh4, out + (size_t)r0 * DM + col, nullptr, gs, nullptr);
    }
    if (nrows > NLAT) {
        const float* mr = modl + (size_t)4 * MODW + col;
        const f32x4 gs = g4 * (*(const f32x4*)(mr + sc_off) + 1.0f), sh4 = *(const f32x4*)(mr + sh_off);
        for (int t = T.bx; t < NCTXR / 4; t += T.G) {
            const int rc = t * 4;
            if (slab) { const f32x4 gt = *(const f32x4*)(gate + (size_t)4 * MODW + col);
                norm_tile<4, true>(T, red, src_ctx + (size_t)rc * DM + col, gs, sh4, out + (size_t)(NLAT + rc) * DM + col, slab + (size_t)rc * DM + col, gt, xout + (size_t)(NLAT + rc) * DM + col); }
            else norm_tile<4, false>(T, red, src_ctx + (size_t)rc * DM + col, gs, sh4, out + (size_t)(NLAT + rc) * DM + col, nullptr, gs, nullptr);
        }
    }
}
__device__ __forceinline__ void finalnorm_phase(const Ctx& T, const float* x, const float* gw, float* out) {
    constexpr int TR = 16;
    float* red = (float*)T.lds;
    const int col = 4 * T.tid;
    const f32x4 g4 = *(const f32x4*)(gw + col);
    for (int t = T.bx; t < NLAT / TR; t += T.G) {
        const int r0 = t * TR;
        f32x4 v[TR];
#pragma unroll
        for (int i = 0; i < TR; ++i) v[i] = *(const f32x4*)(x + (size_t)(r0 + i) * DM + col);
        { float ss[TR];
#pragma unroll
          for (int i = 0; i < TR; ++i) ss[i] = (v[i].x * v[i].x + v[i].y * v[i].y) + (v[i].z * v[i].z + v[i].w * v[i].w);
          wave_sum_n<TR>(ss, T.lane);
#pragma unroll
          for (int i = 0; i < TR; ++i) if (T.lane == i) red[i * 8 + T.wave] = ss[i]; }
        LDS_BAR();
#pragma unroll
        for (int i = 0; i < TR; ++i) { const f32x4 a = *(const f32x4*)(red + i * 8), b = *(const f32x4*)(red + i * 8 + 4);
            const float rstd = 1.0f / sqrtf((((a.x + a.y) + (a.z + a.w)) + ((b.x + b.y) + (b.z + b.w))) * (1.0f / DM) + EPS);
            __builtin_nontemporal_store(v[i] * rstd * g4, (f32x4*)(out + (size_t)(r0 + i) * DM + col)); }
        LDS_BAR();
    }
}

__device__ __forceinline__ void unpack8(const u32x4 w, float* f) { f[0] = bflo(w.x); f[1] = bfhi(w.x); f[2] = bflo(w.y); f[3] = bfhi(w.y); f[4] = bflo(w.z); f[5] = bfhi(w.z); f[6] = bflo(w.w); f[7] = bfhi(w.w); }
__device__ __forceinline__ u32x4 pack8(const float* f) { u32x4 w; w.x = cvt_pk_bf16(f[0], f[1]); w.y = cvt_pk_bf16(f[2], f[3]); w.z = cvt_pk_bf16(f[4], f[5]); w.w = cvt_pk_bf16(f[6], f[7]); return w; }

__device__ __forceinline__ void prep_phase(const Ctx& T, bf16_t* U, const float* qn, const float* kvn) {
    constexpr int RR = 4;
    const int gwv = T.bx * 8 + T.wave, NGW = T.G * 8, lane = T.lane;
    float gq[8], gk[8];
#pragma unroll
    for (int j = 0; j < 8; ++j) { gq[j] = qn[8 * lane + j]; gk[j] = kvn[8 * lane + j]; }
    const int a = (lane >> 4) & 1, fi = lane & 15;
    for (int r0 = gwv * RR; r0 < NROW; r0 += NGW * RR) {
        u32x4 vq[RR], vk[RR], va[RR], vg[RR]; unsigned short x1a[RR], x2a[RR], x1b[RR], x2b[RR]; f32x2 rcs[RR];
        const bool lat = r0 < NLAT;
        const int ia = U_AKR + 32 * a + fi, ib = U_BK + (lane >> 5) * 64 + 32 * a + fi;
#pragma unroll
        for (int i = 0; i < RR; ++i) { const bf16_t* ur = U + (size_t)(r0 + i) * INWP;
            vq[i] = ((const u32x4*)(ur + U_AQ))[lane]; vk[i] = ((const u32x4*)(ur + U_AKV))[lane]; va[i] = ((const u32x4*)(ur + U_CA))[lane]; vg[i] = ((const u32x4*)(ur + U_CG))[lane];
            if (lat) { x1a[i] = ur[ia]; x2a[i] = ur[ia + 16]; x1b[i] = ur[ib]; x2b[i] = ur[ib + 16];
                const int t = (r0 + i) & (SEQ - 1), pos = a ? (t & 63) : (t >> 6); rcs[i] = *(const f32x2*)(ROPE_TAB + (pos * 16 + fi) * 2); } }
        float ssq[2 * RR];
#pragma unroll
        for (int i = 0; i < RR; ++i) { float f[8]; unpack8(vq[i], f); float s = 0.f;
#pragma unroll
            for (int j = 0; j < 8; ++j) s += f[j] * f[j];
            ssq[2 * i] = s; unpack8(vk[i], f); s = 0.f;
#pragma unroll
            for (int j = 0; j < 8; ++j) s += f[j] * f[j];
            ssq[2 * i + 1] = s; }
        wave_sum_n<2 * RR>(ssq, lane);
#pragma unroll
        for (int i = 0; i < RR; ++i) { bf16_t* ur = U + (size_t)(r0 + i) * INWP; float f[8];
            { unpack8(vq[i], f); const float rstd = 1.0f / sqrtf(ssq[2 * i] * (1.0f / 512.0f) + EPS);
#pragma unroll
              for (int j = 0; j < 8; ++j) f[j] = f[j] * rstd * gq[j];
              ((u32x4*)(ur + U_AQ))[lane] = pack8(f); }
            { unpack8(vk[i], f); const float rstd = 1.0f / sqrtf(ssq[2 * i + 1] * (1.0f / 512.0f) + EPS);
#pragma unroll
              for (int j = 0; j < 8; ++j) f[j] = f[j] * rstd * gk[j];
              ((u32x4*)(ur + U_AKV))[lane] = pack8(f); }
            if (lat) {
                const float c = rcs[i].x, s = rcs[i].y;
                if (lane < 32) { const float x1 = bf2f(x1a[i]), x2 = bf2f(x2a[i]); ur[ia] = f2bf(x1 * c - x2 * s); ur[ia + 16] = f2bf(x2 * c + x1 * s); }
                { const float x1 = bf2f(x1b[i]), x2 = bf2f(x2b[i]); ur[ib] = f2bf(x1 * c - x2 * s); ur[ib + 16] = f2bf(x2 * c + x1 * s); }
            }
            { float fg[8]; unpack8(va[i], f); unpack8(vg[i], fg);
#pragma unroll
              for (int j = 0; j < 8; ++j) f[j] = f[j] * sigmoidf_(fg[j]);
              ((u32x4*)(ur + U_CA))[lane] = pack8(f); }
        }
    }
}

__device__ __forceinline__ void mergenorm_phase(const Ctx& T, bf16_t* MIX, const float* on, int nrows) {
    constexpr int RR = 4;
    const int gwv = T.bx * 8 + T.wave, NGW = T.G * 8, lane = T.lane;
    float g0[8], g1[8], g2[8], g3[8];
#pragma unroll
    for (int j = 0; j < 8; ++j) { g0[j] = on[8 * lane + j]; g1[j] = on[512 + 8 * lane + j]; g2[j] = on[1024 + 8 * lane + j]; g3[j] = on[1536 + 8 * lane + j]; }
    for (int r0 = gwv * RR; r0 < nrows; r0 += NGW * RR) {
        u32x4 v0[RR], v1[RR], v2[RR], v3[RR];
#pragma unroll
        for (int i = 0; i < RR; ++i) { const u32x4* mr = (const u32x4*)(MIX + (size_t)(r0 + i) * MIXW) + lane; v0[i] = mr[0]; v1[i] = mr[64]; v2[i] = mr[128]; v3[i] = mr[192]; }
        float ssq[3 * RR];
#pragma unroll
        for (int i = 0; i < RR; ++i) { float f[8], h[8]; unpack8(v0[i], f); unpack8(v1[i], h); float s = 0.f;
#pragma unroll
            for (int j = 0; j < 8; ++j) s += f[j] * f[j] + h[j] * h[j];
            ssq[3 * i] = s; unpack8(v2[i], f); s = 0.f;
#pragma unroll
            for (int j = 0; j < 8; ++j) s += f[j] * f[j];
            ssq[3 * i + 1] = s; unpack8(v3[i], f); s = 0.f;
#pragma unroll
            for (int j = 0; j < 8; ++j) s += f[j] * f[j];
            ssq[3 * i + 2] = s; }
        wave_sum_n<3 * RR>(ssq, lane);
#pragma unroll
        for (int i = 0; i < RR; ++i) { u32x4* mr = (u32x4*)(MIX + (size_t)(r0 + i) * MIXW) + lane; float f[8], h[8];
            { unpack8(v0[i], f); unpack8(v1[i], h); const float rstd = 1.0f / sqrtf(ssq[3 * i] * (1.0f / 1024.0f) + EPS);
#pragma unroll
              for (int j = 0; j < 8; ++j) { f[j] = f[j] * rstd * g0[j]; h[j] = h[j] * rstd * g1[j]; }
              mr[0] = pack8(f); mr[64] = pack8(h); }
            { unpack8(v2[i], f); const float rstd = 1.0f / sqrtf(ssq[3 * i + 1] * (1.0f / 512.0f) + EPS);
#pragma unroll
              for (int j = 0; j < 8; ++j) f[j] = f[j] * rstd * g2[j];
              mr[128] = pack8(f); }
            { unpack8(v3[i], f); const float rstd = 1.0f / sqrtf(ssq[3 * i + 2] * (1.0f / 512.0f) + EPS);
#pragma unroll
              for (int j = 0; j < 8; ++j) f[j] = f[j] * rstd * g3[j];
              mr[192] = pack8(f); }
        }
    }
}

__device__ __forceinline__ void conv_phase(const Ctx& T, const bf16_t* U, bf16_t* MIX, const float* cw, const float* cb, const float* lng, const float* lnb, int nitems) {
    constexpr int CR = 16, NL = CR + 30;
    const int c = T.tid;
    float w[31];
#pragma unroll
    for (int k = 0; k < 31; ++k) w[k] = cw[k * 512 + c];
    const float bias = cb[c], g = lng[c], b = lnb[c];
    float* red = (float*)T.lds;
    unsigned short hv[NL], hn[NL];
#define CONV_LOAD(dst, it) do { const int r0_ = (it) * CR; int s0_, s1_; \
        if (r0_ < NLAT) { s0_ = r0_ & ~(SEQ - 1); s1_ = s0_ + SEQ; } else { s0_ = NLAT + ((r0_ - NLAT) & ~(CTXL - 1)); s1_ = s0_ + CTXL; } \
        _Pragma("unroll") for (int j = 0; j < NL; ++j) { int rr = r0_ - 15 + j; rr = rr < s0_ ? s0_ : (rr >= s1_ ? s1_ - 1 : rr); dst[j] = U[(size_t)rr * INWP + U_CA + c]; } } while (0)
    int item = T.bx; asm volatile("" : "+s"(item));
    if (item < nitems) CONV_LOAD(hv, item);
    while (item < nitems) {
        const int nxt = item + T.G;
        if (nxt < nitems) CONV_LOAD(hn, nxt);
        const int r0 = item * CR;
        int seg0, seg1;
        if (r0 < NLAT) { seg0 = r0 & ~(SEQ - 1); seg1 = seg0 + SEQ; } else { seg0 = NLAT + ((r0 - NLAT) & ~(CTXL - 1)); seg1 = seg0 + CTXL; }
        float acc[CR];
#pragma unroll
        for (int i = 0; i < CR; ++i) acc[i] = bias;
#pragma unroll
        for (int j = 0; j < NL; ++j) {
            const int rr = r0 - 15 + j;
            const float v = (rr >= seg0 && rr < seg1) ? bf2f(hv[j]) : 0.f;
#pragma unroll
            for (int i = 0; i < CR; ++i) { const int k = j - i; if (k >= 0 && k < 31) acc[i] += w[k] * v; }
        }
        float s[2 * CR];
#pragma unroll
        for (int i = 0; i < CR; ++i) { s[i] = acc[i]; s[CR + i] = acc[i] * acc[i]; }
        wave_sum_n<2 * CR>(s, T.lane);
#pragma unroll
        for (int q = 0; q < 2 * CR; ++q) if (T.lane == q) red[T.wave * 2 * CR + q] = s[q];
        LDS_BAR();
#pragma unroll
        for (int i = 0; i < CR; ++i) {
            float sm = 0.f, sq = 0.f;
#pragma unroll
            for (int wv = 0; wv < 8; ++wv) { sm += red[wv * 2 * CR + i]; sq += red[wv * 2 * CR + CR + i]; }
            const float mean = sm * (1.0f / 512.0f); const float var = fmaxf(sq * (1.0f / 512.0f) - mean * mean, 0.f);
            const float y = (acc[i] - mean) * __builtin_amdgcn_rsqf(var + EPS) * g + b;
            MIX[(size_t)(r0 + i) * MIXW + 1536 + c] = f2bf(y * sigmoidf_(y));
        }
        LDS_BAR();
#pragma unroll
        for (int j = 0; j < NL; ++j) hv[j] = hn[j];
        item = nxt;
    }
#undef CONV_LOAD
}

#define XB_TMO      128
#define XB_XCNT(j)  (256  + 64 * (j))
#define XB_XSUB(j)  (1280 + 64 * (j))
#define XB_XGEN(j)  (2304 + 64 * (j))
#define XB_TOP      3328
#define XB_TOPGEN   3392
#define XCD_BAR_WORDS 3456
#define XB_SPIN_CAP (1u << 20)
__device__ __forceinline__ unsigned xb_ld(unsigned* p)              { return __hip_atomic_load(p, __ATOMIC_RELAXED, __HIP_MEMORY_SCOPE_AGENT); }
__device__ __forceinline__ unsigned xb_add(unsigned* p, unsigned v) { return __hip_atomic_fetch_add(p, v, __ATOMIC_RELAXED, __HIP_MEMORY_SCOPE_AGENT); }
__device__ __forceinline__ unsigned xb_xcc_id() { return (unsigned)__builtin_amdgcn_s_getreg((3 << 11) | 20) & 0xFu; }
#define XB_SPIN(cond, bar) do { unsigned _sp = 0; while (cond) { __builtin_amdgcn_s_sleep(1); \
    if ((++_sp & 255u) == 0u) { if (xb_ld(&(bar)[XB_TMO])) break; if (_sp > XB_SPIN_CAP) { atomicAdd(&(bar)[XB_TMO], 1u); break; } } } } while (0)
struct XcdBarrier { unsigned* bar; unsigned x; volatile LAS unsigned* st; };
__device__ __forceinline__ XcdBarrier xcd_barrier_post(unsigned* bar, volatile LAS unsigned* st, const int tid) {
    XcdBarrier b; b.bar = bar; b.x = xb_xcc_id(); b.st = st;
    if (tid == 0) (void)xb_add(&bar[XB_XCNT(b.x)], 1u);
    return b;
}
__device__ __forceinline__ void xcd_barrier_complete(unsigned* bar, unsigned x, unsigned& nloc, unsigned& nx) {
    const unsigned G = gridDim.x * gridDim.y * gridDim.z;
    unsigned sum, cnt, mine, sp = 0u;
    for (;;) {
        sum = 0u; cnt = 0u; mine = 0u;
#pragma unroll
        for (unsigned j = 0; j < 16; ++j) { const unsigned c = xb_ld(&bar[XB_XCNT(j)]); sum += c; cnt += (c > 0u) ? 1u : 0u; mine = (j == x) ? c : mine; }
        if (sum == G) break;
        __builtin_amdgcn_s_sleep(1);
        if ((++sp & 255u) == 0u) { if (xb_ld(&bar[XB_TMO])) break; if (sp > XB_SPIN_CAP) { atomicAdd(&bar[XB_TMO], 1u); break; } }
    }
    nloc = mine > 0u ? mine : 1u; nx = cnt > 0u ? cnt : 1u;
}
__device__ __forceinline__ void xcd_barrier(const XcdBarrier& b, const int tid) {
    asm volatile("s_waitcnt vmcnt(0)" ::: "memory");
    __syncthreads();
    if (tid == 0) {
        unsigned* bar = b.bar;
        __builtin_amdgcn_s_waitcnt(0);
        unsigned nloc = b.st[0], nx = b.st[1];
        if (nloc == 0u) { xcd_barrier_complete(bar, b.x, nloc, nx); b.st[0] = nloc; b.st[1] = nx; }
        const unsigned old = xb_add(&bar[XB_XSUB(b.x)], 1u);
        const unsigned gen = old / nloc;
        if (old + 1u == (gen + 1u) * nloc) {
            __builtin_amdgcn_fence(__ATOMIC_RELEASE, "agent");
            asm volatile("s_waitcnt vmcnt(0)" ::: "memory");
            const unsigned og = xb_add(&bar[XB_TOP], 1u);
            const unsigned tg = og / nx;
            if (og + 1u == (tg + 1u) * nx) xb_add(&bar[XB_TOPGEN], 1u);
            else XB_SPIN(xb_ld(&bar[XB_TOPGEN]) == tg, bar);
            __builtin_amdgcn_fence(__ATOMIC_ACQUIRE, "agent");
            xb_add(&bar[XB_XGEN(b.x)], 1u);
            asm volatile("s_waitcnt vmcnt(0)" ::: "memory");
        } else {
            XB_SPIN(xb_ld(&bar[XB_XGEN(b.x)]) == gen, bar);
            __builtin_amdgcn_fence(__ATOMIC_ACQUIRE, "agent");
            asm volatile("s_waitcnt vmcnt(0)" ::: "memory");
        }
    }
    __syncthreads();
}

#ifndef PH_MASK
#define PH_MASK 0xFFFF
#endif
#ifndef DUP_MASK
#define DUP_MASK 0
#endif
#ifndef DUP_SUB
#define DUP_SUB 0
#endif
#ifndef DUP_BAR
#define DUP_BAR 0
#endif
#ifndef DUP_L
#define DUP_L 3
#endif
__global__ void __launch_bounds__(512, 2) mega_fwd(Params p) {
    extern __shared__ __attribute__((aligned(16))) unsigned char lds[];
    cg::grid_group grid = cg::this_grid();
    unsigned char* ws = p.ws;
    float* mod = (float*)(ws + WS_MOD);
    float* XB = (float*)(ws + WS_X);
    bf16_t* HN = (bf16_t*)(ws + WS_HN); bf16_t* U = (bf16_t*)(ws + WS_U); bf16_t* QB = (bf16_t*)(ws + WS_Q); bf16_t* KVB = (bf16_t*)(ws + WS_KV);
    bf16_t* MIX = (bf16_t*)(ws + WS_MIX); bf16_t* ACT = (bf16_t*)(ws + WS_ACT); float* SLAB = (float*)(ws + WS_SLAB);
    const int wave_s = __builtin_amdgcn_readfirstlane((int)threadIdx.x >> 6);
    { volatile LAS unsigned* m = (volatile LAS unsigned*)((LAS unsigned char*)lds + 131072); const int t0 = tid_from_(wave_s); if (t0 < 64) m[t0] = 0u; }
    __syncthreads();
    if (p.ph_hi - p.ph_lo > 1) (void)xcd_barrier_post((unsigned*)(ws + WS_CTL), (volatile LAS unsigned*)((LAS unsigned char*)lds + 131072) + 8, tid_from_(wave_s));
    int ph = 0; int l_ = 0;
#define RUN(k) ((k) >= p.ph_lo && (k) < p.ph_hi)
#define GBAR() do { XcdBarrier xb_; xb_.bar = (unsigned*)(p.ws + WS_CTL); xb_.x = xb_xcc_id(); xb_.st = (volatile LAS unsigned*)((LAS unsigned char*)lds + 131072) + 8; xcd_barrier(xb_, tid_from_(wave_s)); } while (0)
#define SEAM() do { if (ph >= p.ph_lo && ph + 1 < p.ph_hi) { if (p.ph_lo < 0) grid.sync();   for (int rb_ = 0; rb_ <= DUP_BAR; ++rb_) { XcdBarrier xb_; xb_.bar = (unsigned*)(p.ws + WS_CTL); xb_.x = xb_xcc_id(); xb_.st = (volatile LAS unsigned*)((LAS unsigned char*)lds + 131072) + 8; xcd_barrier(xb_, tid_from_(wave_s)); } } ++ph; } while (0)

    if (((PH_MASK >> 0) & 1) && RUN(ph)) { for (int rep_ = 0; rep_ < 1 + ((DUP_MASK >> 0) & 1) * ((DUP_L >> l_) & 1); ++rep_) { if (rep_) GBAR(); { const Ctx T = make_ctx(lds, wave_s); prologue_phase(T, p); } } }
    SEAM();

    for (int l = 0; l < DEPTH; ++l) { l_ = l;
        const unsigned char* wl = ws + WS_WL + (size_t)l * WL_SIZE;
        const float* modl = mod + (size_t)l * 5 * MODW;
        const float* res_lat = l == 0 ? p.in[I_X] : XB;
        const float* res_ctx = l == 0 ? p.in[I_CTX] : XB + (size_t)NLAT * DM;
        const int mrows = l == 0 ? NROW : NLAT;
        if (((PH_MASK >> 1) & 1) && RUN(ph)) { for (int rep_ = 0; rep_ < 1 + ((DUP_MASK >> 1) & 1) * ((DUP_L >> l_) & 1); ++rep_) { if (rep_) GBAR(); { const Ctx T = make_ctx(lds, wave_s); modnorm_phase(T, res_lat, res_ctx, NROW, p.in[I_NMIX] + l * DM, modl, 0 * DM, 1 * DM, HN, l == 1 ? SLAB : nullptr, mod + 5 * DM, XB); } } }
        SEAM();
        if (((PH_MASK >> 2) & 1) && RUN(ph)) { for (int rep_ = 0; rep_ < 1 + ((DUP_MASK >> 2) & 1) * ((DUP_L >> l_) & 1); ++rep_) { if (rep_) GBAR(); { const Ctx T = make_ctx(lds, wave_s);  pg8::Gemm g{HN, (const bf16_t*)(wl + WL_IN), NROW, INWP, DM, DM}; pg8::StaticOrder S; S.init(NROW, INWP, T.G, T.bx, DM);
            pg8::EpiBf16<0> E{U, INWP}; pg8::gemm_phase<pg8::EpiBf16<0>, pg8::StaticOrder, true, true>(T.lds3, g, S, E, wave_s); } } }
        SEAM();
        if (((PH_MASK >> 3) & 1) && RUN(ph)) { for (int rep_ = 0; rep_ < 1 + ((DUP_MASK >> 3) & 1) * ((DUP_L >> l_) & 1); ++rep_) { if (rep_) GBAR(); { const Ctx T = make_ctx(lds, wave_s); prep_phase(T, U, p.in[I_QN] + l * 512, p.in[I_KVN] + l * 512); } } }
        SEAM();
        if (((PH_MASK >> 4) & 1) && RUN(ph)) { for (int rep_ = 0; rep_ < 1 + ((DUP_MASK >> 4) & 1) * ((DUP_L >> l_) & 1); ++rep_) { if (rep_) GBAR(); { const Ctx T = make_ctx(lds, wave_s);
            for (int gi = 0; gi < 2; ++gi) {
                const int Mg = gi == 0 ? mrows : NROW, Ng = gi == 0 ? QW : KVW;
                pg8::Gemm g{U + (gi == 0 ? U_AQ : U_AKV), (const bf16_t*)(wl + (gi == 0 ? WL_UQ : WL_UKV)), Mg, Ng, 512, INWP}; pg8::StaticOrder S; S.init(Mg, Ng, T.G, T.bx, 512);
                pg8::EpiBf16<0> E{gi == 0 ? QB : KVB, Ng}; pg8::gemm_phase<pg8::EpiBf16<0>, pg8::StaticOrder, true, true>(T.lds3, g, S, E, wave_s);
            }
        } } }
        SEAM();
        if (((PH_MASK >> 5) & 1) && RUN(ph)) { for (int rep_ = 0; rep_ < 1 + ((DUP_MASK >> 5) & 1) * ((DUP_L >> l_) & 1); ++rep_) { if (rep_) GBAR(); { const Ctx T = make_ctx(lds, wave_s);
            const float CA = MLA_SCALE * 1.4426950408889634f, CB = SWA_SCALE * 1.4426950408889634f;
            const int nu = l == 0 ? 544 : 512;
            for (int rs_ = 0; rs_ < 1 + (DUP_SUB & 1); ++rs_)
            for (int u = T.vcu; u < nu; u += T.G) {
                att::UnitP P; P.ldq = QW; P.ldkn = KVW; P.Kp = U + U_AKR; P.ldkp = INWP; P.ldv = KVW; P.ldo = MIXW; P.masked = 0; P.kpos1 = 0; P.has_sink = 0; P.sink = 0.f;
                if (u < 512) { const int bh = u >> 4, qb = u & 15, b = bh >> 3, h = bh & 7; const size_t q0 = (size_t)b * SEQ + qb * 256;
                    P.Q = QB + q0 * QW + h * 192; P.Kn = KVB + h * 256; P.V = KVB + h * 256 + 128; P.O = MIX + q0 * MIXW + h * 128;
                    P.base0 = b * SEQ; P.n0 = 64; P.base1 = NLAT + b * CTXL; P.NT = 68; P.qpos0 = qb * 256; P.rope = 1; }
                else { const int bh = u - 512, b = bh >> 3, h = bh & 7; const size_t q0 = (size_t)NLAT + b * CTXL;
                    P.Q = QB + q0 * QW + h * 192; P.Kn = KVB + h * 256; P.V = KVB + h * 256 + 128; P.O = MIX + q0 * MIXW + h * 128;
                    P.base0 = NLAT + b * CTXL; P.n0 = 4; P.base1 = 0; P.NT = 4; P.qpos0 = 0; P.rope = 0; }
#ifndef NO_MLA
                att::attn_unit<12, 4, 1>(P, (char*)lds, CA, att::THR / MLA_SCALE, wave_s);
#endif
            }
            for (int rs_ = 0; rs_ < 1 + ((DUP_SUB >> 1) & 1); ++rs_)
            for (int u = T.vcu; u < nu; u += T.G) {
                att::UnitP P; P.ldq = INWP; P.Kn = nullptr; P.ldkn = 0; P.ldkp = INWP; P.ldv = INWP; P.ldo = MIXW; P.has_sink = 1;
                if (u < 512) { const int bh = u >> 4, qb = u & 15, b = bh >> 3, h = bh & 7, kvh = h >> 2; const size_t q0 = (size_t)b * SEQ + qb * 256;
                    const int kt0 = qb * 256 - 128 < 0 ? 0 : qb * 256 - 128, kt1 = qb * 256 + 384 > SEQ ? SEQ : qb * 256 + 384;
                    P.Q = U + q0 * INWP + U_BQ + h * 64; P.Kp = U + U_BK + kvh * 64; P.V = U + U_BV + kvh * 64; P.O = MIX + q0 * MIXW + 1024 + h * 64;
                    P.base0 = NLAT + b * CTXL; P.n0 = 4; P.base1 = b * SEQ + kt0; P.NT = 4 + (kt1 - kt0) / 64; P.masked = 1; P.kpos1 = kt0; P.qpos0 = qb * 256; P.rope = 1; P.sink = p.in[I_SINK][l * 8 + h]; }
                else { const int bh = u - 512, b = bh >> 3, h = bh & 7, kvh = h >> 2; const size_t q0 = (size_t)NLAT + b * CTXL;
                    P.Q = U + q0 * INWP + U_BQ + h * 64; P.Kp = U + U_BK + kvh * 64; P.V = U + U_BV + kvh * 64; P.O = MIX + q0 * MIXW + 1024 + h * 64;
                    P.base0 = NLAT + b * CTXL; P.n0 = 4; P.base1 = 0; P.NT = 4; P.masked = 0; P.kpos1 = 0; P.qpos0 = 0; P.rope = 0; P.sink = p.in[I_SINK][l * 8 + h]; }
#ifndef NO_SWA
                att::attn_unit<4, 2, 0>(P, (char*)lds, CB, att::THR / SWA_SCALE, wave_s);
#endif
            }
#ifndef NO_CONV
            for (int rs_ = 0; rs_ < 1 + ((DUP_SUB >> 2) & 1); ++rs_)
            { const Ctx T2 = make_ctx(lds, wave_s);
            conv_phase(T2, U, MIX, p.in[I_CONVW] + l * 31 * 512, p.in[I_CONVB] + l * 512, p.in[I_LNG] + l * 512, p.in[I_LNB] + l * 512, mrows / 16); }
#endif
        } } }
        SEAM();
        if (((PH_MASK >> 6) & 1) && RUN(ph)) { for (int rep_ = 0; rep_ < 1 + ((DUP_MASK >> 6) & 1) * ((DUP_L >> l_) & 1); ++rep_) { if (rep_) GBAR(); { const Ctx T = make_ctx(lds, wave_s); mergenorm_phase(T, MIX, p.in[I_ONORM] + l * MIXW, mrows); } } }
        SEAM();
        if (((PH_MASK >> 7) & 1) && RUN(ph)) { for (int rep_ = 0; rep_ < 1 + ((DUP_MASK >> 7) & 1) * ((DUP_L >> l_) & 1); ++rep_) { if (rep_) GBAR(); { const Ctx T = make_ctx(lds, wave_s);  pg8::Gemm g{MIX, (const bf16_t*)(wl + WL_OUT), mrows, DM, DM, DM}; pg8::CtxSplitOrder S; S.init(DM, T.G, T.bx, DM, l == 0);
            pg8::EpiResid E{res_lat, res_ctx, XB, modl + 2 * DM, SLAB}; pg8::gemm_phase<pg8::EpiResid, pg8::CtxSplitOrder, true, true>(T.lds3, g, S, E, wave_s); } } }
        SEAM();
        if (((PH_MASK >> 8) & 1) && RUN(ph)) { for (int rep_ = 0; rep_ < 1 + ((DUP_MASK >> 8) & 1) * ((DUP_L >> l_) & 1); ++rep_) { if (rep_) GBAR(); { const Ctx T = make_ctx(lds, wave_s); modnorm_phase(T, XB, l == 0 ? p.in[I_CTX] : XB + (size_t)NLAT * DM, mrows, p.in[I_NMLP] + l * DM, modl, 3 * DM, 4 * DM, HN, l == 0 ? SLAB : nullptr, mod + 2 * DM, XB); } } }
        SEAM();
        if (((PH_MASK >> 9) & 1) && RUN(ph)) { for (int rep_ = 0; rep_ < 1 + ((DUP_MASK >> 9) & 1) * ((DUP_L >> l_) & 1); ++rep_) { if (rep_) GBAR(); { const Ctx T = make_ctx(lds, wave_s);  pg8::Gemm g{HN, (const bf16_t*)(wl + WL_W1), mrows, FF, DM, DM}; pg8::StaticOrder S; S.init(mrows, FF, T.G, T.bx, DM);
            pg8::EpiBf16<2> E{ACT, FF}; pg8::gemm_phase<pg8::EpiBf16<2>, pg8::StaticOrder, true, true>(T.lds3, g, S, E, wave_s); } } }
        SEAM();
        if (((PH_MASK >> 10) & 1) && RUN(ph)) { for (int rep_ = 0; rep_ < 1 + ((DUP_MASK >> 10) & 1) * ((DUP_L >> l_) & 1); ++rep_) { if (rep_) GBAR(); { const Ctx T = make_ctx(lds, wave_s);  pg8::Gemm g{ACT, (const bf16_t*)(wl + WL_W2), mrows, DM, FF, FF}; pg8::CtxSplitOrder S; S.init(DM, T.G, T.bx, FF, l == 0);
            pg8::EpiResid E{XB, XB + (size_t)NLAT * DM, XB, modl + 5 * DM, SLAB}; pg8::gemm_phase<pg8::EpiResid, pg8::CtxSplitOrder, true, true>(T.lds3, g, S, E, wave_s); } } }
        SEAM();
    }
    if (((PH_MASK >> 11) & 1) && RUN(ph)) { for (int rep_ = 0; rep_ < 1 + ((DUP_MASK >> 11) & 1) * ((DUP_L >> l_) & 1); ++rep_) { if (rep_) GBAR(); { const Ctx T = make_ctx(lds, wave_s); finalnorm_phase(T, XB, p.in[I_FNORM], p.out); } } }
#undef RUN
#undef SEAM
}

constexpr int LDS_BYTES = 131072 + 1024;
constexpr int N_PHASES = 1 + 10 * DEPTH + 1;
#ifndef MK_ONE_LAUNCH
#define MK_ONE_LAUNCH 1
#endif
extern "C" void kernel_launch(void* const* d_in, const int* in_sizes, int n_in, void* d_out, int out_size, void* d_ws, size_t ws_size, hipStream_t stream) {
    static int grid = 0;
    if (grid == 0) {
        if (n_in != 23 || ws_size < WS_END || out_size != NLAT * DM) { fprintf(stderr, "kernel_launch: unexpected shapes: n_in %d ws %zu (need %zu) out %d\n", n_in, ws_size, (size_t)WS_END, out_size); grid = -1; return; }
        int dev = 0, cus = 0, per_cu = 0;
        hipGetDevice(&dev); hipDeviceGetAttribute(&cus, hipDeviceAttributeMultiprocessorCount, dev);
        if (hipFuncSetAttribute((const void*)mega_fwd, hipFuncAttributeMaxDynamicSharedMemorySize, LDS_BYTES) != hipSuccess) { fprintf(stderr, "kernel_launch: hipFuncSetAttribute failed\n"); grid = -1; return; }
        hipOccupancyMaxActiveBlocksPerMultiprocessor(&per_cu, (const void*)mega_fwd, 512, LDS_BYTES);
        (void)hipGetLastError();
        if (per_cu < 1) { fprintf(stderr, "kernel_launch: occupancy query says %d blocks per CU\n", per_cu); per_cu = 1; }
        grid = cus;
    }
    if (grid < 0) return;
    (void)hipMemsetAsync((char*)d_ws + WS_CTL, 0, 16384, stream);
    Params p{};
    for (int i = 0; i < 23; ++i) p.in[i] = (const float*)d_in[i];
    p.out = (float*)d_out; p.ws = (unsigned char*)d_ws;
#if MK_ONE_LAUNCH
    p.ph_lo = 0; p.ph_hi = N_PHASES;
    void* args[] = {&p};
    hipError_t e = hipLaunchCooperativeKernel((const void*)mega_fwd, dim3(grid), dim3(512), args, LDS_BYTES, stream);
    if (e != hipSuccess) fprintf(stderr, "kernel_launch: cooperative launch failed: %s (grid %d)\n", hipGetErrorString(e), grid);
#else
    for (int k = 0; k < N_PHASES; ++k) { p.ph_lo = k; p.ph_hi = k + 1; hipLaunchKernelGGL(mega_fwd, dim3(grid), dim3(512), LDS_BYTES, stream, p); }
#endif
}
```
